# Optimizing an MI355X kernel written in HIP

```python
import math, functools
import jax, jax.numpy as jnp
from jax import lax
import numpy as np

D_MODEL = 2048
BATCH = 2
SEQ = 4096
DEPTH = 2
DEC_BATCH = 8
DEC_SEQ = 4
PAST_LEN = 16384
PAGE_SIZE = 128

HG_HEADS = 8
HG_DK = 128
HG_DV = 128
HG_WIDTH = HG_HEADS * HG_DV
HG_CHUNK = 32
NSA_HEADS = 16
NSA_KV_HEADS = 4
NSA_GROUP = NSA_HEADS // NSA_KV_HEADS
NSA_HEAD_DIM = 64
NSA_WIDTH = NSA_HEADS * NSA_HEAD_DIM
NSA_KV_WIDTH = NSA_KV_HEADS * NSA_HEAD_DIM
CMP_BLOCK = 32
CMP_STRIDE = 16
SEL_BLOCK = 64
NSA_TOPK = 16
WINDOW = 512
WIN_QBLK = 128
NSA_QBLK = 64
RET_HEADS = 8
RET_DK = 128
RET_DV = 128
RET_WIDTH = RET_HEADS * RET_DV
RET_CHUNK = 64
FFN_HIDDEN = ((8 * D_MODEL // 3 + 255) // 256) * 256
EPS = 1e-6
NEG_BIG = -1e30
POS_BIG = 1e30
MIN_F = 1e-20

IN_SPLITS = (
    HG_HEADS * HG_DK, HG_HEADS * HG_DK, HG_WIDTH, HG_WIDTH,
    NSA_WIDTH, 4 * NSA_KV_WIDTH, 2 * NSA_KV_WIDTH, 3 * NSA_HEADS,
    RET_HEADS * RET_DK, RET_HEADS * RET_DK, RET_WIDTH, RET_WIDTH,
    3 * D_MODEL,
)
W_IN = sum(IN_SPLITS)

kernel_name = 'hybrid_hgrn2_nsa_retention_step'


def rmsnorm(x, gain):
    xf = x.astype(jnp.float32)
    xf = xf * lax.rsqrt(jnp.mean(xf * xf, axis=-1, keepdims=True) + EPS)
    return (xf * gain.astype(jnp.float32)).astype(x.dtype)


def masked_softmax(s, valid):
    s = jnp.where(valid, s.astype(jnp.float32), NEG_BIG)
    m = jnp.max(s, axis=-1, keepdims=True)
    p = jnp.where(valid, jnp.exp(s - m), 0.0)
    return p / jnp.maximum(jnp.sum(p, axis=-1, keepdims=True), 1e-30)


def alibi_slopes():
    h = jnp.arange(1, NSA_HEADS + 1, dtype=jnp.float32)
    return jnp.exp2(-8.0 * h / NSA_HEADS).reshape(NSA_KV_HEADS, NSA_GROUP)


def split_in(h):
    offs = [int(o) for o in np.cumsum(IN_SPLITS)[:-1]]
    return jnp.split(h, offs, axis=-1)


def to_chunks(a, c):
    B, T = a.shape[:2]
    return a.reshape((B, T // c, c) + a.shape[2:]).swapaxes(0, 1)


def from_chunks(a):
    n, B, c = a.shape[:3]
    return a.swapaxes(0, 1).reshape((B, n * c) + a.shape[3:])


def hgrn2_mixer(hq, hf, hi, hg, lb, out_gain, S0):
    B, T = hq.shape[:2]
    q = jax.nn.silu(hq.astype(jnp.float32)).reshape(B, T, HG_HEADS, HG_DK)
    z = hf.astype(jnp.float32).reshape(B, T, HG_HEADS, HG_DK)
    lb = lb.reshape(HG_HEADS, HG_DK)
    sig = jax.nn.sigmoid(z)
    f = lb + (1.0 - lb) * sig
    log_f = jnp.log(jnp.maximum(f, MIN_F))
    k = (1.0 - lb) * (1.0 - sig)
    v = hi.astype(jnp.float32).reshape(B, T, HG_HEADS, HG_DV)
    C = math.gcd(T, HG_CHUNK)
    causal = jnp.tril(jnp.ones((C, C), dtype=bool))[None, :, :, None, None]

    def step(S, inp):
        qc, kc, vc, gc = inp
        b = jnp.cumsum(gc, axis=1)
        diff = b[:, :, None] - b[:, None]
        decay = jnp.where(causal, jnp.exp(jnp.where(causal, diff, 0.0)), 0.0)
        att = jnp.einsum('bthk,btshk,bshk->bths', qc, decay, kc)
        o = jnp.einsum('bths,bshv->bthv', att, vc) + jnp.einsum('bthk,bhkv->bthv', qc * jnp.exp(b), S)
        b_last = b[:, -1]
        S = jnp.exp(b_last)[..., None] * S + jnp.einsum('bshk,bshv->bhkv', kc * jnp.exp(b_last[:, None] - b), vc)
        return S, o

    S, o = lax.scan(step, S0.astype(jnp.float32),
                    (to_chunks(q, C), to_chunks(k, C), to_chunks(v, C), to_chunks(log_f, C)))
    o = rmsnorm(from_chunks(o), out_gain).reshape(B, T, HG_WIDTH) * jax.nn.silu(hg.astype(jnp.float32))
    return o.astype(hq.dtype), S.astype(S0.dtype)


def retention_mixer(rq, rk, rv, rg, S0):
    B, T = rq.shape[:2]
    q = rq.astype(jnp.float32).reshape(B, T, RET_HEADS, RET_DK) * RET_DK ** -0.5
    k = rk.astype(jnp.float32).reshape(B, T, RET_HEADS, RET_DK)
    v = rv.astype(jnp.float32).reshape(B, T, RET_HEADS, RET_DV)
    lg = jnp.log1p(-jnp.exp2(-5.0 - jnp.arange(RET_HEADS, dtype=jnp.float32)))
    C = math.gcd(T, RET_CHUNK)
    t = jnp.arange(C, dtype=jnp.float32)
    rel = t[:, None] - t[None, :]
    D = jnp.where((rel >= 0)[:, :, None], jnp.exp(jnp.maximum(rel, 0.0)[:, :, None] * lg), 0.0)
    D = D.transpose(0, 2, 1)
    q_dec = jnp.exp((t[:, None] + 1.0) * lg)
    k_dec = jnp.exp((C - 1.0 - t)[:, None] * lg)
    chunk_dec = jnp.exp(C * lg)

    def step(S, inp):
        qc, kc, vc = inp
        att = jnp.einsum('bthk,bshk->bths', qc, kc) * D[None]
        o = jnp.einsum('bths,bshv->bthv', att, vc) + jnp.einsum('bthk,bhkv->bthv', qc * q_dec[None, :, :, None], S)
        S = chunk_dec[None, :, None, None] * S + jnp.einsum('bshk,bshv->bhkv', kc * k_dec[None, :, :, None], vc)
        return S, o

    S, o = lax.scan(step, S0.astype(jnp.float32), (to_chunks(q, C), to_chunks(k, C), to_chunks(v, C)))
    o = from_chunks(o)
    mu = jnp.mean(o, axis=-1, keepdims=True)
    var = jnp.mean(jnp.square(o - mu), axis=-1, keepdims=True)
    o = ((o - mu) * lax.rsqrt(var + EPS)).reshape(B, T, RET_WIDTH) * jax.nn.silu(rg.astype(jnp.float32))
    return o.astype(rq.dtype), S.astype(S0.dtype)


def compress_blocks(rows, w_pos):
    B, L = rows.shape[:2]
    R = CMP_BLOCK // CMP_STRIDE
    n_chunk = -(-L // CMP_STRIDE)
    rows = jnp.pad(rows, ((0, 0), (0, n_chunk * CMP_STRIDE - L), (0, 0), (0, 0), (0, 0)))
    chunks = rows.reshape(B, n_chunk, CMP_STRIDE, 2, NSA_KV_HEADS, NSA_HEAD_DIM)
    w = w_pos.reshape(2, R, CMP_STRIDE).astype(rows.dtype)
    n_blk = n_chunk - R + 1
    comp = sum(jnp.einsum('bnsche,cs->bnche', chunks[:, r:r + n_blk], w[:, r]) for r in range(R))
    blk_end = jnp.arange(n_blk) * CMP_STRIDE + CMP_BLOCK - 1
    return comp, blk_end


def nsa_cmp_sel(q, q_pos, kc, vc, blk_end, gather_sel, n_sel, k_gain_sel):
    B, T = q.shape[:2]
    slopes = alibi_slopes()
    qblk = NSA_QBLK if T % NSA_QBLK == 0 else T
    nqb = T // qblk
    topk = min(NSA_TOPK, n_sel)
    R = CMP_BLOCK // CMP_STRIDE
    M = SEL_BLOCK // CMP_STRIDE
    NB = kc.shape[1]
    blk_ids = jnp.arange(n_sel)

    def body(args):
        qb, tb = args
        s = jnp.einsum('bqhgd,bnhd->bqhgn', qb, kc).astype(jnp.float32)
        dist = (tb[:, None] - blk_end[None, :]).astype(jnp.float32)
        s = s - slopes[None, None, :, :, None] * dist[None, :, None, None, :]
        p = masked_softmax(s, (dist >= 0)[None, :, None, None, :])
        o_cmp = jnp.einsum('bqhgn,bnhd->bqhgd', p.astype(vc.dtype), vc)
        imp = jnp.sum(p, axis=3)
        imp = jnp.pad(imp, ((0, 0), (0, 0), (0, 0), (0, M * n_sel + R - 1 - NB)))
        acc = sum(imp[..., r:r + M * n_sel] for r in range(R))
        imp_sel = acc.reshape(B, qblk, NSA_KV_HEADS, n_sel, M).sum(-1)
        cur = tb // SEL_BLOCK
        forced = (blk_ids[None] == 0) | (blk_ids[None] == cur[:, None])
        allowed = blk_ids[None] * SEL_BLOCK <= tb[:, None]
        score = jnp.where(forced[None, :, None], POS_BIG,
                          jnp.where(allowed[None, :, None], imp_sel, NEG_BIG))
        _, idx = lax.top_k(score, topk)
        rows = gather_sel(idx)
        shp = (B, qblk, NSA_KV_HEADS, topk * SEL_BLOCK, NSA_HEAD_DIM)
        ks = rmsnorm(rows[..., 0, :], k_gain_sel).reshape(shp)
        vs = rows[..., 1, :].reshape(shp)
        kpos = (idx[..., None] * SEL_BLOCK + jnp.arange(SEL_BLOCK)).reshape(shp[:4])
        d2 = (tb[None, :, None, None] - kpos).astype(jnp.float32)
        s2 = jnp.einsum('bqhgd,bqhkd->bqhgk', qb, ks).astype(jnp.float32)
        s2 = s2 - slopes[None, None, :, :, None] * d2[:, :, :, None, :]
        p2 = masked_softmax(s2, (d2 >= 0)[:, :, :, None, :])
        o_sel = jnp.einsum('bqhgk,bqhkd->bqhgd', p2.astype(vs.dtype), vs)
        return o_cmp, o_sel

    qs = q.reshape(B, nqb, qblk, NSA_KV_HEADS, NSA_GROUP, NSA_HEAD_DIM).swapaxes(0, 1)
    ts = q_pos.reshape(nqb, qblk)
    o_cmp, o_sel = lax.map(body, (qs, ts))
    o_cmp = o_cmp.swapaxes(0, 1).reshape(B, T, NSA_KV_HEADS, NSA_GROUP, NSA_HEAD_DIM)
    o_sel = o_sel.swapaxes(0, 1).reshape(B, T, NSA_KV_HEADS, NSA_GROUP, NSA_HEAD_DIM)
    return o_cmp, o_sel


def window_attend(q, kv, q_pos, k_pos, k_gain):
    slopes = alibi_slopes()
    k = rmsnorm(kv[..., 0, :, :], k_gain)
    s = jnp.einsum('bnqhgd,bnkhd->bnqhgk', q, k).astype(jnp.float32)
    dist = q_pos[:, :, None] - k_pos[:, None, :]
    valid = (dist >= 0) & (dist < WINDOW) & (k_pos[:, None, :] >= 0)
    s = s - slopes[None, None, None, :, :, None] * dist.astype(jnp.float32)[None, :, :, None, None, :]
    p = masked_softmax(s, valid[None, :, :, None, None, :])
    return jnp.einsum('bnqhgk,bnkhd->bnqhgd', p.astype(kv.dtype), kv[..., 1, :, :])


def nsa_prompt(q, kv4, kvw, lw):
    B, T = q.shape[:2]
    pos = jnp.arange(T)
    comp, blk_end = compress_blocks(kv4[:, :, 0:2], lw['nsa_cmp_w'])
    kc = rmsnorm(comp[:, :, 0], lw['nsa_k_norm'][0])
    vc = comp[:, :, 1]
    n_sel = -(-T // SEL_BLOCK)
    sel = jnp.pad(kv4[:, :, 2:4], ((0, 0), (0, n_sel * SEL_BLOCK - T), (0, 0), (0, 0), (0, 0)))
    sel = sel.reshape(B, n_sel, SEL_BLOCK, 2, NSA_KV_HEADS, NSA_HEAD_DIM)
    b_ix = jnp.arange(B)[:, None, None, None]
    h_ix = jnp.arange(NSA_KV_HEADS)[None, None, :, None]

    def gather(idx):
        return sel[b_ix, idx, :, :, h_ix]

    o_cmp, o_sel = nsa_cmp_sel(q, pos, kc, vc, blk_end, gather, n_sel, lw['nsa_k_norm'][1])
    nq = T // WIN_QBLK
    nw = WINDOW // WIN_QBLK
    padded = jnp.pad(kvw, ((0, 0), (WINDOW, 0), (0, 0), (0, 0), (0, 0)))
    padded = padded.reshape(B, nq + nw, WIN_QBLK, 2, NSA_KV_HEADS, NSA_HEAD_DIM)
    kvb = jnp.concatenate([padded[:, j:j + nq] for j in range(nw + 1)], axis=2)
    qb = q.reshape(B, nq, WIN_QBLK, NSA_KV_HEADS, NSA_GROUP, NSA_HEAD_DIM)
    q_pos = pos.reshape(nq, WIN_QBLK)
    k_pos = (jnp.arange(nq)[:, None] - nw) * WIN_QBLK + jnp.arange((nw + 1) * WIN_QBLK)[None]
    o_win = window_attend(qb, kvb, q_pos, k_pos, lw['nsa_k_norm'][2])
    o_win = o_win.reshape(B, T, NSA_KV_HEADS, NSA_GROUP, NSA_HEAD_DIM)
    win_state = kvw[:, T - min(WINDOW, T):]
    return o_cmp, o_sel, o_win, win_state


def nsa_sample(q, kv4, kvw, lw, pool, win_buf, page_table):
    B, T = q.shape[:2]
    pos = PAST_LEN + jnp.arange(T)
    n_pages = PAST_LEN // PAGE_SIZE
    past_cmp = pool[page_table, :, 0:2].reshape(B, n_pages * PAGE_SIZE, 2, NSA_KV_HEADS, NSA_HEAD_DIM)
    comp, blk_end = compress_blocks(jnp.concatenate([past_cmp, kv4[:, :, 0:2]], axis=1), lw['nsa_cmp_w'])
    kc = rmsnorm(comp[:, :, 0], lw['nsa_k_norm'][0])
    vc = comp[:, :, 1]
    n_past_blk = PAST_LEN // SEL_BLOCK
    n_new_blk = -(-T // SEL_BLOCK)
    n_sel = n_past_blk + n_new_blk
    bpp = PAGE_SIZE // SEL_BLOCK
    pool_blk = pool.reshape(pool.shape[0], bpp, SEL_BLOCK, 4, NSA_KV_HEADS, NSA_HEAD_DIM)
    new_blk = jnp.pad(kv4[:, :, 2:4], ((0, 0), (0, n_new_blk * SEL_BLOCK - T), (0, 0), (0, 0), (0, 0)))
    new_blk = new_blk.reshape(B, n_new_blk, SEL_BLOCK, 2, NSA_KV_HEADS, NSA_HEAD_DIM)
    b_ix = jnp.arange(B)[:, None, None, None]
    h_ix = jnp.arange(NSA_KV_HEADS)[None, None, :, None]

    def gather(idx):
        is_past = idx < n_past_blk
        ip = jnp.minimum(idx, n_past_blk - 1)
        page = page_table[b_ix, ip // bpp]
        past = pool_blk[page, ip % bpp, :, 2:4, h_ix]
        new = new_blk[b_ix, jnp.clip(idx - n_past_blk, 0, n_new_blk - 1), :, :, h_ix]
        return jnp.where(is_past[..., None, None, None], past, new)

    o_cmp, o_sel = nsa_cmp_sel(q, pos, kc, vc, blk_end, gather, n_sel, lw['nsa_k_norm'][1])
    wb = win_buf.shape[1]
    kv_ctx = jnp.concatenate([win_buf, kvw], axis=1)
    k_pos = (PAST_LEN - wb + jnp.arange(wb + T))[None]
    o_win = window_attend(q[:, None], kv_ctx[:, None], pos[None], k_pos, lw['nsa_k_norm'][2])[:, 0]
    win_state = kv_ctx[:, T:]
    return o_cmp, o_sel, o_win, win_state


def trunk_layer(x, lw, lb, hg_state, ret_state, nsa_attend):
    B, T, _ = x.shape
    h = rmsnorm(x, lw['norm_attn']) @ lw['w_in']
    (hq, hf, hi, hgate, nq, nkv, nwkv, nbg, rq, rk, rv, rgate, mg) = split_in(h)
    oA, hg_new = hgrn2_mixer(hq, hf, hi, hgate, lb, lw['hg_out_norm'], hg_state)
    q = rmsnorm(nq.reshape(B, T, NSA_KV_HEADS, NSA_GROUP, NSA_HEAD_DIM), lw['nsa_q_norm']) * NSA_HEAD_DIM ** -0.5
    kv4 = nkv.reshape(B, T, 4, NSA_KV_HEADS, NSA_HEAD_DIM)
    kvw = nwkv.reshape(B, T, 2, NSA_KV_HEADS, NSA_HEAD_DIM)
    o_cmp, o_sel, o_win, win_state = nsa_attend(q, kv4, kvw, lw)
    bg = jax.nn.sigmoid(nbg.reshape(B, T, NSA_KV_HEADS, NSA_GROUP, 3))
    oB = (bg[..., 0:1] * o_cmp + bg[..., 1:2] * o_sel + bg[..., 2:3] * o_win).reshape(B, T, NSA_WIDTH)
    oB = oB.astype(x.dtype)
    oC, ret_new = retention_mixer(rq, rk, rv, rgate, ret_state)
    gA, gB, gC = jnp.split(jax.nn.sigmoid(mg), 3, axis=-1)
    merged = gA * (oA @ lw['w_branch_hg']) + gB * (oB @ lw['w_branch_nsa']) + gC * (oC @ lw['w_branch_ret'])
    x = x + merged @ lw['w_out']
    hf2 = rmsnorm(x, lw['norm_ffn'])
    x = x + (jax.nn.silu(hf2 @ lw['w_gate']) * (hf2 @ lw['w_up'])) @ lw['w_down']
    return x, kv4, win_state, hg_new, ret_new


def setup_inputs(seed: int = 0) -> dict:
    key = jax.random.key(seed)
    ks = jax.random.split(key, 24)
    f32 = jnp.float32
    n_pages = PAST_LEN // PAGE_SIZE
    n_used = DEC_BATCH * n_pages
    n_pool = n_used + max(1, n_used // 4)
    win_buf = min(WINDOW, PAST_LEN)

    def nrm(k, shape, scale):
        return scale * jax.random.normal(k, shape, f32)

    def gain(k, shape):
        return 1.0 + nrm(k, shape, 0.05)

    return {
        'x_prompt': nrm(ks[0], (BATCH, SEQ, D_MODEL), 1.0),
        'x_sample': nrm(ks[1], (DEC_BATCH, DEC_SEQ, D_MODEL), 1.0),
        'cache_nsa': nrm(ks[2], (DEPTH, n_pool, PAGE_SIZE, 4, NSA_KV_HEADS, NSA_HEAD_DIM), 1.0),
        'cache_win': nrm(ks[3], (DEPTH, DEC_BATCH, win_buf, 2, NSA_KV_HEADS, NSA_HEAD_DIM), 1.0),
        'state_hgrn': nrm(ks[4], (DEPTH, DEC_BATCH, HG_HEADS, HG_DK, HG_DV), 0.5),
        'state_ret': nrm(ks[5], (DEPTH, DEC_BATCH, RET_HEADS, RET_DK, RET_DV), 2.0),
        'page_table': jax.random.permutation(ks[6], n_pool)[:n_used].reshape(DEC_BATCH, n_pages).astype(jnp.int32),
        'norm_attn': gain(ks[7], (DEPTH, D_MODEL)),
        'w_in': nrm(ks[8], (DEPTH, D_MODEL, W_IN), D_MODEL ** -0.5),
        'hgrn_lb_logits': nrm(ks[9], (DEPTH, HG_HEADS * HG_DK), 0.5),
        'hgrn_out_norm': gain(ks[10], (DEPTH, HG_DV)),
        'nsa_q_norm': gain(ks[11], (DEPTH, NSA_HEAD_DIM)),
        'nsa_k_norm': gain(ks[12], (DEPTH, 3, NSA_HEAD_DIM)),
        'nsa_cmp_w': (1.0 + nrm(ks[13], (DEPTH, 2, CMP_BLOCK), 0.1)) / CMP_BLOCK,
        'w_branch_hg': nrm(ks[14], (DEPTH, HG_WIDTH, D_MODEL), HG_WIDTH ** -0.5),
        'w_branch_nsa': nrm(ks[15], (DEPTH, NSA_WIDTH, D_MODEL), NSA_WIDTH ** -0.5),
        'w_branch_ret': nrm(ks[16], (DEPTH, RET_WIDTH, D_MODEL), RET_WIDTH ** -0.5),
        'w_out': nrm(ks[17], (DEPTH, D_MODEL, D_MODEL), D_MODEL ** -0.5),
        'norm_ffn': gain(ks[18], (DEPTH, D_MODEL)),
        'w_gate': nrm(ks[19], (DEPTH, D_MODEL, FFN_HIDDEN), D_MODEL ** -0.5),
        'w_up': nrm(ks[20], (DEPTH, D_MODEL, FFN_HIDDEN), D_MODEL ** -0.5),
        'w_down': nrm(ks[21], (DEPTH, FFN_HIDDEN, D_MODEL), FFN_HIDDEN ** -0.5),
    }


def reference(x_prompt, x_sample, cache_nsa, cache_win, state_hgrn, state_ret, page_table,
              norm_attn, w_in, hgrn_lb_logits, hgrn_out_norm, nsa_q_norm, nsa_k_norm, nsa_cmp_w,
              w_branch_hg, w_branch_nsa, w_branch_ret, w_out, norm_ffn, w_gate, w_up, w_down):
    sm = jax.nn.softmax(hgrn_lb_logits.astype(jnp.float32), axis=0)
    lower_bounds = jnp.clip(jnp.cumsum(sm, axis=0) - sm[0:1], 0.0, 1.0 - 1e-6)
    xp, xs = x_prompt, x_sample
    kv_p, kv_s, win_p, win_s, hg_p, hg_s, ret_p, ret_s = [], [], [], [], [], [], [], []
    for l in range(DEPTH):
        lw = {
            'norm_attn': norm_attn[l], 'w_in': w_in[l], 'hg_out_norm': hgrn_out_norm[l],
            'nsa_q_norm': nsa_q_norm[l], 'nsa_k_norm': nsa_k_norm[l], 'nsa_cmp_w': nsa_cmp_w[l],
            'w_branch_hg': w_branch_hg[l], 'w_branch_nsa': w_branch_nsa[l], 'w_branch_ret': w_branch_ret[l],
            'w_out': w_out[l], 'norm_ffn': norm_ffn[l], 'w_gate': w_gate[l], 'w_up': w_up[l], 'w_down': w_down[l],
        }
        hg0 = jnp.zeros((xp.shape[0], HG_HEADS, HG_DK, HG_DV), jnp.float32)
        ret0 = jnp.zeros((xp.shape[0], RET_HEADS, RET_DK, RET_DV), jnp.float32)
        xp, kvp, wp, hp, rp = trunk_layer(xp, lw, lower_bounds[l], hg0, ret0, nsa_prompt)
        sample_attend = functools.partial(nsa_sample, pool=cache_nsa[l], win_buf=cache_win[l], page_table=page_table)
        xs, kvs, wsmp, hs, rs = trunk_layer(xs, lw, lower_bounds[l], state_hgrn[l], state_ret[l], sample_attend)
        kv_p.append(kvp); kv_s.append(kvs); win_p.append(wp); win_s.append(wsmp)
        hg_p.append(hp); hg_s.append(hs); ret_p.append(rp); ret_s.append(rs)
    return (xp, xs, jnp.stack(kv_p), jnp.stack(kv_s), jnp.stack(win_p), jnp.stack(win_s),
            jnp.stack(hg_p), jnp.stack(hg_s), jnp.stack(ret_p), jnp.stack(ret_s))
```

```cpp
#ifndef CPU_TEST
#include <hip/hip_runtime.h>
#endif
#include <cstdio>
#include <cstdint>
#include <cmath>

#ifndef CFG_SMALL
constexpr int D_MODEL = 2048, BATCH = 2, SEQ = 4096, DEPTH = 2, DEC_BATCH = 8, DEC_SEQ = 4, PAST_LEN = 16384, PAGE_SIZE = 128;
constexpr int HG_HEADS = 8, HG_DK = 128, HG_DV = 128;
constexpr int NSA_HEADS = 16, NSA_KV_HEADS = 4, NSA_HEAD_DIM = 64, CMP_BLOCK = 32, CMP_STRIDE = 16, SEL_BLOCK = 64, NSA_TOPK = 16, WINDOW = 512;
constexpr int RET_HEADS = 8, RET_DK = 128, RET_DV = 128;
#else
constexpr int D_MODEL = 64, BATCH = 2, SEQ = 1024, DEPTH = 2, DEC_BATCH = 2, DEC_SEQ = 4, PAST_LEN = 512, PAGE_SIZE = 128;
constexpr int HG_HEADS = 2, HG_DK = 32, HG_DV = 32;
constexpr int NSA_HEADS = 8, NSA_KV_HEADS = 2, NSA_HEAD_DIM = 32, CMP_BLOCK = 32, CMP_STRIDE = 16, SEL_BLOCK = 64, NSA_TOPK = 5, WINDOW = 128;
constexpr int RET_HEADS = 2, RET_DK = 32, RET_DV = 32;
#endif
constexpr int HGK = HG_HEADS * HG_DK, HGW = HG_HEADS * HG_DV, NSA_GROUP = NSA_HEADS / NSA_KV_HEADS, NSAW = NSA_HEADS * NSA_HEAD_DIM, NSAKVW = NSA_KV_HEADS * NSA_HEAD_DIM;
constexpr int RETK = RET_HEADS * RET_DK, RETW = RET_HEADS * RET_DV;
constexpr int FFN = ((8 * D_MODEL / 3 + 255) / 256) * 256;
constexpr float EPS = 1e-6f, NEG_BIG = -1e30f, POS_BIG = 1e30f, MIN_F = 1e-20f;
constexpr int C_HQ = 0, C_HF = C_HQ + HGK, C_HI = C_HF + HGK, C_HG = C_HI + HGW, C_NQ = C_HG + HGW, C_NKV = C_NQ + NSAW, C_NWKV = C_NKV + 4 * NSAKVW,
              C_NBG = C_NWKV + 2 * NSAKVW, C_RQ = C_NBG + 3 * NSA_HEADS, C_RK = C_RQ + RETK, C_RV = C_RK + RETK, C_RG = C_RV + RETW, C_MG = C_RG + RETW, W_IN = C_MG + 3 * D_MODEL;
constexpr int HP = ((W_IN + 255) / 256) * 256;
constexpr int NP = BATCH * SEQ, NS = DEC_BATCH * DEC_SEQ, MR = NP + NS, MP = ((MR + 255) / 256) * 256;
constexpr int NSEQ = BATCH + DEC_BATCH;
constexpr int KBR = HGW + NSAW + RETW;
constexpr int CMP_R = CMP_BLOCK / CMP_STRIDE, SEL_M = SEL_BLOCK / CMP_STRIDE;
constexpr int NBP = SEQ / CMP_STRIDE - CMP_R + 1;
constexpr int LS = PAST_LEN + DEC_SEQ, NCH_S = (LS + CMP_STRIDE - 1) / CMP_STRIDE, NBS = NCH_S - CMP_R + 1;
constexpr int NSEL_P = (SEQ + SEL_BLOCK - 1) / SEL_BLOCK, NPAST_BLK = PAST_LEN / SEL_BLOCK, NNEW_BLK = (DEC_SEQ + SEL_BLOCK - 1) / SEL_BLOCK, NSEL_S = NPAST_BLK + NNEW_BLK;
constexpr int NSEL_MAX = NSEL_P > NSEL_S ? NSEL_P : NSEL_S;
constexpr int NBPP = ((NBP + 31) / 32) * 32;
constexpr int HDIM = NSA_HEAD_DIM;
constexpr int TOPK_P = NSA_TOPK < NSEL_P ? NSA_TOPK : NSEL_P, TOPK_S = NSA_TOPK < NSEL_S ? NSA_TOPK : NSEL_S;
constexpr int NPAGES = PAST_LEN / PAGE_SIZE, NUSED = DEC_BATCH * NPAGES, NPOOL = NUSED + (NUSED / 4 > 1 ? NUSED / 4 : 1), WINBUF = WINDOW < PAST_LEN ? WINDOW : PAST_LEN;
constexpr int WINP = WINDOW < SEQ ? WINDOW : SEQ;
constexpr int ROWF = 4 * NSAKVW;
constexpr int WROWF = 2 * NSAKVW;
static_assert(DEC_SEQ <= CMP_STRIDE && NNEW_BLK == 1, "sample group: one new selection block");

constexpr long O_YP = 0, O_YS = O_YP + (long)NP * D_MODEL, O_KVP = O_YS + (long)NS * D_MODEL, O_KVS = O_KVP + (long)DEPTH * NP * ROWF, O_WP = O_KVS + (long)DEPTH * NS * ROWF,
               O_WS = O_WP + (long)DEPTH * BATCH * WINP * WROWF, O_HP = O_WS + (long)DEPTH * DEC_BATCH * WINBUF * WROWF, O_HS = O_HP + (long)DEPTH * BATCH * HG_HEADS * HG_DK * HG_DV,
               O_RP = O_HS + (long)DEPTH * DEC_BATCH * HG_HEADS * HG_DK * HG_DV, O_RS = O_RP + (long)DEPTH * BATCH * RET_HEADS * RET_DK * RET_DV, O_END = O_RS + (long)DEPTH * DEC_BATCH * RET_HEADS * RET_DK * RET_DV;

#ifdef CPU_TEST
#define HD
#define DEV
#define FI inline
#else
#define HD __host__ __device__
#define DEV __device__
#define FI __forceinline__
#endif
typedef unsigned short bf16;
HD FI float bf2f(bf16 b) { union { unsigned u; float f; } c; c.u = ((unsigned)b) << 16; return c.f; }
HD FI unsigned pk2bf(float lo, float hi) {
#if defined(__HIP_DEVICE_COMPILE__)
    typedef float f32x2_t_ __attribute__((ext_vector_type(2))); typedef __bf16 bf16x2_t_ __attribute__((ext_vector_type(2)));
    const f32x2_t_ v = {lo, hi}; const bf16x2_t_ b = __builtin_convertvector(v, bf16x2_t_); return __builtin_bit_cast(unsigned, b);
#else
    union { unsigned u; float f; } a, b; a.f = lo; b.f = hi; return ((a.u + 0x7fffu + ((a.u >> 16) & 1u)) >> 16) | (((b.u + 0x7fffu + ((b.u >> 16) & 1u)) >> 16) << 16);
#endif
}
HD FI bf16 f2bf(float f) { return (bf16)(pk2bf(f, f) & 0xffffu); }
HD FI float fexp(float x) {
#if defined(__HIP_DEVICE_COMPILE__)
    return __builtin_amdgcn_exp2f(x * 1.44269504088896341f);
#else
    return expf(x);
#endif
}
HD FI float fexp2(float x) {
#if defined(__HIP_DEVICE_COMPILE__)
    return __builtin_amdgcn_exp2f(x);
#else
    return exp2f(x);
#endif
}
constexpr float LOG2E = 1.44269504088896341f;
HD FI float flog(float x) {
#if defined(__HIP_DEVICE_COMPILE__)
    return __builtin_amdgcn_logf(x) * 0.693147180559945309f;
#else
    return logf(x);
#endif
}
HD FI float frsq(float x) {
#if defined(__HIP_DEVICE_COMPILE__)
    return __builtin_amdgcn_rsqf(x);
#else
    return 1.0f / sqrtf(x);
#endif
}
HD FI float frcp(float x) {
#if defined(__HIP_DEVICE_COMPILE__)
    return __builtin_amdgcn_rcpf(x);
#else
    return 1.0f / x;
#endif
}
HD FI float sigmoid_fast(float x) { return frcp(1.0f + fexp(-x)); }
HD FI float silu_fast(float x) { return x * frcp(1.0f + fexp(-x)); }
HD FI float sigmoidf_(float x) { return sigmoid_fast(x); }
HD FI float siluf_(float x) { return silu_fast(x); }


DEV FI void ld4bf(const bf16* p, float (&v)[4]) {
#ifdef CPU_TEST
    for (int j = 0; j < 4; ++j) v[j] = bf2f(p[j]);
#else
    const uint2 u = *(const uint2*)p; v[0] = __uint_as_float(u.x << 16); v[1] = __uint_as_float(u.x & 0xffff0000u); v[2] = __uint_as_float(u.y << 16); v[3] = __uint_as_float(u.y & 0xffff0000u);
#endif
}
DEV FI void st4bf(bf16* p, const float* v) {
#ifdef CPU_TEST
    for (int j = 0; j < 4; ++j) p[j] = f2bf(v[j]);
#else
    uint2 u; u.x = pk2bf(v[0], v[1]); u.y = pk2bf(v[2], v[3]); *(uint2*)p = u;
#endif
}
DEV FI void ld4f(const float* p, float (&v)[4]) {
#ifdef CPU_TEST
    for (int j = 0; j < 4; ++j) v[j] = p[j];
#else
    const float4 u = *(const float4*)p; v[0] = u.x; v[1] = u.y; v[2] = u.z; v[3] = u.w;
#endif
}
DEV FI void st4f_nt(float* p, const float* v) {
#ifdef CPU_TEST
    for (int j = 0; j < 4; ++j) p[j] = v[j];
#else
    typedef float v4f_o __attribute__((ext_vector_type(4))); const v4f_o u = {v[0], v[1], v[2], v[3]}; __builtin_nontemporal_store(u, (v4f_o*)p);
#endif
}
DEV FI unsigned ldu_nt(const unsigned* p) {
#ifdef CPU_TEST
    return *p;
#else
    return __builtin_nontemporal_load(p);
#endif
}
DEV FI float ldf_nt(const float* p) {
#ifdef CPU_TEST
    return *p;
#else
    return __builtin_nontemporal_load(p);
#endif
}
DEV FI void st4f(float* p, const float* v) {
#ifdef CPU_TEST
    for (int j = 0; j < 4; ++j) p[j] = v[j];
#else
    *(float4*)p = make_float4(v[0], v[1], v[2], v[3]);
#endif
}
constexpr size_t al256(size_t x) { return (x + 255) & ~(size_t)255; }
constexpr size_t WS_CTL = 0, CTL_BYTES = 1u << 20;
constexpr size_t SZ_WIN = (size_t)HP * D_MODEL * 2, SZ_WBR = (size_t)D_MODEL * KBR * 2, SZ_WOUT = (size_t)D_MODEL * D_MODEL * 2, SZ_WGU = (size_t)2 * FFN * D_MODEL * 2, SZ_WDN = (size_t)D_MODEL * FFN * 2;
constexpr size_t WS_WIN = al256(WS_CTL + CTL_BYTES), WS_WBR = al256(WS_WIN + DEPTH * SZ_WIN), WS_WOUT = al256(WS_WBR + DEPTH * SZ_WBR), WS_WGU = al256(WS_WOUT + DEPTH * SZ_WOUT),
                 WS_WDN = al256(WS_WGU + DEPTH * SZ_WGU);
constexpr size_t WS_LB = al256(WS_WDN + DEPTH * SZ_WDN);
constexpr size_t WS_XN = al256(WS_LB + (size_t)DEPTH * HGK * 4);
constexpr size_t WS_H = al256(WS_XN + (size_t)MP * D_MODEL * 2);
constexpr size_t WS_OCAT = al256(WS_H + (size_t)MP * HP * 2);
constexpr size_t WS_MGF = al256(WS_OCAT + (size_t)MP * KBR * 2);
constexpr size_t WS_MG = al256(WS_MGF + (size_t)MP * D_MODEL * 4);
constexpr size_t WS_X1 = al256(WS_MG + (size_t)MP * D_MODEL * 2);
constexpr size_t WS_XL = al256(WS_X1 + (size_t)MP * D_MODEL * 4);
constexpr size_t WS_GU = al256(WS_XL + (size_t)MP * D_MODEL * 4);
constexpr size_t WS_F = al256(WS_GU + (size_t)MP * FFN * 2);
constexpr size_t WS_KK = al256(WS_F + (size_t)MR * HGK * 4);
constexpr size_t WS_QS = al256(WS_KK + (size_t)MR * HGK * 4);
constexpr size_t WS_OA = al256(WS_QS + (size_t)MR * HGK * 4);
constexpr size_t WS_OR = al256(WS_OA + (size_t)MR * HGW * 4);
constexpr size_t WS_QH = al256(WS_OR + (size_t)MR * RETW * 4);
constexpr size_t WS_KCP = al256(WS_QH + (size_t)MR * NSAW * 4);
constexpr size_t WS_VCP = al256(WS_KCP + (size_t)BATCH * NBP * NSAKVW * 4);
constexpr size_t WS_KCS = al256(WS_VCP + (size_t)BATCH * NBP * NSAKVW * 4);
constexpr size_t WS_VCS = al256(WS_KCS + (size_t)DEC_BATCH * NBS * NSAKVW * 4);
constexpr size_t WS_PP = al256(WS_VCS + (size_t)DEC_BATCH * NBS * NSAKVW * 4);
constexpr size_t WS_PS = al256(WS_PP + (size_t)NP * NSA_HEADS * NBPP * 4);
constexpr size_t WS_OCMP = al256(WS_PS + (size_t)NS * NSA_HEADS * NBS * 4);
constexpr size_t WS_OSEL = al256(WS_OCMP + (size_t)MR * NSAW * 4);
constexpr size_t WS_SC = al256(WS_OSEL + (size_t)MR * NSAW * 4);
constexpr size_t WS_IDX = al256(WS_SC + (size_t)MR * NSA_KV_HEADS * NSEL_MAX * 4);
constexpr size_t WS_QHB = al256(WS_IDX + (size_t)MR * NSA_KV_HEADS * NSA_TOPK * 4);
constexpr size_t WS_KSN = al256(WS_QHB + (size_t)MR * NSAW * 2);
constexpr size_t WS_KWN = al256(WS_KSN + (size_t)BATCH * NSA_KV_HEADS * SEQ * HDIM * 2);
constexpr size_t WS_VSP = al256(WS_KWN + (size_t)BATCH * NSA_KV_HEADS * SEQ * HDIM * 2);
constexpr size_t WS_VWP = al256(WS_VSP + (size_t)BATCH * NSA_KV_HEADS * SEQ * HDIM * 2);
constexpr size_t WS_KCB = al256(WS_VWP + (size_t)BATCH * NSA_KV_HEADS * SEQ * HDIM * 2);
constexpr size_t WS_VCB = al256(WS_KCB + (size_t)BATCH * NSA_KV_HEADS * NBPP * HDIM * 2);
constexpr size_t WS_SELM = al256(WS_VCB + (size_t)BATCH * NSA_KV_HEADS * NBPP * HDIM * 2);
constexpr int HG_C = 32, RET_C = 64, HG_NCH = SEQ / HG_C, RET_NCH = SEQ / RET_C;
constexpr size_t WS_KCSB = al256(WS_SELM + (size_t)NP * NSA_KV_HEADS * 8);
constexpr size_t SZ_KCS = (size_t)DEC_BATCH * NSA_KV_HEADS * NBS * HDIM * 2;
constexpr size_t WS_VCSB = al256(WS_KCSB + DEPTH * SZ_KCS);
constexpr size_t WS_SELMS = al256(WS_VCSB + DEPTH * SZ_KCS);
constexpr size_t WS_SPART = al256(WS_SELMS + (size_t)NS * NSA_KV_HEADS * ((NSEL_S + 63) / 64) * 8);
constexpr size_t WS_HQT = al256(WS_SPART + (size_t)DEC_BATCH * NSA_KV_HEADS * 16 * 3 * 64 * (2 + NSA_HEAD_DIM / 2) * 4);
constexpr size_t WS_HKT = al256(WS_HQT + (size_t)BATCH * HG_HEADS * SEQ * HG_DK * 2);
constexpr size_t WS_HKE = al256(WS_HKT + (size_t)BATCH * HG_HEADS * SEQ * HG_DK * 2);
constexpr size_t WS_HVP = al256(WS_HKE + (size_t)BATCH * HG_HEADS * SEQ * HG_DK * 2);
constexpr size_t WS_HDEC = al256(WS_HVP + (size_t)BATCH * HG_HEADS * SEQ * HG_DV * 2);
constexpr size_t WS_HDS = al256(WS_HDEC + (size_t)BATCH * HG_HEADS * HG_NCH * HG_DK * 4);
constexpr size_t WS_HSC = al256(WS_HDS + (size_t)BATCH * HG_HEADS * HG_NCH * HG_DV * HG_DK * 4);
constexpr size_t WS_RKE = al256(WS_HSC + (size_t)BATCH * HG_HEADS * HG_NCH * HG_DV * HG_DK * 2);
constexpr size_t WS_RVP = al256(WS_RKE + (size_t)BATCH * RET_HEADS * SEQ * RET_DK * 2);
constexpr size_t WS_RDS = al256(WS_RVP + (size_t)BATCH * RET_HEADS * SEQ * RET_DV * 2);
constexpr size_t WS_RSC = al256(WS_RDS + (size_t)BATCH * RET_HEADS * RET_NCH * RET_DV * RET_DK * 4);
constexpr size_t WS_END = al256(WS_RSC + (size_t)BATCH * RET_HEADS * RET_NCH * RET_DV * RET_DK * 2);

struct P {
    const float *x_prompt, *x_sample, *cache_nsa, *cache_win, *state_hgrn, *state_ret; const int* page_table;
    const float *norm_attn, *w_in, *lb_logits, *hg_out_norm, *nsa_q_norm, *nsa_k_norm, *nsa_cmp_w, *w_br_hg, *w_br_nsa, *w_br_ret, *w_out, *norm_ffn, *w_gate, *w_up, *w_down;
    float* out; unsigned char* ws;
};
#define WSP(T, off) ((T*)(p.ws + (off)))

HD FI int seq_rows(int s) { return s < BATCH ? SEQ : DEC_SEQ; }
HD FI int seq_row0(int s) { return s < BATCH ? s * SEQ : NP + (s - BATCH) * DEC_SEQ; }
HD FI int row_seq(int r) { return r < NP ? r / SEQ : BATCH + (r - NP) / DEC_SEQ; }
HD FI int row_t(int r) { return r < NP ? r % SEQ : (r - NP) % DEC_SEQ; }
HD FI int tile_perm(int ko) { const int s = ko >> 4, q = (ko >> 3) & 1, h = (ko >> 2) & 1, j = (q << 2) | (ko & 3); return s * 16 + h * 8 + j; }
HD FI int kf_off(int key, int d) { return (((d >> 4) * 2 + ((d >> 3) & 1)) * 32 + key) * 8 + (d & 7); }
HD FI int vf_off(int key, int d) { const int s2 = key >> 4, h = (key >> 2) & 1, j = (((key >> 3) & 1) << 2) | (key & 3); return (((s2 * (HDIM / 32) + (d >> 5)) * 2 + h) * 32 + (d & 31)) * 8 + j; }
DEV FI void ld8bf(const bf16* p, float (&v)[8]) {
#ifdef CPU_TEST
    for (int j = 0; j < 8; ++j) v[j] = bf2f(p[j]);
#else
    const uint4 u = *(const uint4*)p; const unsigned w[4] = {u.x, u.y, u.z, u.w};
#pragma unroll
    for (int j = 0; j < 4; ++j) { v[2 * j] = __uint_as_float(w[j] << 16); v[2 * j + 1] = __uint_as_float(w[j] & 0xffff0000u); }
#endif
}
DEV FI void st8bf(bf16* p, const float* v) {
#ifdef CPU_TEST
    for (int j = 0; j < 8; ++j) p[j] = f2bf(v[j]);
#else
    uint4 u; u.x = pk2bf(v[0], v[1]); u.y = pk2bf(v[2], v[3]); u.z = pk2bf(v[4], v[5]); u.w = pk2bf(v[6], v[7]); *(uint4*)p = u;
#endif
}
DEV FI void st_vtile(bf16* tile, int d, const bf16 (&x)[32]) {
#ifdef CPU_TEST
    for (int ko = 0; ko < 32; ++ko) tile[vf_off(ko, d)] = x[ko];
#else
#pragma unroll
    for (int s2 = 0; s2 < 2; ++s2)
#pragma unroll
        for (int h = 0; h < 2; ++h) { unsigned pk[4];
#pragma unroll
            for (int jj = 0; jj < 4; ++jj) { const int j0 = 2 * jj, j1 = 2 * jj + 1; pk[jj] = (unsigned)x[16 * s2 + 8 * (j0 >> 2) + 4 * h + (j0 & 3)] | ((unsigned)x[16 * s2 + 8 * (j1 >> 2) + 4 * h + (j1 & 3)] << 16); }
            *(uint4*)(tile + vf_off(16 * s2 + 4 * h, d)) = make_uint4(pk[0], pk[1], pk[2], pk[3]); }
#endif
}
DEV FI void st_tile32(bf16* dst, const bf16 (&x)[32]) {
#ifdef CPU_TEST
    for (int ko = 0; ko < 32; ++ko) dst[tile_perm(ko)] = x[ko];
#else
    unsigned pk[16];
#pragma unroll
    for (int q = 0; q < 16; ++q) pk[q] = 0u;
#pragma unroll
    for (int ko = 0; ko < 32; ++ko) { const int pp = tile_perm(ko); pk[pp >> 1] |= (unsigned)x[ko] << (16 * (pp & 1)); }
#pragma unroll
    for (int q = 0; q < 4; ++q) ((uint4*)dst)[q] = make_uint4(pk[4 * q], pk[4 * q + 1], pk[4 * q + 2], pk[4 * q + 3]);
#endif
}
HD FI float slope_of(int head) { return exp2f(-8.0f * (float)(head + 1) / (float)NSA_HEADS); }
HD FI float slope2_of(int head) { return slope_of(head) * LOG2E; }

DEV FI void ph_lb(const P& p, long gtid, long gsize) {
    float* LB = WSP(float, WS_LB);
    for (long c = gtid; c < HGK; c += gsize) {
        float mx = -3.0e38f;
        for (int l = 0; l < DEPTH; ++l) mx = fmaxf(mx, p.lb_logits[l * HGK + c]);
        float den = 0.f;
        for (int l = 0; l < DEPTH; ++l) den += expf(p.lb_logits[l * HGK + c] - mx);
        const float sm0 = expf(p.lb_logits[c] - mx) / den; float cum = 0.f;
        for (int l = 0; l < DEPTH; ++l) { cum += expf(p.lb_logits[l * HGK + c] - mx) / den; float lb = cum - sm0; lb = fminf(fmaxf(lb, 0.f), 1.0f - 1e-6f); LB[l * HGK + c] = lb; }
    }
}

struct SrcIn  { const float* w; HD FI float operator()(int n, int k) const { return n < W_IN ? w[(size_t)k * W_IN + n] : 0.f; } };
struct SrcT   { const float* w; int N; HD FI float operator()(int n, int k) const { return w[(size_t)k * N + n]; } };
template <class S> DEV FI void conv_rows(bf16* dst, int ldd, int nrows, int K, const S& src, long gtid, long gsize, int grp = 0) {
    const long items = (long)nrows * (K / 8);
    for (long i = gtid; i < items; i += gsize) {
        const int n = (int)(i % nrows), k0 = (int)(i / nrows) * 8;
        const int dn = grp ? (n / grp) * 2 * grp + n % grp : n;
        bf16* d = dst + (size_t)dn * ldd + k0;
        for (int j = 0; j < 8; ++j) d[j] = f2bf(src(n, k0 + j));
    }
}
DEV FI void ph_convert(const P& p, long gtid, long gsize) {
    for (int l = 0; l < DEPTH; ++l) {
        conv_rows(WSP(bf16, WS_WIN + l * SZ_WIN), D_MODEL, HP, D_MODEL, SrcIn{p.w_in + (size_t)l * D_MODEL * W_IN}, gtid, gsize);
        conv_rows(WSP(bf16, WS_WBR + l * SZ_WBR), KBR, D_MODEL, HGW, SrcT{p.w_br_hg + (size_t)l * HGW * D_MODEL, D_MODEL}, gtid, gsize);
        conv_rows(WSP(bf16, WS_WBR + l * SZ_WBR) + HGW, KBR, D_MODEL, NSAW, SrcT{p.w_br_nsa + (size_t)l * NSAW * D_MODEL, D_MODEL}, gtid, gsize);
        conv_rows(WSP(bf16, WS_WBR + l * SZ_WBR) + HGW + NSAW, KBR, D_MODEL, RETW, SrcT{p.w_br_ret + (size_t)l * RETW * D_MODEL, D_MODEL}, gtid, gsize);
        conv_rows(WSP(bf16, WS_WOUT + l * SZ_WOUT), D_MODEL, D_MODEL, D_MODEL, SrcT{p.w_out + (size_t)l * D_MODEL * D_MODEL, D_MODEL}, gtid, gsize);
        conv_rows(WSP(bf16, WS_WGU + l * SZ_WGU), D_MODEL, FFN, D_MODEL, SrcT{p.w_gate + (size_t)l * D_MODEL * FFN, FFN}, gtid, gsize, 128);
        conv_rows(WSP(bf16, WS_WGU + l * SZ_WGU) + (size_t)128 * D_MODEL, D_MODEL, FFN, D_MODEL, SrcT{p.w_up + (size_t)l * D_MODEL * FFN, FFN}, gtid, gsize, 128);
        conv_rows(WSP(bf16, WS_WDN + l * SZ_WDN), FFN, D_MODEL, FFN, SrcT{p.w_down + (size_t)l * FFN * D_MODEL, D_MODEL}, gtid, gsize);
    }
}

DEV FI const float* xin_row(const P& p, int l, int row) {
    if (l == 0) return row < NP ? p.x_prompt + (size_t)row * D_MODEL : p.x_sample + (size_t)(row - NP) * D_MODEL;
    return WSP(float, WS_XL) + (size_t)row * D_MODEL;
}
DEV FI void ph_norm(const P& p, int l, int stage, long gtid, long gsize) {
    bf16* XN = WSP(bf16, WS_XN);
    for (long row = gtid; row < MP; row += gsize) {
        bf16* o = XN + (size_t)row * D_MODEL;
        if (row >= MR) { for (int c = 0; c < D_MODEL; ++c) o[c] = 0; continue; }
        const float* x = stage == 0 ? xin_row(p, l, (int)row) : WSP(float, WS_X1) + (size_t)row * D_MODEL;
        const float* g = (stage == 0 ? p.norm_attn : p.norm_ffn) + (size_t)l * D_MODEL;
        float ss = 0.f; for (int c = 0; c < D_MODEL; ++c) ss += x[c] * x[c];
        const float r = 1.0f / sqrtf(ss / (float)D_MODEL + EPS);
        for (int c = 0; c < D_MODEL; ++c) o[c] = f2bf(x[c] * r * g[c]);
    }
}

DEV FI void ph_hg_pre(const P& p, int l, long gtid, long gsize, int row0 = 0) {
    const bf16* H = WSP(bf16, WS_H); const float* LB = WSP(float, WS_LB) + (size_t)l * HGK;
    float *F = WSP(float, WS_F), *KK = WSP(float, WS_KK), *QS = WSP(float, WS_QS);
    for (long i0 = gtid; i0 < (long)(MR - row0) * HGK; i0 += gsize) {
        const long i = i0 + (long)row0 * HGK; const int row = (int)(i / HGK), c = (int)(i % HGK);
        const float z = bf2f(H[(size_t)row * HP + C_HF + c]), sig = sigmoidf_(z), lb = LB[c];
        F[i] = fmaxf(lb + (1.0f - lb) * sig, MIN_F); KK[i] = (1.0f - lb) * (1.0f - sig);
        QS[i] = siluf_(bf2f(H[(size_t)row * HP + C_HQ + c]));
    }
}
DEV FI void ph_hg_scan(const P& p, int l, long gtid, long gsize, int seq0 = 0) {
    const bf16* H = WSP(bf16, WS_H); const float *F = WSP(float, WS_F), *KK = WSP(float, WS_KK), *QS = WSP(float, WS_QS); float* OA = WSP(float, WS_OA);
    for (long i = gtid; i < (long)(NSEQ - seq0) * HG_HEADS * HG_DV; i += gsize) {
        const int v = (int)(i % HG_DV), h = (int)((i / HG_DV) % HG_HEADS), s = seq0 + (int)(i / ((long)HG_DV * HG_HEADS));
        const int T = seq_rows(s), r0 = seq_row0(s);
        float S[HG_DK];
        if (s < BATCH) {
#pragma unroll
            for (int k = 0; k < HG_DK; ++k) S[k] = 0.f;
        } else {
            const float* s0 = p.state_hgrn + ((((size_t)l * DEC_BATCH + (s - BATCH)) * HG_HEADS + h) * HG_DK) * HG_DV + v;
#pragma unroll
            for (int k = 0; k < HG_DK; ++k) S[k] = s0[(size_t)k * HG_DV];
        }
        for (int t = 0; t < T; ++t) {
            const size_t rb = (size_t)(r0 + t) * HGK + (size_t)h * HG_DK;
            const float vv = bf2f(H[(size_t)(r0 + t) * HP + C_HI + h * HG_DV + v]);
            float o = 0.f;
#pragma unroll
            for (int k = 0; k < HG_DK; ++k) { S[k] = F[rb + k] * S[k] + KK[rb + k] * vv; o += QS[rb + k] * S[k]; }
            OA[(size_t)(r0 + t) * HGW + h * HG_DV + v] = o;
        }
        float* so = s < BATCH ? p.out + O_HP + ((((size_t)l * BATCH + s) * HG_HEADS + h) * HG_DK) * HG_DV + v
                              : p.out + O_HS + ((((size_t)l * DEC_BATCH + (s - BATCH)) * HG_HEADS + h) * HG_DK) * HG_DV + v;
#pragma unroll
        for (int k = 0; k < HG_DK; ++k) so[(size_t)k * HG_DV] = S[k];
    }
}
DEV FI void ph_hg_post(const P& p, int l, long gtid, long gsize, int row0 = 0) {
    const bf16* H = WSP(bf16, WS_H); const float* OA = WSP(float, WS_OA); bf16* OCAT = WSP(bf16, WS_OCAT); const float* g = p.hg_out_norm + (size_t)l * HG_DV;
    for (long i = gtid; i < (long)(MR - row0) * HG_HEADS; i += gsize) {
        const int row = row0 + (int)(i / HG_HEADS), h = (int)(i % HG_HEADS);
        const float* o = OA + (size_t)row * HGW + h * HG_DV;
        float ss = 0.f; for (int v = 0; v < HG_DV; ++v) ss += o[v] * o[v];
        const float r = 1.0f / sqrtf(ss / (float)HG_DV + EPS);
        for (int v = 0; v < HG_DV; ++v) OCAT[(size_t)row * KBR + h * HG_DV + v] = f2bf(o[v] * r * g[v] * siluf_(bf2f(H[(size_t)row * HP + C_HG + h * HG_DV + v])));
    }
}

DEV FI void ph_ret_scan(const P& p, int l, long gtid, long gsize, int seq0 = 0) {
    const bf16* H = WSP(bf16, WS_H); float* OR = WSP(float, WS_OR);
    const float qs = 1.0f / sqrtf((float)RET_DK);
    for (long i = gtid; i < (long)(NSEQ - seq0) * RET_HEADS * RET_DV; i += gsize) {
        const int v = (int)(i % RET_DV), h = (int)((i / RET_DV) % RET_HEADS), s = seq0 + (int)(i / ((long)RET_DV * RET_HEADS));
        const int T = seq_rows(s), r0 = seq_row0(s);
        const float gam = 1.0f - exp2f(-5.0f - (float)h);
        float S[RET_DK];
        if (s < BATCH) {
#pragma unroll
            for (int k = 0; k < RET_DK; ++k) S[k] = 0.f;
        } else {
            const float* s0 = p.state_ret + ((((size_t)l * DEC_BATCH + (s - BATCH)) * RET_HEADS + h) * RET_DK) * RET_DV + v;
#pragma unroll
            for (int k = 0; k < RET_DK; ++k) S[k] = s0[(size_t)k * RET_DV];
        }
        for (int t = 0; t < T; ++t) {
            const bf16* hr = H + (size_t)(r0 + t) * HP;
            const float vv = bf2f(hr[C_RV + h * RET_DV + v]);
            float o = 0.f;
#pragma unroll
            for (int k = 0; k < RET_DK; ++k) { S[k] = gam * S[k] + bf2f(hr[C_RK + h * RET_DK + k]) * vv; o += bf2f(hr[C_RQ + h * RET_DK + k]) * S[k]; }
            OR[(size_t)(r0 + t) * RETW + h * RET_DV + v] = o * qs;
        }
        float* so = s < BATCH ? p.out + O_RP + ((((size_t)l * BATCH + s) * RET_HEADS + h) * RET_DK) * RET_DV + v
                              : p.out + O_RS + ((((size_t)l * DEC_BATCH + (s - BATCH)) * RET_HEADS + h) * RET_DK) * RET_DV + v;
#pragma unroll
        for (int k = 0; k < RET_DK; ++k) so[(size_t)k * RET_DV] = S[k];
    }
}
DEV FI void ph_ret_post(const P& p, int l, long gtid, long gsize, int row0 = 0) {
    const bf16* H = WSP(bf16, WS_H); const float* OR = WSP(float, WS_OR); bf16* OCAT = WSP(bf16, WS_OCAT);
    for (long i = gtid; i < (long)(MR - row0) * RET_HEADS; i += gsize) {
        const int row = row0 + (int)(i / RET_HEADS), h = (int)(i % RET_HEADS);
        const float* o = OR + (size_t)row * RETW + h * RET_DV;
        float mu = 0.f; for (int v = 0; v < RET_DV; ++v) mu += o[v]; mu /= (float)RET_DV;
        float var = 0.f; for (int v = 0; v < RET_DV; ++v) var += (o[v] - mu) * (o[v] - mu); var /= (float)RET_DV;
        const float r = 1.0f / sqrtf(var + EPS);
        for (int v = 0; v < RET_DV; ++v) OCAT[(size_t)row * KBR + HGW + NSAW + h * RET_DV + v] = f2bf((o[v] - mu) * r * siluf_(bf2f(H[(size_t)row * HP + C_RG + h * RET_DV + v])));
    }
}

static_assert(SEQ % RET_C == 0 && SEQ % HG_C == 0 && HG_C == 32 && RET_C == 64, "chunk sizes");
DEV FI void ph_rec_prep(const P& p, int l, long gtid, long gsize) {
    const bf16* H = WSP(bf16, WS_H); const float* LB = WSP(float, WS_LB) + (size_t)l * HGK;
    for (long i = gtid; i < (long)BATCH * HG_HEADS * HG_NCH * HG_DK; i += gsize) {
        const int k = (int)(i % HG_DK); long r = i / HG_DK; const int c = (int)(r % HG_NCH); r /= HG_NCH; const int h = (int)(r % HG_HEADS), b = (int)(r / HG_HEADS);
        const size_t bh = (size_t)b * HG_HEADS + h; const float lb = LB[h * HG_DK + k];
        float cum[HG_C], kk[HG_C]; float bsum = 0.f;
#pragma unroll
        for (int s = 0; s < HG_C; ++s) { const size_t row = (size_t)b * SEQ + c * HG_C + s;
            const float z = bf2f(H[row * HP + C_HF + h * HG_DK + k]), sig = sigmoidf_(z), f = fmaxf(lb + (1.0f - lb) * sig, MIN_F);
            bsum += flog(f); cum[s] = bsum; kk[s] = (1.0f - lb) * (1.0f - sig); }
        bf16* QT = WSP(bf16, WS_HQT) + (bh * SEQ + c * HG_C) * HG_DK + k; bf16* KT = WSP(bf16, WS_HKT) + (bh * SEQ + c * HG_C) * HG_DK + k;
        bf16* KE = WSP(bf16, WS_HKE) + (bh * HG_DK + k) * SEQ + c * HG_C;
        bf16 ke[HG_C];
#pragma unroll
        for (int s = 0; s < HG_C; ++s) { const size_t row = (size_t)b * SEQ + c * HG_C + s;
            QT[(size_t)s * HG_DK] = f2bf(siluf_(bf2f(H[row * HP + C_HQ + h * HG_DK + k])) * fexp(cum[s]));
            KT[(size_t)s * HG_DK] = f2bf(kk[s] * fexp(fminf(-cum[s], 80.0f)));
            ke[s] = f2bf(kk[s] * fexp(bsum - cum[s])); }
        st_tile32(KE, ke);
        WSP(float, WS_HDEC)[(bh * HG_NCH + c) * HG_DK + k] = fexp(bsum);
    }
    for (long i = gtid; i < (long)3 * BATCH * HG_HEADS * (SEQ / 32) * HG_DV; i += gsize) {
        const int ch = (int)(i % HG_DV); long r = i / HG_DV; const int tile = (int)(r % (SEQ / 32)); r /= (SEQ / 32); const int h = (int)(r % HG_HEADS); r /= HG_HEADS; const int b = (int)(r % BATCH), which = (int)(r / BATCH);
        const size_t bh = (size_t)b * HG_HEADS + h;
        const int col = (which == 0 ? C_HI : (which == 1 ? C_RV : C_RK)) + h * HG_DV + ch;
        bf16* dst = WSP(bf16, which == 0 ? WS_HVP : (which == 1 ? WS_RVP : WS_RKE)) + (bh * HG_DV + ch) * SEQ + tile * 32;
        const float lg2 = log2f(1.0f - fexp2(-5.0f - (float)h));
        bf16 xv[32];
#pragma unroll
        for (int ko = 0; ko < 32; ++ko) { const bf16 x = H[(size_t)(b * SEQ + tile * 32 + ko) * HP + col];
            xv[ko] = which == 2 ? f2bf(bf2f(x) * fexp2(lg2 * (float)(RET_C - 1 - ((tile * 32 + ko) % RET_C)))) : x; }
        st_tile32(dst, xv);
    }
}
static_assert(HG_HEADS == RET_HEADS && HG_DV == RET_DV && HG_DK == RET_DK && HG_DK == HG_DV, "ph_rec_prep shares its item space between the two mixers");
constexpr int SCB = (HG_NCH % 32 == 0 && RET_NCH % 32 == 0) ? 32 : 8;
static_assert(HG_NCH % SCB == 0 && RET_NCH % SCB == 0, "scan batches");
DEV FI void ph_rec_scan(const P& p, int l, long gtid, long gsize) {
    constexpr int KP2 = HG_DK / 2;
    const long nh = (long)BATCH * HG_HEADS * HG_DV * KP2;
    for (long i = gtid; i < 2 * nh; i += gsize) {
        const int which = i >= nh; const long j = which ? i - nh : i;
        const int k = 2 * (int)(j % KP2), v = (int)((j / KP2) % HG_DV), h = (int)((j / ((long)KP2 * HG_DV)) % HG_HEADS), b = (int)(j / ((long)KP2 * HG_DV * HG_HEADS));
        const size_t bh = (size_t)b * HG_HEADS + h;
        float S0 = 0.f, S1 = 0.f;
        if (which == 0) {
            const unsigned* dS = (const unsigned*)(WSP(bf16, WS_HDS) + bh * HG_NCH * HG_DV * HG_DK + (size_t)v * HG_DK + k); unsigned* SC = (unsigned*)(WSP(bf16, WS_HSC) + bh * HG_NCH * HG_DV * HG_DK + (size_t)v * HG_DK + k);
            const float* dec = WSP(float, WS_HDEC) + bh * HG_NCH * HG_DK + k;
            for (int c0 = 0; c0 < HG_NCH; c0 += SCB) { unsigned d8[SCB]; float e0[SCB], e1[SCB];
#pragma unroll
                for (int j = 0; j < SCB; ++j) { d8[j] = ldu_nt(dS + (size_t)(c0 + j) * (HG_DV * HG_DK / 2)); e0[j] = dec[(size_t)(c0 + j) * HG_DK]; e1[j] = dec[(size_t)(c0 + j) * HG_DK + 1]; }
#pragma unroll
                for (int j = 0; j < SCB; ++j) { SC[(size_t)(c0 + j) * (HG_DV * HG_DK / 2)] = pk2bf(S0, S1); S0 = e0[j] * S0 + bf2f((bf16)(d8[j] & 0xffffu)); S1 = e1[j] * S1 + bf2f((bf16)(d8[j] >> 16)); } }
            float* o = p.out + O_HP + ((((size_t)l * BATCH + b) * HG_HEADS + h) * HG_DK + k) * HG_DV + v; o[0] = S0; o[HG_DV] = S1;
        } else {
            const unsigned* dS = (const unsigned*)(WSP(bf16, WS_RDS) + bh * RET_NCH * RET_DV * RET_DK + (size_t)v * RET_DK + k); unsigned* SC = (unsigned*)(WSP(bf16, WS_RSC) + bh * RET_NCH * RET_DV * RET_DK + (size_t)v * RET_DK + k);
            const float gc = exp2f(log2f(1.0f - exp2f(-5.0f - (float)h)) * (float)RET_C);
            for (int c0 = 0; c0 < RET_NCH; c0 += SCB) { unsigned d8[SCB];
#pragma unroll
                for (int j = 0; j < SCB; ++j) d8[j] = ldu_nt(dS + (size_t)(c0 + j) * (RET_DV * RET_DK / 2));
#pragma unroll
                for (int j = 0; j < SCB; ++j) { SC[(size_t)(c0 + j) * (RET_DV * RET_DK / 2)] = pk2bf(S0, S1); S0 = gc * S0 + bf2f((bf16)(d8[j] & 0xffffu)); S1 = gc * S1 + bf2f((bf16)(d8[j] >> 16)); } }
            float* o = p.out + O_RP + ((((size_t)l * BATCH + b) * RET_HEADS + h) * RET_DK + k) * RET_DV + v; o[0] = S0; o[RET_DV] = S1;
        }
    }
}

DEV FI void ph_nsa_q(const P& p, int l, long gtid, long gsize) {
    const bf16* H = WSP(bf16, WS_H); float* QH = WSP(float, WS_QH); bf16* QHB = WSP(bf16, WS_QHB); const float* g = p.nsa_q_norm + (size_t)l * NSA_HEAD_DIM;
    const float sc = 1.0f / sqrtf((float)NSA_HEAD_DIM);
    for (long i = gtid; i < (long)MR * NSA_HEADS; i += gsize) {
        const int row = (int)(i / NSA_HEADS), hd = (int)(i % NSA_HEADS);
        const bf16* q = H + (size_t)row * HP + C_NQ + hd * NSA_HEAD_DIM;
        float xr[HDIM]; float ss = 0.f;
#pragma unroll
        for (int e0 = 0; e0 < HDIM; e0 += 8) { float v8[8]; ld8bf(q + e0, v8);
#pragma unroll
            for (int j = 0; j < 8; ++j) { xr[e0 + j] = v8[j]; ss += v8[j] * v8[j]; } }
        const float r = sc / sqrtf(ss / (float)NSA_HEAD_DIM + EPS);
#pragma unroll
        for (int e0 = 0; e0 < HDIM; e0 += 8) { float v8[8];
#pragma unroll
            for (int j = 0; j < 8; ++j) v8[j] = xr[e0 + j] * r * g[e0 + j];
            { float w8[8];
#pragma unroll
              for (int j = 0; j < 8; ++j) w8[j] = v8[j] * LOG2E;
              st8bf(QHB + (size_t)row * NSAW + hd * NSA_HEAD_DIM + e0, w8); }
            st4f(QH + (size_t)row * NSAW + hd * NSA_HEAD_DIM + e0, v8); st4f(QH + (size_t)row * NSAW + hd * NSA_HEAD_DIM + e0 + 4, v8 + 4); }
    }
}
struct RowPtr { const bf16* hb; const float* fb; };
DEV FI RowPtr nsa_row_ptr(const P& p, const bf16* H, int l, int s, int pos, int c, int h) {
    RowPtr r; r.hb = nullptr; r.fb = nullptr;
    if (s < BATCH) { r.hb = H + (size_t)(s * SEQ + pos) * HP + C_NKV + c * NSAKVW + h * NSA_HEAD_DIM; return r; }
    const int sb = s - BATCH;
    if (pos < PAST_LEN) { const int page = p.page_table[sb * NPAGES + pos / PAGE_SIZE];
        r.fb = p.cache_nsa + ((((size_t)l * NPOOL + page) * PAGE_SIZE + pos % PAGE_SIZE) * 4 + c) * NSAKVW + h * NSA_HEAD_DIM; return r; }
    if (pos < LS) r.hb = H + (size_t)(NP + sb * DEC_SEQ + (pos - PAST_LEN)) * HP + C_NKV + c * NSAKVW + h * NSA_HEAD_DIM;
    return r;
}
DEV FI RowPtr win_row_ptr(const P& p, const bf16* H, int l, int s, int kpos, int c, int h) {
    RowPtr r; r.hb = nullptr; r.fb = nullptr;
    if (s < BATCH) { r.hb = H + (size_t)(s * SEQ + kpos) * HP + C_NWKV + c * NSAKVW + h * NSA_HEAD_DIM; return r; }
    const int sb = s - BATCH;
    if (kpos < PAST_LEN) r.fb = p.cache_win + ((((size_t)l * DEC_BATCH + sb) * WINBUF + (kpos - (PAST_LEN - WINBUF))) * 2 + c) * NSAKVW + h * NSA_HEAD_DIM;
    else r.hb = H + (size_t)(NP + sb * DEC_SEQ + (kpos - PAST_LEN)) * HP + C_NWKV + c * NSAKVW + h * NSA_HEAD_DIM;
    return r;
}
#ifdef CPU_TEST
#define SCHED_FENCE() do {} while (0)
#else
#define SCHED_FENCE() __builtin_amdgcn_sched_barrier(0)
#endif
constexpr int ECH = NSA_HEAD_DIM < 8 ? NSA_HEAD_DIM : 8;
DEV FI void row_dot(const RowPtr& r, const float (&q)[NSA_HEAD_DIM], float& dot, float& ss) {
    dot = 0.f; ss = 0.f;
    if (r.hb) {
#pragma unroll
        for (int e0 = 0; e0 < NSA_HEAD_DIM; e0 += ECH) {
#pragma unroll
            for (int e = e0; e < e0 + ECH; ++e) { const float kv = bf2f(r.hb[e]); dot += q[e] * kv; ss += kv * kv; }
            SCHED_FENCE(); }
    } else if (r.fb) {
#pragma unroll
        for (int e0 = 0; e0 < NSA_HEAD_DIM; e0 += ECH) {
#pragma unroll
            for (int e = e0; e < e0 + ECH; ++e) { const float kv = r.fb[e]; dot += q[e] * kv; ss += kv * kv; }
            SCHED_FENCE(); }
    }
}
template <int N> DEV FI void row_axpy(const RowPtr& r, int eoff, float (&acc)[N], float a, float b) {
    constexpr int CH = N < 8 ? N : 8;
    if (r.hb) {
#pragma unroll
        for (int e0 = 0; e0 < N; e0 += CH) {
#pragma unroll
            for (int e = e0; e < e0 + CH; ++e) acc[e] = acc[e] * a + b * bf2f(r.hb[eoff + e]);
            SCHED_FENCE(); }
    } else if (r.fb) {
#pragma unroll
        for (int e0 = 0; e0 < N; e0 += CH) {
#pragma unroll
            for (int e = e0; e < e0 + CH; ++e) acc[e] = acc[e] * a + b * r.fb[eoff + e];
            SCHED_FENCE(); }
    } else {
#pragma unroll
        for (int e = 0; e < N; ++e) acc[e] = acc[e] * a;
    }
}
DEV FI void ph_cmp(const P& p, int l, long gtid, long gsize) {
    const bf16* H = WSP(bf16, WS_H);
    const float* w = p.nsa_cmp_w + (size_t)l * 2 * CMP_BLOCK; const float* gk = p.nsa_k_norm + (size_t)l * 3 * NSA_HEAD_DIM;
    const long nP = (long)BATCH * NBP * NSA_KV_HEADS * 2, nS = (long)DEC_BATCH * NBS * NSA_KV_HEADS * 2;
    for (long i = gtid; i < nP + nS; i += gsize) {
        int s, n, h, c; float* dst;
        if (i < nP) { c = (int)(i & 1); const long j = i >> 1; h = (int)(j % NSA_KV_HEADS); n = (int)((j / NSA_KV_HEADS) % NBP); s = (int)(j / ((long)NSA_KV_HEADS * NBP));
            dst = WSP(float, c ? WS_VCP : WS_KCP) + ((size_t)s * NBP + n) * NSAKVW + h * NSA_HEAD_DIM; }
        else { const long i2 = i - nP; c = (int)(i2 & 1); const long j = i2 >> 1; h = (int)(j % NSA_KV_HEADS); n = (int)((j / NSA_KV_HEADS) % NBS); const int sb = (int)(j / ((long)NSA_KV_HEADS * NBS)); s = BATCH + sb;
            dst = WSP(float, c ? WS_VCS : WS_KCS) + ((size_t)sb * NBS + n) * NSAKVW + h * NSA_HEAD_DIM; }
        float acc[NSA_HEAD_DIM];
#pragma unroll
        for (int e = 0; e < NSA_HEAD_DIM; ++e) acc[e] = 0.f;
#pragma unroll 1
        for (int j = 0; j < CMP_BLOCK; ++j) { const RowPtr r = nsa_row_ptr(p, H, l, s, n * CMP_STRIDE + j, c, h); row_axpy<NSA_HEAD_DIM>(r, 0, acc, 1.0f, w[c * CMP_BLOCK + j]); }
        if (c == 0) {
            float ss = 0.f;
#pragma unroll
            for (int e = 0; e < NSA_HEAD_DIM; ++e) ss += acc[e] * acc[e];
            const float r = 1.0f / sqrtf(ss / (float)NSA_HEAD_DIM + EPS);
#pragma unroll
            for (int e = 0; e < NSA_HEAD_DIM; ++e) acc[e] = acc[e] * r * gk[e];
        }
#pragma unroll
        for (int e = 0; e < NSA_HEAD_DIM; ++e) dst[e] = acc[e];
        {
            const int npitch = s < BATCH ? NBPP : NBS; const size_t sh = s < BATCH ? (size_t)s * NSA_KV_HEADS + h : (size_t)(s - BATCH) * NSA_KV_HEADS + h;
            if (c == 0) { bf16* kb = WSP(bf16, s < BATCH ? WS_KCB : WS_KCSB + l * SZ_KCS) + (sh * npitch + (n & ~31)) * HDIM;
#pragma unroll
                for (int e = 0; e < NSA_HEAD_DIM; ++e) kb[kf_off(n & 31, e)] = f2bf(acc[e]); }
            else { bf16* vb = WSP(bf16, s < BATCH ? WS_VCB : WS_VCSB + l * SZ_KCS) + (sh * npitch + (n & ~31)) * HDIM;
#pragma unroll
                for (int e = 0; e < NSA_HEAD_DIM; ++e) vb[vf_off(n & 31, e)] = f2bf(acc[e]); }
        }
    }
}
DEV FI void ph_nsa_prep(const P& p, int l, long gtid, long gsize) {
    const bf16* H = WSP(bf16, WS_H);
    for (long i = gtid; i < (long)NP * NSA_KV_HEADS * 2; i += gsize) {
        const int which = (int)(i & 1), kvh = (int)((i >> 1) % NSA_KV_HEADS), row = (int)((i >> 1) / NSA_KV_HEADS), b = row / SEQ, t = row % SEQ;
        const bf16* src = H + (size_t)row * HP + (which == 0 ? C_NKV + 2 * NSAKVW : C_NWKV) + kvh * HDIM;
        const float* gk = p.nsa_k_norm + ((size_t)l * 3 + 1 + which) * HDIM;
        bf16* dst = WSP(bf16, which == 0 ? WS_KSN : WS_KWN) + (((size_t)b * NSA_KV_HEADS + kvh) * SEQ + (t & ~31)) * HDIM;
        float xr[HDIM]; float ss = 0.f;
#pragma unroll
        for (int e0 = 0; e0 < HDIM; e0 += 8) { float v8[8]; ld8bf(src + e0, v8);
#pragma unroll
            for (int j = 0; j < 8; ++j) { xr[e0 + j] = v8[j]; ss += v8[j] * v8[j]; } }
        const float r = frsq(ss / (float)HDIM + EPS);
#pragma unroll
        for (int e0 = 0; e0 < HDIM; e0 += 8) { float v8[8];
#pragma unroll
            for (int j = 0; j < 8; ++j) v8[j] = xr[e0 + j] * r * gk[e0 + j];
            st8bf(dst + kf_off(t & 31, e0), v8); }
    }
    for (long i = gtid; i < (long)BATCH * NSA_KV_HEADS * 2 * (SEQ / 32) * HDIM; i += gsize) {
        const int d = (int)(i % HDIM); long r = i / HDIM; const int tile = (int)(r % (SEQ / 32)); r /= (SEQ / 32); const int which = (int)(r & 1); r >>= 1; const int kvh = (int)(r % NSA_KV_HEADS), b = (int)(r / NSA_KV_HEADS);
        const bf16* src = H + (size_t)(b * SEQ + tile * 32) * HP + (which == 0 ? C_NKV + 3 * NSAKVW : C_NWKV + NSAKVW) + kvh * HDIM + d;
        bf16* dst = WSP(bf16, which == 0 ? WS_VSP : WS_VWP) + (((size_t)b * NSA_KV_HEADS + kvh) * SEQ + tile * 32) * HDIM;
        bf16 xv[32];
#pragma unroll
        for (int ko = 0; ko < 32; ++ko) xv[ko] = src[(size_t)ko * HP];
        st_vtile(dst, d, xv);
    }
    for (long i = gtid; i < (long)BATCH * NSA_KV_HEADS * (NBPP - NBP) * HDIM; i += gsize) {
        const int e = (int)(i % HDIM); long r = i / HDIM; const int n = NBP + (int)(r % (NBPP - NBP)); r /= (NBPP - NBP); const int kvh = (int)(r % NSA_KV_HEADS), b = (int)(r / NSA_KV_HEADS);
        WSP(bf16, WS_KCB)[(((size_t)b * NSA_KV_HEADS + kvh) * NBPP + (n & ~31)) * HDIM + kf_off(n & 31, e)] = 0;
        WSP(bf16, WS_VCB)[(((size_t)b * NSA_KV_HEADS + kvh) * NBPP + (n & ~31)) * HDIM + vf_off(n & 31, e)] = 0;
    }
}
DEV FI void ph_cmp_attn(const P& p, int l, long gtid, long gsize, int row0 = 0) {
    const float* QH = WSP(float, WS_QH); float* OCMP = WSP(float, WS_OCMP);
    for (long i = gtid; i < (long)(MR - row0) * NSA_HEADS; i += gsize) {
        const int row = row0 + (int)(i / NSA_HEADS), hd = (int)(i % NSA_HEADS), kvh = hd / NSA_GROUP;
        const int s = row_seq(row), t = row_t(row), pos = s < BATCH ? t : PAST_LEN + t, nb = s < BATCH ? NBP : NBS;
        const float* KC = s < BATCH ? WSP(float, WS_KCP) + (size_t)s * NBP * NSAKVW : WSP(float, WS_KCS) + (size_t)(s - BATCH) * NBS * NSAKVW;
        const float* VC = s < BATCH ? WSP(float, WS_VCP) + (size_t)s * NBP * NSAKVW : WSP(float, WS_VCS) + (size_t)(s - BATCH) * NBS * NSAKVW;
        float* Pr = s < BATCH ? WSP(float, WS_PP) + ((size_t)row * NSA_HEADS + hd) * NBPP : WSP(float, WS_PS) + ((size_t)(row - NP) * NSA_HEADS + hd) * NBS;
        int nvalid = pos < CMP_BLOCK - 1 ? 0 : (pos - (CMP_BLOCK - 1)) / CMP_STRIDE + 1; if (nvalid > nb) nvalid = nb;
        const float slope = slope_of(hd);
        float q[NSA_HEAD_DIM], o[NSA_HEAD_DIM];
#pragma unroll
        for (int e = 0; e < NSA_HEAD_DIM; ++e) { q[e] = QH[(size_t)row * NSAW + hd * NSA_HEAD_DIM + e]; o[e] = 0.f; }
        float m = -3.0e38f, sum = 0.f;
#pragma unroll 1
        for (int n = 0; n < nvalid; ++n) {
            const float* k = KC + (size_t)n * NSAKVW + kvh * NSA_HEAD_DIM; const float* v = VC + (size_t)n * NSAKVW + kvh * NSA_HEAD_DIM;
            float sc = 0.f;
#pragma unroll
            for (int e = 0; e < NSA_HEAD_DIM; ++e) sc += q[e] * k[e];
            sc -= slope * (float)(pos - (n * CMP_STRIDE + CMP_BLOCK - 1));
            const float mn = fmaxf(m, sc), a = expf(m - mn), b = expf(sc - mn);
            sum = sum * a + b;
#pragma unroll
            for (int e = 0; e < NSA_HEAD_DIM; ++e) o[e] = o[e] * a + b * v[e];
            m = mn;
        }
        const float inv = 1.0f / fmaxf(sum, 1e-30f);
#pragma unroll
        for (int e = 0; e < NSA_HEAD_DIM; ++e) OCMP[(size_t)row * NSAW + hd * NSA_HEAD_DIM + e] = o[e] * inv;
#pragma unroll 1
        for (int n = 0; n < nb; ++n) {
            float pr = 0.f;
            if (n < nvalid) { const float* k = KC + (size_t)n * NSAKVW + kvh * NSA_HEAD_DIM; float sc = 0.f;
#pragma unroll
                for (int e = 0; e < NSA_HEAD_DIM; ++e) sc += q[e] * k[e];
                sc -= slope * (float)(pos - (n * CMP_STRIDE + CMP_BLOCK - 1)); pr = expf(sc - m) * inv; }
            Pr[n] = pr;
        }
    }
}
DEV FI void ph_select(const P& p, int l, long gtid, long gsize, int row0 = 0) {
    float* SC = WSP(float, WS_SC); int* IDX = WSP(int, WS_IDX);
    for (long i = gtid; i < (long)(MR - row0) * NSA_KV_HEADS; i += gsize) {
        const int row = row0 + (int)(i / NSA_KV_HEADS), kvh = (int)(i % NSA_KV_HEADS);
        const int s = row_seq(row), t = row_t(row), pos = s < BATCH ? t : PAST_LEN + t, nb = s < BATCH ? NBP : NBS, nsel = s < BATCH ? NSEL_P : NSEL_S, topk = s < BATCH ? TOPK_P : TOPK_S;
        const float* Pr = s < BATCH ? WSP(float, WS_PP) + ((size_t)row * NSA_HEADS + kvh * NSA_GROUP) * NBPP : WSP(float, WS_PS) + ((size_t)(row - NP) * NSA_HEADS + kvh * NSA_GROUP) * NBS;
        float* sc = SC + ((size_t)row * NSA_KV_HEADS + kvh) * NSEL_MAX; int* idx = IDX + ((size_t)row * NSA_KV_HEADS + kvh) * NSA_TOPK;
        const int cur = pos / SEL_BLOCK, npitch = s < BATCH ? NBPP : NBS;
        for (int j = 0; j < nsel; ++j) {
            float a = 0.f;
            for (int mm = 0; mm < SEL_M; ++mm) for (int r = 0; r < CMP_R; ++r) { const int n = j * SEL_M + mm + r; if (n < nb) for (int g = 0; g < NSA_GROUP; ++g) a += Pr[(size_t)g * npitch + n]; }
            const bool forced = (j == 0) || (j == cur), allowed = (long)j * SEL_BLOCK <= pos;
            sc[j] = forced ? POS_BIG : (allowed ? a : NEG_BIG);
        }
        for (int r = 0; r < topk; ++r) {
            float best = -3.4e38f; int bi = 0;
            for (int j = 0; j < nsel; ++j) if (sc[j] > best) { best = sc[j]; bi = j; }
            idx[r] = bi; sc[bi] = -3.4e38f;
        }
    }
}
constexpr int HDH = NSA_HEAD_DIM / 2;
DEV FI void ph_sel_attn(const P& p, int l, long gtid, long gsize, int row0 = 0) {
    const bf16* H = WSP(bf16, WS_H); const float* QH = WSP(float, WS_QH); float* OSEL = WSP(float, WS_OSEL); const int* IDX = WSP(int, WS_IDX);
    const float* gk = p.nsa_k_norm + ((size_t)l * 3 + 1) * NSA_HEAD_DIM;
    for (long i = gtid; i < (long)(MR - row0) * NSA_HEADS * 2; i += gsize) {
        const int half = (int)(i & 1), row = row0 + (int)((i >> 1) / NSA_HEADS), hd = (int)((i >> 1) % NSA_HEADS), kvh = hd / NSA_GROUP, eoff = half * HDH;
        const int s = row_seq(row), t = row_t(row), pos = s < BATCH ? t : PAST_LEN + t, topk = s < BATCH ? TOPK_P : TOPK_S;
        const int* idx = IDX + ((size_t)row * NSA_KV_HEADS + kvh) * NSA_TOPK;
        const float slope = slope_of(hd);
        float q[NSA_HEAD_DIM], o[HDH];
#pragma unroll
        for (int e = 0; e < NSA_HEAD_DIM; ++e) q[e] = QH[(size_t)row * NSAW + hd * NSA_HEAD_DIM + e] * gk[e];
#pragma unroll
        for (int e = 0; e < HDH; ++e) o[e] = 0.f;
        float m = -3.0e38f, sum = 0.f;
#pragma unroll 1
        for (int r = 0; r < topk; ++r) {
            const int blk = idx[r];
#pragma unroll 1
            for (int j = 0; j < SEL_BLOCK; ++j) {
                const int kpos = blk * SEL_BLOCK + j; if (kpos > pos) break;
                float dot, ss; row_dot(nsa_row_ptr(p, H, l, s, kpos, 2, kvh), q, dot, ss);
                const float sc = dot / sqrtf(ss / (float)NSA_HEAD_DIM + EPS) - slope * (float)(pos - kpos);
                const float mn = fmaxf(m, sc), a_ = expf(m - mn), b_ = expf(sc - mn); sum = sum * a_ + b_; m = mn;
                row_axpy<HDH>(nsa_row_ptr(p, H, l, s, kpos, 3, kvh), eoff, o, a_, b_);
            }
        }
        const float inv = 1.0f / fmaxf(sum, 1e-30f);
#pragma unroll
        for (int e = 0; e < HDH; ++e) OSEL[(size_t)row * NSAW + hd * NSA_HEAD_DIM + eoff + e] = o[e] * inv;
    }
}
DEV FI void ph_win_attn(const P& p, int l, long gtid, long gsize, int row0 = 0) {
    const bf16* H = WSP(bf16, WS_H); const float* QH = WSP(float, WS_QH); const float *OCMP = WSP(float, WS_OCMP), *OSEL = WSP(float, WS_OSEL); bf16* OCAT = WSP(bf16, WS_OCAT);
    const float* gk = p.nsa_k_norm + ((size_t)l * 3 + 2) * NSA_HEAD_DIM;
    for (long i = gtid; i < (long)(MR - row0) * NSA_HEADS * 2; i += gsize) {
        const int half = (int)(i & 1), row = row0 + (int)((i >> 1) / NSA_HEADS), hd = (int)((i >> 1) % NSA_HEADS), kvh = hd / NSA_GROUP, eoff = half * HDH;
        const int s = row_seq(row), t = row_t(row), pos = s < BATCH ? t : PAST_LEN + t;
        const float slope = slope_of(hd);
        float q[NSA_HEAD_DIM], o[HDH];
#pragma unroll
        for (int e = 0; e < NSA_HEAD_DIM; ++e) q[e] = QH[(size_t)row * NSAW + hd * NSA_HEAD_DIM + e] * gk[e];
#pragma unroll
        for (int e = 0; e < HDH; ++e) o[e] = 0.f;
        float m = -3.0e38f, sum = 0.f;
        int k0 = pos - WINDOW + 1; const int lo = s < BATCH ? 0 : PAST_LEN - WINBUF; if (k0 < lo) k0 = lo;
#pragma unroll 1
        for (int kpos = k0; kpos <= pos; ++kpos) {
            float dot, ss; row_dot(win_row_ptr(p, H, l, s, kpos, 0, kvh), q, dot, ss);
            const float sc = dot / sqrtf(ss / (float)NSA_HEAD_DIM + EPS) - slope * (float)(pos - kpos);
            const float mn = fmaxf(m, sc), a_ = expf(m - mn), b_ = expf(sc - mn); sum = sum * a_ + b_; m = mn;
            row_axpy<HDH>(win_row_ptr(p, H, l, s, kpos, 1, kvh), eoff, o, a_, b_);
        }
        const float inv = 1.0f / fmaxf(sum, 1e-30f);
        const bf16* bgp = H + (size_t)row * HP + C_NBG + hd * 3;
        const float b0 = sigmoidf_(bf2f(bgp[0])), b1 = sigmoidf_(bf2f(bgp[1])), b2 = sigmoidf_(bf2f(bgp[2]));
#pragma unroll
        for (int e = 0; e < HDH; ++e) { const size_t qi = (size_t)row * NSAW + hd * NSA_HEAD_DIM + eoff + e;
            OCAT[(size_t)row * KBR + HGW + hd * NSA_HEAD_DIM + eoff + e] = f2bf(b0 * OCMP[qi] + b1 * OSEL[qi] + b2 * o[e] * inv); }
    }
}
DEV FI void ph_copy_win(const P& p, int l, long gtid, long gsize) {
    const long n = (long)DEC_BATCH * (WINBUF - DEC_SEQ) * WROWF;
    for (long i = gtid; i < n; i += gsize) {
        const int c = (int)(i % WROWF), j = (int)((i / WROWF) % (WINBUF - DEC_SEQ)), sb = (int)(i / ((long)WROWF * (WINBUF - DEC_SEQ)));
        p.out[O_WS + (((size_t)l * DEC_BATCH + sb) * WINBUF + j) * WROWF + c] = p.cache_win[(((size_t)l * DEC_BATCH + sb) * WINBUF + j + DEC_SEQ) * WROWF + c];
    }
}
DEV FI void ph_zero_pad(const P& p, long gtid, long gsize) {
    bf16* OCAT = WSP(bf16, WS_OCAT);
    for (long i = gtid; i < (long)(MP - MR) * KBR; i += gsize) OCAT[(size_t)MR * KBR + i] = 0;
}

#ifndef FAST_EPI
#define FAST_EPI 0
#endif
#if FAST_EPI
#define SIG_EPI sigmoid_fast
#define SILU_EPI silu_fast
#else
#define SIG_EPI sigmoidf_
#define SILU_EPI siluf_
#endif
struct EpIn {
    bf16* H; float* out; int l;
    DEV FI void apply4(int row, int col, const float* v) const {
        if (col >= C_MG && col < W_IN) { const float g[4] = {SIG_EPI(v[0]), SIG_EPI(v[1]), SIG_EPI(v[2]), SIG_EPI(v[3])}; st4bf(H + (size_t)row * HP + col, g); return; }
        st4bf(H + (size_t)row * HP + col, v);
        if (row >= MR) return;
        if (col >= C_NKV && col < C_NKV + ROWF) {
            float* o = row < NP ? out + O_KVP + ((size_t)l * NP + row) * ROWF + (col - C_NKV) : out + O_KVS + ((size_t)l * NS + (row - NP)) * ROWF + (col - C_NKV);
            st4f_nt(o, v);
        } else if (col >= C_NWKV && col < C_NWKV + WROWF) {
            const int s = row_seq(row), t = row_t(row); float* o = nullptr;
            if (s < BATCH) { if (t >= SEQ - WINP) o = out + O_WP + (((size_t)l * BATCH + s) * WINP + (t - (SEQ - WINP))) * WROWF + (col - C_NWKV); }
            else o = out + O_WS + (((size_t)l * DEC_BATCH + (s - BATCH)) * WINBUF + (WINBUF - DEC_SEQ + t)) * WROWF + (col - C_NWKV);
            if (o) st4f_nt(o, v);
        }
    }
};
struct EpBr {
    const bf16* H; float* MGF; bf16* MG;
    DEV FI void apply4(int row, int col, const float* v, int seg) const {
        float* mf = MGF + (size_t)row * D_MODEL + col; float g[4], r[4];
        ld4bf(H + (size_t)row * HP + C_MG + seg * D_MODEL + col, g);
        if (seg == 0) { for (int j = 0; j < 4; ++j) r[j] = g[j] * v[j]; }
        else { float m[4]; ld4f(mf, m); for (int j = 0; j < 4; ++j) r[j] = m[j] + g[j] * v[j]; }
        if (seg == 2) st4bf(MG + (size_t)row * D_MODEL + col, r); else st4f(mf, r);
    }
};
struct EpOut {
    const float *xp, *xs, *xl; float* X1; int l;
    DEV FI void apply4(int row, int col, const float* v) const {
        if (row >= MR) return;
        float* o = X1 + (size_t)row * D_MODEL + col; float r[4];
        const float* x = l == 0 ? (row < NP ? xp + (size_t)row * D_MODEL : xs + (size_t)(row - NP) * D_MODEL) : xl + (size_t)row * D_MODEL;
        float xv[4]; ld4f(x + col, xv); for (int j = 0; j < 4; ++j) r[j] = xv[j] + v[j];
        st4f(o, r);
    }
};
struct EpGU {
    bf16* GU;
    DEV FI void apply4(int row, int ocol, const float* vg, const float* vu) const {
        float r[4]; for (int j = 0; j < 4; ++j) r[j] = SILU_EPI(vg[j]) * vu[j];
        st4bf(GU + (size_t)row * FFN + ocol, r);
    }
};
struct EpDown {
    const float* X1; float* XL; float* out; int l;
    DEV FI void apply4(int row, int col, const float* v) const {
        if (row >= MR) return;
        float x[4], r[4]; ld4f(X1 + (size_t)row * D_MODEL + col, x);
        for (int j = 0; j < 4; ++j) r[j] = x[j] + v[j];
        if (l == DEPTH - 1) st4f_nt(out + O_YP + (size_t)row * D_MODEL + col, r); else st4f(XL + (size_t)row * D_MODEL + col, r);
    }
};
#ifdef CPU_TEST
constexpr int NL = 64;
struct bf16x8 { short d[8]; short& operator[](int i) { return d[i]; } const short& operator[](int i) const { return d[i]; } };
struct f32x16 { float d[16]; float& operator[](int i) { return d[i]; } const float& operator[](int i) const { return d[i]; } };
#define LANE_OF(ln) (ln)
#else
constexpr int NL = 1;
typedef short bf16x8 __attribute__((ext_vector_type(8)));
typedef float f32x16 __attribute__((ext_vector_type(16)));
#define LANE_OF(ln) (lane_)
#endif
#define LANES for (int ln = 0; ln < NL; ++ln)
DEV FI int lane_fresh(int lane_) {
#ifndef CPU_TEST
    asm volatile("" : "+v"(lane_));
#endif
    return lane_;
}
typedef unsigned long long u64;

DEV FI bf16x8 ld8(const bf16* p) {
#ifdef CPU_TEST
    bf16x8 r; for (int j = 0; j < 8; ++j) r[j] = (short)p[j]; return r;
#else
    return *(const bf16x8*)p;
#endif
}
DEV FI void mfma32(const bf16x8* a, const bf16x8* b, f32x16* c) {
#ifdef CPU_TEST
    static float Am[32][16], Bm[16][32];
    for (int ln = 0; ln < 64; ++ln) { const int r = ln & 31, h = ln >> 5; for (int j = 0; j < 8; ++j) { Am[r][8 * h + j] = bf2f((bf16)a[ln][j]); Bm[8 * h + j][r] = bf2f((bf16)b[ln][j]); } }
    for (int ln = 0; ln < 64; ++ln) { const int col = ln & 31, h = ln >> 5; for (int i = 0; i < 16; ++i) { const int row = (i & 3) + 8 * (i >> 2) + 4 * h; float s = 0.f; for (int k = 0; k < 16; ++k) s += Am[row][k] * Bm[k][col]; c[ln][i] += s; } }
#else
    c[0] = __builtin_amdgcn_mfma_f32_32x32x16_bf16(a[0], b[0], c[0], 0, 0, 0);
#endif
}
DEV FI void xor32_max(float* x) {
#ifdef CPU_TEST
    for (int ln = 0; ln < 32; ++ln) { const float m = fmaxf(x[ln], x[ln + 32]); x[ln] = m; x[ln + 32] = m; }
#else
    x[0] = fmaxf(x[0], __shfl_xor(x[0], 32));
#endif
}
DEV FI void xor32_add(float* x) {
#ifdef CPU_TEST
    for (int ln = 0; ln < 32; ++ln) { const float m = x[ln] + x[ln + 32]; x[ln] = m; x[ln + 32] = m; }
#else
    x[0] = x[0] + __shfl_xor(x[0], 32);
#endif
}
DEV FI void half_max32(float* x) {
#ifdef CPU_TEST
    for (int hf = 0; hf < 2; ++hf) { float m = -3.4e38f; for (int ln = 0; ln < 32; ++ln) m = fmaxf(m, x[32 * hf + ln]); for (int ln = 0; ln < 32; ++ln) x[32 * hf + ln] = m; }
#else
#pragma unroll
    for (int o = 16; o >= 1; o >>= 1) x[0] = fmaxf(x[0], __shfl_xor(x[0], o));
#endif
}
DEV FI void half_sum32(float* x) {
#ifdef CPU_TEST
    for (int hf = 0; hf < 2; ++hf) { float m = 0.f; for (int ln = 0; ln < 32; ++ln) m += x[32 * hf + ln]; for (int ln = 0; ln < 32; ++ln) x[32 * hf + ln] = m; }
#else
#pragma unroll
    for (int o = 16; o >= 1; o >>= 1) x[0] += __shfl_xor(x[0], o);
#endif
}
DEV FI void lane_xor_f(const float* x, float* y, int mask) {
#ifdef CPU_TEST
    float t[64]; for (int ln = 0; ln < 64; ++ln) t[ln] = x[ln ^ mask]; for (int ln = 0; ln < 64; ++ln) y[ln] = t[ln];
#else
    y[0] = __shfl_xor(x[0], mask);
#endif
}
DEV FI void lane_xor_u(const unsigned* x, unsigned* y, int mask) {
#ifdef CPU_TEST
    unsigned t[64]; for (int ln = 0; ln < 64; ++ln) t[ln] = x[ln ^ mask]; for (int ln = 0; ln < 64; ++ln) y[ln] = t[ln];
#else
    y[0] = (unsigned)__shfl_xor((int)x[0], mask);
#endif
}
DEV FI void wave_argmax(float* v, int* j) {
#ifdef CPU_TEST
    float bv = v[0]; int bj = j[0]; for (int ln = 1; ln < 64; ++ln) if (v[ln] > bv || (v[ln] == bv && j[ln] < bj)) { bv = v[ln]; bj = j[ln]; }
    for (int ln = 0; ln < 64; ++ln) { v[ln] = bv; j[ln] = bj; }
#else
#pragma unroll
    for (int o = 32; o >= 1; o >>= 1) { const float ov = __shfl_xor(v[0], o); const int oj = __shfl_xor(j[0], o); if (ov > v[0] || (ov == v[0] && oj < j[0])) { v[0] = ov; j[0] = oj; } }
#endif
}
DEV FI int wave_first_i(const int* x) {
#ifdef CPU_TEST
    return x[0];
#else
    return __builtin_amdgcn_readfirstlane(x[0]);
#endif
}
DEV FI u64 wave_ballot(const bool* pr) {
#ifdef CPU_TEST
    u64 m = 0; for (int ln = 0; ln < 64; ++ln) if (pr[ln]) m |= (1ull << ln); return m;
#else
    return (u64)__ballot(pr[0]);
#endif
}
DEV FI float wave_bcast(const float* x, int i) {
#ifdef CPU_TEST
    return x[i];
#else
    return __int_as_float(__builtin_amdgcn_readlane(__float_as_int(x[0]), i));
#endif
}
DEV FI bf16 f2bf_s(float f) { return f2bf(f); }
DEV FI int koff_of(int i, int h) { return (i & 3) + 8 * (i >> 2) + 4 * h; }

constexpr int NSTEP = HDIM / 16, NDB = HDIM / 32;
static_assert(HDIM % 32 == 0, "wave attention: head dim multiple of 32");
struct WAttn { f32x16 o[NDB][NL]; float m[NL], l[NL]; };
DEV FI void wattn_reset(WAttn& st) { LANES { st.m[ln] = -3.0e38f; st.l[ln] = 0.f; for (int db = 0; db < NDB; ++db) for (int i = 0; i < 16; ++i) st.o[db][ln][i] = 0.f; } }
template <class F> DEV FI void wattn_scores(const int lane_, const bf16* Kt, const bf16x8 (&qf)[NSTEP][NL], f32x16 (&s)[NL], const F& f) {
    LANES { for (int i = 0; i < 16; ++i) s[ln][i] = 0.f; }
#pragma unroll
    for (int step = 0; step < NSTEP; ++step) { bf16x8 kf[NL]; LANES { const int lane = LANE_OF(ln), r = lane & 31, h = lane >> 5; kf[ln] = ld8(Kt + ((step * 2 + h) * 32 + r) * 8); } mfma32(kf, qf[step], s); }
    LANES { const int lane = LANE_OF(ln);
#pragma unroll
        for (int i = 0; i < 16; ++i) { bool v; float b; f(ln, lane, i, v, b); s[ln][i] = v ? s[ln][i] + b : -3.0e38f; } }
}
template <class F> DEV FI void wattn_tile(const int lane_, const bf16* Kt, const bf16* Vt, int vpitch, const bf16x8 (&qf)[NSTEP][NL], WAttn& st, const F& f) {
    f32x16 s[NL]; wattn_scores(lane_, Kt, qf, s, f);
    float mx[NL]; LANES { float m = -3.0e38f;
#pragma unroll
        for (int i = 0; i < 16; ++i) m = fmaxf(m, s[ln][i]); mx[ln] = m; }
    xor32_max(mx);
    bf16x8 pf[2][NL];
    LANES { const float mn = fmaxf(st.m[ln], mx[ln]), alpha = fexp2(st.m[ln] - mn); float sum = 0.f;
#pragma unroll
        for (int i = 0; i < 16; ++i) { const float pv = s[ln][i] > -1.0e38f ? fexp2(s[ln][i] - mn) : 0.f; sum += pv; pf[i >> 3][ln][i & 7] = (short)f2bf_s(pv); }
        st.l[ln] = st.l[ln] * alpha + sum; st.m[ln] = mn;
#pragma unroll
        for (int db = 0; db < NDB; ++db)
#pragma unroll
            for (int i = 0; i < 16; ++i) st.o[db][ln][i] *= alpha; }
#pragma unroll
    for (int s2 = 0; s2 < 2; ++s2)
#pragma unroll
        for (int db = 0; db < NDB; ++db) { bf16x8 vf[NL]; LANES { const int lane = LANE_OF(ln), r = lane & 31, h = lane >> 5; vf[ln] = ld8(Vt + (((s2 * NDB + db) * 2 + h) * 32 + r) * 8); } mfma32(vf, pf[s2], st.o[db]); }
}
DEV FI void wattn_finish(WAttn& st) {
    xor32_add(st.l);
    LANES { const float inv = frcp(fmaxf(st.l[ln], 1e-30f));
#pragma unroll
        for (int db = 0; db < NDB; ++db)
#pragma unroll
            for (int i = 0; i < 16; ++i) st.o[db][ln][i] *= inv; }
}

#ifndef WATTN_NB
#define WATTN_NB 2
#endif
struct WFrags { bf16x8 k[NSTEP][NL]; bf16x8 v[2][NDB][NL]; };
DEV FI void wattn_fetch(const int lane_, const bf16* Kt, const bf16* Vt, int vpitch, WFrags& fr) {
    LANES { const int lane = LANE_OF(ln), r = lane & 31, h = lane >> 5;
#pragma unroll
        for (int step = 0; step < NSTEP; ++step) fr.k[step][ln] = ld8(Kt + ((step * 2 + h) * 32 + r) * 8);
        if (Vt) {
#pragma unroll
            for (int s2 = 0; s2 < 2; ++s2)
#pragma unroll
                for (int db = 0; db < NDB; ++db) fr.v[s2][db][ln] = ld8(Vt + (((s2 * NDB + db) * 2 + h) * 32 + r) * 8); } }
}
template <class F> DEV FI void wattn_scores_fr(const int lane_, int tile, const WFrags& fr, const bf16x8 (&qf)[NSTEP][NL], f32x16 (&s)[NL], const F& f) {
    LANES { for (int i = 0; i < 16; ++i) s[ln][i] = 0.f; }
#pragma unroll
    for (int step = 0; step < NSTEP; ++step) mfma32(fr.k[step], qf[step], s);
    LANES { const int lane = LANE_OF(ln);
#pragma unroll
        for (int i = 0; i < 16; ++i) { bool v; float b; f(tile, ln, lane, i, v, b); s[ln][i] = v ? s[ln][i] + b : -3.0e38f; } }
}
template <class CB, class D, class LOK, class EM, class EOK> struct WMask { const CB& cb; const D& d; const LOK& lane_ok; const EM& elem; const EOK& elem_ok; };
template <class CB, class D, class LOK, class EM, class EOK> DEV FI WMask<CB, D, LOK, EM, EOK> make_wmask(const CB& cb, const D& d, const LOK& lok, const EM& em, const EOK& eok) { return WMask<CB, D, LOK, EM, EOK>{cb, d, lok, em, eok}; }
DEV FI bool wave_any(const bool* pr) { return wave_ballot(pr) != 0ull; }
template <class MK> DEV FI void wattn_step(const int lane_, int tile, const WFrags& fr, const bf16x8 (&qf)[NSTEP][NL], WAttn& st, const MK& mk) {
    f32x16 s[NL]; LANES { for (int i = 0; i < 16; ++i) s[ln][i] = 0.f; }
#pragma unroll
    for (int step = 0; step < NSTEP; ++step) mfma32(fr.k[step], qf[step], s);
    const bool em = mk.elem(tile);
    float mx[NL], dd[NL]; bool lok[NL];
    LANES { const int lane = LANE_OF(ln); float m = -3.0e38f;
        if (em) {
#pragma unroll
            for (int i = 0; i < 16; ++i) { const float v = mk.elem_ok(tile, ln, lane, i) ? s[ln][i] + mk.cb(i, ln) : -3.0e38f; s[ln][i] = v; m = fmaxf(m, v); }
        } else {
#pragma unroll
            for (int i = 0; i < 16; ++i) { const float v = s[ln][i] + mk.cb(i, ln); s[ln][i] = v; m = fmaxf(m, v); }
        }
        lok[ln] = mk.lane_ok(tile, ln); dd[ln] = mk.d(tile, ln);
        mx[ln] = (lok[ln] && m > -1.0e38f) ? m + dd[ln] : -3.0e38f; }
    xor32_max(mx);
    bf16x8 pf[2][NL]; bool up[NL]; float alpha[NL];
    LANES { const float mn = fmaxf(st.m[ln], mx[ln]); up[ln] = mn > st.m[ln]; alpha[ln] = fexp2(st.m[ln] - mn); st.m[ln] = mn;
        const float mref = lok[ln] ? mn - dd[ln] : 3.0e38f; float sum = 0.f;
        if (em) {
#pragma unroll
            for (int i = 0; i < 16; ++i) { const float pv = s[ln][i] > -1.0e38f ? fexp2(s[ln][i] - mref) : 0.f; sum += pv; pf[i >> 3][ln][i & 7] = (short)f2bf_s(pv); }
        } else {
#pragma unroll
            for (int i = 0; i < 16; ++i) { const float pv = fexp2(s[ln][i] - mref); sum += pv; pf[i >> 3][ln][i & 7] = (short)f2bf_s(pv); }
        }
        st.l[ln] = st.l[ln] * alpha[ln] + sum; }
    if (wave_any(up)) {
        LANES {
#pragma unroll
            for (int db = 0; db < NDB; ++db)
#pragma unroll
                for (int i = 0; i < 16; ++i) st.o[db][ln][i] *= alpha[ln]; } }
#pragma unroll
    for (int s2 = 0; s2 < 2; ++s2)
#pragma unroll
        for (int db = 0; db < NDB; ++db) mfma32(fr.v[s2][db], pf[s2], st.o[db]);
}
template <int NB, class NEXT, class FETCH, class STEP> DEV FI void wattn_run(const NEXT& next, const FETCH& fetch, const STEP& step) {
    static_assert(NB >= 2, "ring");
    WFrags fr[NB]; int tl[NB];
#pragma unroll
    for (int k = 0; k < NB - 1; ++k) { tl[k] = next(); if (tl[k] >= 0) fetch(tl[k], fr[k]); }
    for (;;) {
#pragma unroll
        for (int k = 0; k < NB; ++k) { constexpr int dummy = 0; (void)dummy; const int kn = (k + NB - 1) % NB;
            tl[kn] = next(); if (tl[kn] >= 0) fetch(tl[kn], fr[kn]);
            if (tl[k] < 0) return;
            step(tl[k], fr[k]); }
    }
}
DEV FI u64 wave_uniform_u64(u64 x) {
#ifdef CPU_TEST
    return x;
#else
    return ((u64)(unsigned)__builtin_amdgcn_readfirstlane((int)(unsigned)(x >> 32)) << 32) | (unsigned)__builtin_amdgcn_readfirstlane((int)(unsigned)x);
#endif
}
DEV FI u64 wave_or_u64(const u64* x) {
#ifdef CPU_TEST
    u64 m = 0; for (int ln = 0; ln < 64; ++ln) m |= x[ln]; return m;
#else
    unsigned lo = (unsigned)x[0], hi = (unsigned)(x[0] >> 32);
#pragma unroll
    for (int o = 32; o >= 1; o >>= 1) { lo |= (unsigned)__shfl_xor((int)lo, o); hi |= (unsigned)__shfl_xor((int)hi, o); }
    return ((u64)hi << 32) | lo;
#endif
}

static_assert(NSA_GROUP == 4 && SEQ % 64 == 0 && SEL_BLOCK == 64, "wave NSA layout");
constexpr int NTG = SEQ / 8;
DEV FI void nsa_q_frags(const int lane_, const P& p, int l, const size_t (&row)[NL], int kvh, bf16x8 (&qf)[NSTEP][NL]) {
    const bf16* H = WSP(bf16, WS_H); const float* g = p.nsa_q_norm + (size_t)l * HDIM;
    float x[NSTEP * 8][NL], ss[NL];
    LANES { const int lane = LANE_OF(ln), r = lane & 31, h = lane >> 5; const bf16* q = H + row[ln] * HP + C_NQ + (kvh * 4 + (r & 3)) * HDIM; float a = 0.f;
#pragma unroll
        for (int step = 0; step < NSTEP; ++step) { float v8[8]; ld8bf(q + 16 * step + 8 * h, v8);
#pragma unroll
            for (int j = 0; j < 8; ++j) { x[step * 8 + j][ln] = v8[j]; a += v8[j] * v8[j]; } }
        ss[ln] = a; }
    xor32_add(ss);
    LANES { const int lane = LANE_OF(ln), h = lane >> 5; const float rn = LOG2E / sqrtf((float)HDIM) * frsq(ss[ln] / (float)HDIM + EPS);
#pragma unroll
        for (int step = 0; step < NSTEP; ++step)
#pragma unroll
            for (int j = 0; j < 8; ++j) qf[step][ln][j] = (short)f2bf_s(x[step * 8 + j][ln] * rn * g[16 * step + 8 * h + j]); }
}
DEV FI void nsa_load_q(const int lane_, const P& p, int l, int b, int kvh, int t0, bf16x8 (&qf)[NSTEP][NL]) {
    size_t row[NL]; LANES { const int r = LANE_OF(ln) & 31; row[ln] = (size_t)b * SEQ + t0 + (r >> 2); }
    nsa_q_frags(lane_, p, l, row, kvh, qf);
}
DEV FI void nsa_cmp_item(const int lane_, const P& p, int l, int b, int kvh, int tg) {
    const int t0 = tg * 8;
    bf16x8 qf[NSTEP][NL]; nsa_load_q(lane_, p, l, b, kvh, t0, qf);
    const bf16* KC = WSP(bf16, WS_KCB) + ((size_t)b * NSA_KV_HEADS + kvh) * NBPP * HDIM; const bf16* VC = WSP(bf16, WS_VCB) + ((size_t)b * NSA_KV_HEADS + kvh) * NBPP * HDIM;
    const int tl = t0 + 7, nvmax = tl < CMP_BLOCK - 1 ? 0 : (tl - (CMP_BLOCK - 1)) / CMP_STRIDE + 1, ntile = (nvmax + 31) / 32;
    WAttn st; wattn_reset(st);
    auto f = [&](int tile, int ln, int lane, int i, bool& v, float& bias) { const int r = lane & 31, h = lane >> 5, t = t0 + (r >> 2), n = tile * 32 + koff_of(i, h), be = n * CMP_STRIDE + CMP_BLOCK - 1;
        v = be <= t; bias = slope2_of(kvh * 4 + (r & 3)) * (float)(be - t0); (void)ln; };
    float sl2[NL]; int hh_[NL];
    LANES { const int lane = LANE_OF(ln), r = lane & 31; sl2[ln] = slope2_of(kvh * 4 + (r & 3)); hh_[ln] = lane >> 5; }
    auto cb = [&](int i, int ln) { return sl2[ln] * (float)(koff_of(i, 0) * CMP_STRIDE); };
    { int nx = ntile - 1; auto next = [&]() { return nx >= 0 ? nx-- : -1; };
      auto fetch = [&](int tile, WFrags& fr) { wattn_fetch(lane_, KC + (size_t)tile * 32 * HDIM, VC + (size_t)tile * 32 * HDIM, 0, fr); };
      auto dfn = [&](int tile, int ln) { return sl2[ln] * (float)((tile * 32 + 4 * hh_[ln]) * CMP_STRIDE + CMP_BLOCK - 1 - t0); };
      auto lokf = [&](int, int) { return true; };
      auto emf = [&](int) { return true; };
      auto eokf = [&](int tile, int ln, int lane, int i) { const int r = lane & 31, h = lane >> 5; (void)ln; return (tile * 32 + koff_of(i, h)) * CMP_STRIDE + CMP_BLOCK - 1 <= t0 + (r >> 2); };
      const auto mk = make_wmask(cb, dfn, lokf, emf, eokf);
      auto step = [&](int tile, const WFrags& fr) { wattn_step(lane_, tile, fr, qf, st, mk); };
      wattn_run<2>(next, fetch, step); }
    float mfin[NL]; LANES mfin[ln] = st.m[ln];
    wattn_finish(st);
    float* OCMP = WSP(float, WS_OCMP); float* PP = WSP(float, WS_PP);
    LANES { const int lane = LANE_OF(ln), r = lane & 31, h = lane >> 5; const size_t row = (size_t)b * SEQ + t0 + (r >> 2); const int head = kvh * 4 + (r & 3);
#pragma unroll
        for (int db = 0; db < NDB; ++db)
#pragma unroll
            for (int q4 = 0; q4 < 4; ++q4) { const float ov[4] = {st.o[db][ln][4 * q4], st.o[db][ln][4 * q4 + 1], st.o[db][ln][4 * q4 + 2], st.o[db][ln][4 * q4 + 3]}; st4f(OCMP + row * NSAW + head * HDIM + 32 * db + 8 * q4 + 4 * h, ov); } }
    constexpr int NT = NBPP / 32, NA = 4 * NT;
    static_assert(NSEL_P == 8 * NT && SEL_M == 4 && CMP_R == 2, "in-wave selection layout");
    float A[NA][NL]; LANES { for (int k = 0; k < NA; ++k) A[k][ln] = 0.f; }
#pragma unroll
    for (int T = 0; T < NT; ++T) {
        float part[4][NL], e0[4][NL];
        if (T < ntile) {
            WFrags fr; wattn_fetch(lane_, KC + (size_t)T * 32 * HDIM, nullptr, 0, fr);
            f32x16 s[NL]; wattn_scores_fr(lane_, T, fr, qf, s, f);
            LANES { const float inv = frcp(fmaxf(st.l[ln], 1e-30f));
#pragma unroll
                for (int q4 = 0; q4 < 4; ++q4) { float pv[4];
#pragma unroll
                    for (int j = 0; j < 4; ++j) { const float sv = s[ln][4 * q4 + j]; pv[j] = sv > -1.0e38f ? fexp2(sv - mfin[ln]) * inv : 0.f; }
                    part[q4][ln] = pv[0] + 2.0f * (pv[1] + pv[2] + pv[3]); e0[q4][ln] = pv[0]; } }
#pragma unroll
            for (int q4 = 0; q4 < 4; ++q4) {
                float t1[NL]; lane_xor_f(part[q4], t1, 1); LANES part[q4][ln] += t1[ln]; lane_xor_f(part[q4], t1, 2); LANES part[q4][ln] += t1[ln];
                lane_xor_f(e0[q4], t1, 1); LANES e0[q4][ln] += t1[ln]; lane_xor_f(e0[q4], t1, 2); LANES e0[q4][ln] += t1[ln]; }
        } else { LANES { for (int q4 = 0; q4 < 4; ++q4) { part[q4][ln] = 0.f; e0[q4][ln] = 0.f; } } }
        float pe0[4][NL];
#pragma unroll
        for (int q4 = 0; q4 < 4; ++q4) lane_xor_f(e0[q4], pe0[q4], 32);
        LANES { const int h = LANE_OF(ln) >> 5;
            if (T > 0 && h == 1) A[4 * T - 1][ln] += pe0[0][ln];
#pragma unroll
            for (int q4 = 0; q4 < 4; ++q4) A[4 * T + q4][ln] = part[q4][ln] + (h == 0 ? pe0[q4][ln] : (q4 < 3 ? pe0[q4 + 1 < 4 ? q4 + 1 : 3][ln] : 0.f)); }
    }
    LANES { const int lane = LANE_OF(ln), r = lane & 31, h = lane >> 5, t = t0 + (r >> 2), cur = t / SEL_BLOCK;
#pragma unroll
        for (int k = 0; k < NA; ++k) { const int j = 8 * (k >> 2) + 2 * (k & 3) + h; const bool forced = (j == 0) || (j == cur), allowed = j * SEL_BLOCK <= t;
            A[k][ln] = forced ? POS_BIG : (allowed ? A[k][ln] : NEG_BIG); } }
    float tv[NT][NL]; int tj[NT][NL], cnt[NT][NL];
    LANES { const int lane = LANE_OF(ln), g = lane & 3, h = lane >> 5;
#pragma unroll
        for (int T = 0; T < NT; ++T) { tv[T][ln] = g == 0 ? A[4 * T][ln] : (g == 1 ? A[4 * T + 1][ln] : (g == 2 ? A[4 * T + 2][ln] : A[4 * T + 3][ln])); tj[T][ln] = 8 * T + 2 * g + h; cnt[T][ln] = 0; } }
#pragma unroll
    for (int k = 0; k < NA; ++k) { float vpk[NL]; lane_xor_f(A[k], vpk, 32);
        LANES { const int h = LANE_OF(ln) >> 5; const int io = 8 * (k >> 2) + 2 * (k & 3) + h, ip = io + 1 - 2 * h; const float vo = A[k][ln], vp = vpk[ln];
#pragma unroll
            for (int T = 0; T < NT; ++T) { const float x = tv[T][ln]; const int jj = tj[T][ln];
                cnt[T][ln] += ((vo > x || (vo == x && io < jj)) ? 1 : 0) + ((vp > x || (vp == x && ip < jj)) ? 1 : 0); } } }
    unsigned mlo[NL], mhi[NL];
    LANES { unsigned lo = 0u, hi = 0u;
#pragma unroll
        for (int T = 0; T < NT; ++T) { const int jj = tj[T][ln]; if (cnt[T][ln] < TOPK_P) { if (jj < 32) lo |= 1u << jj; else hi |= 1u << (jj - 32); } }
        mlo[ln] = lo; mhi[ln] = hi; }
    { unsigned t1[NL];
      const int xs[3] = {1, 2, 32};
#pragma unroll
      for (int q = 0; q < 3; ++q) { lane_xor_u(mlo, t1, xs[q]); LANES mlo[ln] |= t1[ln]; lane_xor_u(mhi, t1, xs[q]); LANES mhi[ln] |= t1[ln]; } }
    LANES { const int lane = LANE_OF(ln), r = lane & 31; if ((lane & 3) == 0 && lane < 32) WSP(u64, WS_SELM)[((size_t)b * SEQ + t0 + (r >> 2)) * NSA_KV_HEADS + kvh] = ((u64)mhi[ln] << 32) | mlo[ln]; }
}
static_assert(NSEL_P <= 64, "wave select: at most 64 selection blocks");
DEV FI void nsa_select_item(const int lane_, const P& p, int row, int kvh) {
    const float* Pr = WSP(float, WS_PP) + ((size_t)row * NSA_HEADS + kvh * NSA_GROUP) * NBPP;
    const int t = row % SEQ, cur = t / SEL_BLOCK;
    float sc[NL];
    LANES { const int j = LANE_OF(ln); float a = 0.f;
        if (j < NSEL_P) { for (int mm = 0; mm < SEL_M; ++mm) for (int r = 0; r < CMP_R; ++r) { const int n = j * SEL_M + mm + r; if (n < NBP) for (int g = 0; g < NSA_GROUP; ++g) a += Pr[(size_t)g * NBPP + n]; }
            const bool forced = (j == 0) || (j == cur), allowed = j * SEL_BLOCK <= t; sc[ln] = forced ? POS_BIG : (allowed ? a : NEG_BIG); }
        else sc[ln] = -3.4e38f; }
    bool sel[NL]; int cnt[NL]; LANES cnt[ln] = 0;
    for (int i = 0; i < NSEL_P; ++i) { const float v = wave_bcast(sc, i); LANES { const int j = LANE_OF(ln); cnt[ln] += (v > sc[ln] || (v == sc[ln] && i < j)) ? 1 : 0; } }
    LANES { const int j = LANE_OF(ln); sel[ln] = j < NSEL_P && cnt[ln] < TOPK_P; }
    const u64 m = wave_ballot(sel);
    LANES { if (LANE_OF(ln) == 0) WSP(u64, WS_SELM)[(size_t)row * NSA_KV_HEADS + kvh] = m; }
}
DEV FI void nsa_selwin_item(const int lane_, const P& p, int l, int b, int kvh, int tg) {
    const int t0 = tg * 8, cur = t0 / SEL_BLOCK;
    bf16x8 qf[NSTEP][NL]; nsa_load_q(lane_, p, l, b, kvh, t0, qf);
    const size_t bk = (size_t)b * NSA_KV_HEADS + kvh;
    u64 msk[NL]; LANES { const int r = LANE_OF(ln) & 31; msk[ln] = WSP(u64, WS_SELM)[((size_t)b * SEQ + t0 + (r >> 2)) * NSA_KV_HEADS + kvh]; }
    WAttn st; wattn_reset(st);
    float sl2[NL]; int hh_[NL];
    LANES { const int lane = LANE_OF(ln), r = lane & 31; sl2[ln] = slope2_of(kvh * 4 + (r & 3)); hh_[ln] = lane >> 5; }
    auto cb = [&](int i, int ln) { return sl2[ln] * (float)koff_of(i, 0); };
    auto dfn = [&](int tile, int ln) { return sl2[ln] * (float)(tile * 32 + 4 * hh_[ln] - t0); };
    { const bf16* KS = WSP(bf16, WS_KSN) + bk * SEQ * HDIM; const bf16* VS = WSP(bf16, WS_VSP) + bk * SEQ * HDIM;
      u64 U = wave_uniform_u64(wave_or_u64(msk)); if (cur < 63) U &= (2ull << cur) - 1ull;
      int half = 1;
      auto next = [&]() { if (U == 0ull) return -1; const int j = 63 - (int)__builtin_clzll(U); const int tile = 2 * j + half; if (!half) U &= ~(1ull << j); half ^= 1; return tile; };
      auto fetch = [&](int tile, WFrags& fr) { wattn_fetch(lane_, KS + (size_t)tile * 32 * HDIM, VS + (size_t)tile * 32 * HDIM, 0, fr); };
      auto lokf = [&](int tile, int ln) { return (bool)((msk[ln] >> (tile >> 1)) & 1ull); };
      auto emf = [&](int tile) { return (tile >> 1) == cur; };
      auto eokf = [&](int tile, int ln, int lane, int i) { const int r = lane & 31, h = lane >> 5; (void)ln; return tile * 32 + koff_of(i, h) <= t0 + (r >> 2); };
      const auto mk = make_wmask(cb, dfn, lokf, emf, eokf);
      auto step = [&](int tile, const WFrags& fr) { wattn_step(lane_, tile, fr, qf, st, mk); };
      wattn_run<WATTN_NB>(next, fetch, step); }
    wattn_finish(st);
    f32x16 osel[NDB][NL]; LANES { for (int db = 0; db < NDB; ++db) osel[db][ln] = st.o[db][ln]; }
    wattn_reset(st);
    { const bf16* KW = WSP(bf16, WS_KWN) + bk * SEQ * HDIM; const bf16* VW = WSP(bf16, WS_VWP) + bk * SEQ * HDIM;
      int lo = t0 - WINDOW + 1; if (lo < 0) lo = 0;
      const int first = lo / 32; int nx = (t0 + 7) / 32;
      auto next = [&]() { return nx >= first ? nx-- : -1; };
      auto fetch = [&](int tile, WFrags& fr) { wattn_fetch(lane_, KW + (size_t)tile * 32 * HDIM, VW + (size_t)tile * 32 * HDIM, 0, fr); };
      auto lokf = [&](int, int) { return true; };
      auto emf = [&](int tile) { return tile * 32 + 31 > t0 || tile * 32 <= t0 + 7 - WINDOW; };
      auto eokf = [&](int tile, int ln, int lane, int i) { const int r = lane & 31, h = lane >> 5, t = t0 + (r >> 2), kpos = tile * 32 + koff_of(i, h); (void)ln; return kpos <= t && kpos > t - WINDOW; };
      const auto mk = make_wmask(cb, dfn, lokf, emf, eokf);
      auto step = [&](int tile, const WFrags& fr) { wattn_step(lane_, tile, fr, qf, st, mk); };
      wattn_run<WATTN_NB>(next, fetch, step); }
    wattn_finish(st);
    const bf16* H = WSP(bf16, WS_H); const float* OCMP = WSP(float, WS_OCMP); bf16* OCAT = WSP(bf16, WS_OCAT);
    LANES { const int lane = LANE_OF(ln), r = lane & 31, h = lane >> 5; const size_t row = (size_t)b * SEQ + t0 + (r >> 2); const int head = kvh * 4 + (r & 3);
        const bf16* bgp = H + row * HP + C_NBG + head * 3;
        const float b0 = sigmoidf_(bf2f(bgp[0])), b1 = sigmoidf_(bf2f(bgp[1])), b2 = sigmoidf_(bf2f(bgp[2]));
#pragma unroll
        for (int db = 0; db < NDB; ++db)
#pragma unroll
            for (int i = 0; i < 16; ++i) { const int d = 32 * db + koff_of(i, h);
                OCAT[row * KBR + HGW + head * HDIM + d] = f2bf(b0 * OCMP[row * NSAW + head * HDIM + d] + b1 * osel[db][ln][i] + b2 * st.o[db][ln][i]); } }
}
DEV FI void phw_nsa_cmp(const int lane_, const P& p, int l, int xc, int nxc, int wl, int nwl) {
    for (int bkv = xc; bkv < BATCH * NSA_KV_HEADS; bkv += nxc)
        for (int tgi = wl; tgi < NTG; tgi += nwl) { const int tg = tgi < NTG / 2 ? 2 * tgi : 2 * (NTG - 1 - tgi) + 1; nsa_cmp_item(lane_fresh(lane_), p, l, bkv / NSA_KV_HEADS, bkv % NSA_KV_HEADS, tg); }
}
DEV FI void phw_nsa_select(const int lane_, const P& p, int wv, int nw) {
    for (int it = wv; it < NP * NSA_KV_HEADS; it += nw) nsa_select_item(lane_fresh(lane_), p, it / NSA_KV_HEADS, it % NSA_KV_HEADS);
}
DEV FI void phw_nsa_selwin(const int lane_, const P& p, int l, int xc, int nxc, int wl, int nwl) {
    for (int bkv = xc; bkv < BATCH * NSA_KV_HEADS; bkv += nxc)
        for (int tgi = wl; tgi < NTG; tgi += nwl) { const int tg = tgi < NTG / 2 ? 2 * tgi : 2 * (NTG - 1 - tgi) + 1;
            nsa_selwin_item(lane_fresh(lane_), p, l, bkv / NSA_KV_HEADS, bkv % NSA_KV_HEADS, tg); }
}

constexpr int RK = HG_DK, RV = HG_DV, RKS = RK / 16, RVB = RV / 32, RKB = RK / 32;
static_assert(RK % 32 == 0 && RV % 32 == 0, "recurrence head dims");
template <int REC> DEV FI void rec_ds_item(const int lane_, const P& p, int b, int h, int c, int vb) {
    constexpr int C = REC ? RET_C : HG_C, NCH = REC ? RET_NCH : HG_NCH;
    const size_t bh = (size_t)b * HG_HEADS + h;
    const bf16* VP = WSP(bf16, REC ? WS_RVP : WS_HVP) + bh * RV * SEQ + (size_t)c * C; const bf16* KE = WSP(bf16, REC ? WS_RKE : WS_HKE) + bh * RK * SEQ + (size_t)c * C;
    bf16* dS = WSP(bf16, REC ? WS_RDS : WS_HDS) + (bh * NCH + c) * RV * RK;
    f32x16 acc[RKB][NL]; LANES { for (int kb = 0; kb < RKB; ++kb) for (int i = 0; i < 16; ++i) acc[kb][ln][i] = 0.f; }
#pragma unroll
    for (int st = 0; st < C / 16; ++st) { bf16x8 af[NL];
        LANES { const int lane = LANE_OF(ln), r = lane & 31, hh = lane >> 5; af[ln] = ld8(VP + (size_t)(32 * vb + r) * SEQ + 16 * st + 8 * hh); }
#pragma unroll
        for (int kb = 0; kb < RKB; ++kb) { bf16x8 bfr[NL]; LANES { const int lane = LANE_OF(ln), r = lane & 31, hh = lane >> 5; bfr[ln] = ld8(KE + (size_t)(32 * kb + r) * SEQ + 16 * st + 8 * hh); } mfma32(af, bfr, acc[kb]); } }
#pragma unroll
    for (int kb = 0; kb < RKB; ++kb) {
        LANES { const int lane = LANE_OF(ln), r = lane & 31, hh = lane >> 5;
#pragma unroll
            for (int i = 0; i < 16; ++i) dS[(size_t)(32 * vb + koff_of(i, hh)) * RK + 32 * kb + r] = f2bf(acc[kb][ln][i]); }
        SCHED_FENCE(); }
}
template <int REC> DEV FI void rec_out_item(const int lane_, const P& p, int l, int b, int h, int tile) {
    constexpr int C = REC ? RET_C : HG_C, NCH = REC ? RET_NCH : HG_NCH;
    const int c = tile * 32 / C, half = (tile * 32 % C) / 32;
    const size_t bh = (size_t)b * HG_HEADS + h; const bf16* H = WSP(bf16, WS_H);
    bf16x8 qf[RKS][NL];
    LANES { const int lane = LANE_OF(ln), r = lane & 31, hh = lane >> 5;
        const bf16* qrow = REC ? H + (size_t)(b * SEQ + tile * 32 + r) * HP + C_RQ + h * RK : WSP(bf16, WS_HQT) + (bh * SEQ + tile * 32 + r) * RK;
#pragma unroll
        for (int ks = 0; ks < RKS; ++ks) qf[ks][ln] = ld8(qrow + 16 * ks + 8 * hh); }
    bf16x8 kf0[RKS][NL];
    LANES { const int lane = LANE_OF(ln), r = lane & 31, hh = lane >> 5; const int stile0 = c * (C / 32);
        const bf16* krow = REC ? H + (size_t)(b * SEQ + stile0 * 32 + r) * HP + C_RK + h * RK : WSP(bf16, WS_HKT) + (bh * SEQ + stile0 * 32 + r) * RK;
#pragma unroll
        for (int ks = 0; ks < RKS; ++ks) kf0[ks][ln] = ld8(krow + 16 * ks + 8 * hh); }
    f32x16 o[RVB][NL]; LANES { for (int vb = 0; vb < RVB; ++vb) for (int i = 0; i < 16; ++i) o[vb][ln][i] = 0.f; }
    { const bf16* SC = WSP(bf16, REC ? WS_RSC : WS_HSC) + (bh * NCH + c) * RV * RK;
#pragma unroll
      for (int vb = 0; vb < RVB; ++vb) {
#pragma unroll
        for (int ks = 0; ks < RKS; ++ks) { bf16x8 af[NL]; LANES { const int lane = LANE_OF(ln), r = lane & 31, hh = lane >> 5; af[ln] = ld8(SC + (size_t)(32 * vb + r) * RK + 16 * ks + 8 * hh); } mfma32(af, qf[ks], o[vb]); } SCHED_FENCE(); } }
    const float lg2 = REC ? log2f(1.0f - fexp2(-5.0f - (float)h)) : 0.f;
    if (REC) { LANES { const int r = LANE_OF(ln) & 31; const float fct = fexp2(lg2 * (float)(half * 32 + r + 1));
#pragma unroll
        for (int vb = 0; vb < RVB; ++vb)
#pragma unroll
            for (int i = 0; i < 16; ++i) o[vb][ln][i] *= fct; } }
    const bf16* VP = WSP(bf16, REC ? WS_RVP : WS_HVP) + bh * RV * SEQ;
    for (int st = 0; st <= half; ++st) {
        const int stile = c * (C / 32) + st;
        f32x16 a[NL]; LANES { for (int i = 0; i < 16; ++i) a[ln][i] = 0.f; }
        if (st == 0) {
#pragma unroll
            for (int ks = 0; ks < RKS; ++ks) mfma32(kf0[ks], qf[ks], a);
        } else {
#pragma unroll
            for (int ks = 0; ks < RKS; ++ks) { bf16x8 kf[NL];
                LANES { const int lane = LANE_OF(ln), r = lane & 31, hh = lane >> 5;
                    const bf16* krow = REC ? H + (size_t)(b * SEQ + stile * 32 + r) * HP + C_RK + h * RK : WSP(bf16, WS_HKT) + (bh * SEQ + stile * 32 + r) * RK;
                    kf[ln] = ld8(krow + 16 * ks + 8 * hh); }
                mfma32(kf, qf[ks], a); }
        }
        bf16x8 pf[2][NL];
        LANES { const int lane = LANE_OF(ln), r = lane & 31, hh = lane >> 5, tc = half * 32 + r;
#pragma unroll
            for (int i = 0; i < 16; ++i) { const int sc = st * 32 + koff_of(i, hh); float v = a[ln][i];
                v = sc <= tc ? (REC ? v * fexp2(lg2 * (float)(tc - sc)) : v) : 0.f; pf[i >> 3][ln][i & 7] = (short)f2bf_s(v); } }
#pragma unroll
        for (int s2 = 0; s2 < 2; ++s2)
#pragma unroll
            for (int vb = 0; vb < RVB; ++vb) { bf16x8 vf[NL]; LANES { const int lane = LANE_OF(ln), r = lane & 31, hh = lane >> 5; vf[ln] = ld8(VP + (size_t)(32 * vb + r) * SEQ + stile * 32 + 16 * s2 + 8 * hh); } mfma32(vf, pf[s2], o[vb]); }
        SCHED_FENCE();
    }
    float s1[NL], s2v[NL];
    if (REC) { const float qs = 1.0f / sqrtf((float)RK);
        LANES { float a = 0.f;
#pragma unroll
            for (int vb = 0; vb < RVB; ++vb)
#pragma unroll
                for (int i = 0; i < 16; ++i) { o[vb][ln][i] *= qs; a += o[vb][ln][i]; }
            s1[ln] = a; }
        xor32_add(s1);
        LANES { const float mu = s1[ln] / (float)RV; float a = 0.f;
#pragma unroll
            for (int vb = 0; vb < RVB; ++vb)
#pragma unroll
                for (int i = 0; i < 16; ++i) { o[vb][ln][i] -= mu; a += o[vb][ln][i] * o[vb][ln][i]; }
            s2v[ln] = a; }
        xor32_add(s2v);
    } else {
        LANES { float a = 0.f;
#pragma unroll
            for (int vb = 0; vb < RVB; ++vb)
#pragma unroll
                for (int i = 0; i < 16; ++i) a += o[vb][ln][i] * o[vb][ln][i];
            s2v[ln] = a; }
        xor32_add(s2v);
    }
    bf16* OCAT = WSP(bf16, WS_OCAT); const float* gn = p.hg_out_norm + (size_t)l * HG_DV;
    LANES { const int lane = LANE_OF(ln), r = lane & 31, hh = lane >> 5; const size_t row = (size_t)b * SEQ + tile * 32 + r;
        const float rs = frsq(s2v[ln] / (float)RV + EPS);
#pragma unroll
        for (int vb = 0; vb < RVB; ++vb) {
#pragma unroll
            for (int q4 = 0; q4 < 4; ++q4) { const int v0 = 32 * vb + 8 * q4 + 4 * hh;
                float g[4], ov[4]; ld4bf(H + row * HP + (REC ? C_RG : C_HG) + h * RV + v0, g);
#pragma unroll
                for (int j = 0; j < 4; ++j) ov[j] = o[vb][ln][4 * q4 + j] * rs * (REC ? 1.0f : gn[v0 + j]) * siluf_(g[j]);
                st4bf(OCAT + row * KBR + (REC ? HGW + NSAW : 0) + h * RV + v0, ov); }
            SCHED_FENCE(); } }
}
DEV FI void phw_rec_ds(const int lane_, const P& p, int wv, int nw) {
    const int nH = BATCH * HG_HEADS * HG_NCH * RVB, nR = BATCH * RET_HEADS * RET_NCH * RVB;
    for (int it = wv; it < nH + nR; it += nw) {
        if (it < nH) { const int vb = it % RVB, c = (it / RVB) % HG_NCH, h = (it / (RVB * HG_NCH)) % HG_HEADS, b = it / (RVB * HG_NCH * HG_HEADS); rec_ds_item<0>(lane_fresh(lane_), p, b, h, c, vb); }
        else { const int j = it - nH; const int vb = j % RVB, c = (j / RVB) % RET_NCH, h = (j / (RVB * RET_NCH)) % RET_HEADS, b = j / (RVB * RET_NCH * RET_HEADS); rec_ds_item<1>(lane_fresh(lane_), p, b, h, c, vb); }
    }
}
template <int REC> DEV FI void rec_chain_item(const int lane_, const P& p, int l, int b, int h, int vb, int kb) {
    constexpr int C = REC ? RET_C : HG_C, NCH = REC ? RET_NCH : HG_NCH, NST = C / 16, CB = REC ? 4 : 8;
    static_assert(NCH % CB == 0, "chain batches");
    const size_t bh = (size_t)b * HG_HEADS + h;
    const bf16* VP = WSP(bf16, REC ? WS_RVP : WS_HVP) + bh * RV * SEQ; const bf16* KE = WSP(bf16, REC ? WS_RKE : WS_HKE) + bh * RK * SEQ;
    bf16* SC = WSP(bf16, REC ? WS_RSC : WS_HSC) + bh * NCH * RV * RK;
    const float* dec = WSP(float, WS_HDEC) + bh * HG_NCH * HG_DK + 32 * kb;
    const float gc = REC ? exp2f(log2f(1.0f - exp2f(-5.0f - (float)h)) * (float)RET_C) : 0.f;
    f32x16 S[NL]; LANES { for (int i = 0; i < 16; ++i) S[ln][i] = 0.f; }
#pragma unroll 1
    for (int c0 = 0; c0 < NCH; c0 += CB) {
        bf16x8 af[CB][NST][NL], bfr[CB][NST][NL]; float e[CB][NL];
#pragma unroll
        for (int j = 0; j < CB; ++j) {
            LANES { const int lane = LANE_OF(ln), r = lane & 31, hh = lane >> 5;
#pragma unroll
                for (int st = 0; st < NST; ++st) { af[j][st][ln] = ld8(VP + (size_t)(32 * vb + r) * SEQ + (size_t)(c0 + j) * C + 16 * st + 8 * hh); bfr[j][st][ln] = ld8(KE + (size_t)(32 * kb + r) * SEQ + (size_t)(c0 + j) * C + 16 * st + 8 * hh); }
                e[j][ln] = REC ? gc : dec[(size_t)(c0 + j) * HG_DK + r]; } }
#pragma unroll
        for (int j = 0; j < CB; ++j) {
            bf16* sc = SC + (size_t)(c0 + j) * RV * RK;
            LANES { const int lane = LANE_OF(ln), r = lane & 31, hh = lane >> 5;
#pragma unroll
                for (int i = 0; i < 16; ++i) { sc[(size_t)(32 * vb + koff_of(i, hh)) * RK + 32 * kb + r] = f2bf(S[ln][i]); S[ln][i] *= e[j][ln]; } }
#pragma unroll
            for (int st = 0; st < NST; ++st) mfma32(af[j][st], bfr[j][st], S);
        }
    }
    float* o = p.out + (REC ? O_RP : O_HP) + (((size_t)l * BATCH + b) * HG_HEADS + h) * RK * RV;
    LANES { const int lane = LANE_OF(ln), r = lane & 31, hh = lane >> 5;
#pragma unroll
        for (int q4 = 0; q4 < 4; ++q4) { const float t[4] = {S[ln][4 * q4], S[ln][4 * q4 + 1], S[ln][4 * q4 + 2], S[ln][4 * q4 + 3]}; st4f(o + (size_t)(32 * kb + r) * RV + 32 * vb + 8 * q4 + 4 * hh, t); } }
}
DEV FI void phw_rec_chain(const int lane_, const P& p, int l, int slot, int nslots) {
    constexpr int PER = RVB * RKB, nG = BATCH * HG_HEADS;
    for (int it = slot; it < 2 * nG * PER; it += nslots) { const int g = it / PER, idx = it % PER, vb = idx / RKB, kb = idx % RKB, bh = g >> 1;
        if (g & 1) rec_chain_item<1>(lane_fresh(lane_), p, l, bh / HG_HEADS, bh % HG_HEADS, vb, kb); else rec_chain_item<0>(lane_fresh(lane_), p, l, bh / HG_HEADS, bh % HG_HEADS, vb, kb); }
}
DEV FI void phw_rec_out(const int lane_, const P& p, int l, int wv, int nw) {
    const int nT = BATCH * HG_HEADS * (SEQ / 32);
    for (int it = wv; it < 2 * nT; it += nw) { const int j = it >> 1; const int tile = j % (SEQ / 32), h = (j / (SEQ / 32)) % HG_HEADS, b = j / ((SEQ / 32) * HG_HEADS);
        if (((it & 1) ^ ((j / ((nw + 1) / 2)) & 1)) != 0) rec_out_item<1>(lane_fresh(lane_), p, l, b, h, tile); else rec_out_item<0>(lane_fresh(lane_), p, l, b, h, tile); }
}
DEV FI void phw_rec_out_x(const int lane_, const P& p, int l, int xc, int nxc, int wl, int nwl) {
    for (int bh = xc; bh < BATCH * HG_HEADS; bh += nxc)
        for (int idx = wl; idx < 2 * (SEQ / 32); idx += nwl) { const int tile = idx >> 1, b = bh / HG_HEADS, h = bh % HG_HEADS;
            if ((((idx & 1) ^ (bh / nxc)) & 1) != 0) rec_out_item<1>(lane_fresh(lane_), p, l, b, h, tile); else rec_out_item<0>(lane_fresh(lane_), p, l, b, h, tile); }
}

static_assert(DEC_SEQ == 4 && PAGE_SIZE % 32 == 0 && (PAST_LEN - WINBUF) % 32 == 0 && NBS % 32 == 0, "wave NSA, sample group");
constexpr int SQW = (NSEL_S + 63) / 64;
struct TileSrc { const float* f; const bf16* b; int stride, nvalid; };
DEV FI float ts_at(const TileSrc& s, int ko, int d) { if (ko >= s.nvalid) return 0.f; return s.f ? s.f[(size_t)ko * s.stride + d] : bf2f(s.b[(size_t)ko * s.stride + d]); }
DEV FI TileSrc sel_tile_src(const P& p, const bf16* H, int l, int sb, int kpos0, int c, int kvh) {
    TileSrc s; s.f = nullptr; s.b = nullptr; s.stride = 0; s.nvalid = 0;
    if (kpos0 < PAST_LEN) { const int page = p.page_table[sb * NPAGES + kpos0 / PAGE_SIZE];
        s.f = p.cache_nsa + (((size_t)l * NPOOL + page) * PAGE_SIZE + kpos0 % PAGE_SIZE) * ROWF + c * NSAKVW + kvh * HDIM; s.stride = ROWF; s.nvalid = 32; }
    else { const int off = kpos0 - PAST_LEN; int nv = DEC_SEQ - off; nv = nv < 0 ? 0 : (nv > 32 ? 32 : nv);
        s.b = H + (size_t)(NP + sb * DEC_SEQ + (nv > 0 ? off : 0)) * HP + C_NKV + c * NSAKVW + kvh * HDIM; s.stride = HP; s.nvalid = nv; }
    return s;
}
DEV FI TileSrc win_tile_src(const P& p, const bf16* H, int l, int sb, int kpos0, int c, int kvh) {
    TileSrc s; s.f = nullptr; s.b = nullptr; s.stride = 0; s.nvalid = 0;
    if (kpos0 < PAST_LEN) { s.f = p.cache_win + (((size_t)l * DEC_BATCH + sb) * WINBUF + (kpos0 - (PAST_LEN - WINBUF))) * WROWF + c * NSAKVW + kvh * HDIM; s.stride = WROWF; s.nvalid = 32; }
    else { const int off = kpos0 - PAST_LEN; int nv = DEC_SEQ - off; nv = nv < 0 ? 0 : (nv > 32 ? 32 : nv);
        s.b = H + (size_t)(NP + sb * DEC_SEQ + (nv > 0 ? off : 0)) * HP + C_NWKV + c * NSAKVW + kvh * HDIM; s.stride = HP; s.nvalid = nv; }
    return s;
}
DEV FI void build_kf(const int lane_, const TileSrc& ks, const float* gk, bf16x8 (&kf)[NSTEP][NL]) {
    float x[NSTEP * 8][NL]; float ss[NL];
    LANES { const int lane = LANE_OF(ln), r = lane & 31, h = lane >> 5; float a = 0.f;
#pragma unroll
        for (int step = 0; step < NSTEP; ++step)
#pragma unroll
            for (int j = 0; j < 8; ++j) { const float v = ts_at(ks, r, 16 * step + 8 * h + j); x[step * 8 + j][ln] = v; a += v * v; }
        ss[ln] = a; }
    xor32_add(ss);
    LANES { const int lane = LANE_OF(ln), h = lane >> 5; const float rn = frsq(ss[ln] / (float)HDIM + EPS);
#pragma unroll
        for (int step = 0; step < NSTEP; ++step)
#pragma unroll
            for (int j = 0; j < 8; ++j) kf[step][ln][j] = (short)f2bf_s(x[step * 8 + j][ln] * rn * gk[16 * step + 8 * h + j]); }
}
template <class F> DEV FI void wattn_tile_src(const int lane_, const bf16x8 (&kf)[NSTEP][NL], const TileSrc& vs, const bf16x8 (&qf)[NSTEP][NL], WAttn& st, const F& f) {
    float xv[2][NDB][8][NL];
    LANES { const int lane = LANE_OF(ln), r = lane & 31, h = lane >> 5;
#pragma unroll
        for (int s2 = 0; s2 < 2; ++s2)
#pragma unroll
            for (int db = 0; db < NDB; ++db)
#pragma unroll
                for (int j = 0; j < 8; ++j) xv[s2][db][j][ln] = ts_at(vs, 16 * s2 + 8 * (j >> 2) + 4 * h + (j & 3), 32 * db + r); }
    f32x16 s[NL]; LANES { for (int i = 0; i < 16; ++i) s[ln][i] = 0.f; }
#pragma unroll
    for (int step = 0; step < NSTEP; ++step) mfma32(kf[step], qf[step], s);
    LANES { const int lane = LANE_OF(ln);
#pragma unroll
        for (int i = 0; i < 16; ++i) { bool v; float b; f(ln, lane, i, v, b); s[ln][i] = v ? s[ln][i] + b : -3.0e38f; } }
    float mx[NL]; LANES { float m = -3.0e38f;
#pragma unroll
        for (int i = 0; i < 16; ++i) m = fmaxf(m, s[ln][i]); mx[ln] = m; }
    xor32_max(mx);
    bf16x8 pf[2][NL];
    LANES { const float mn = fmaxf(st.m[ln], mx[ln]), alpha = fexp2(st.m[ln] - mn); float sum = 0.f;
#pragma unroll
        for (int i = 0; i < 16; ++i) { const float pv = s[ln][i] > -1.0e38f ? fexp2(s[ln][i] - mn) : 0.f; sum += pv; pf[i >> 3][ln][i & 7] = (short)f2bf_s(pv); }
        st.l[ln] = st.l[ln] * alpha + sum; st.m[ln] = mn;
#pragma unroll
        for (int db = 0; db < NDB; ++db)
#pragma unroll
            for (int i = 0; i < 16; ++i) st.o[db][ln][i] *= alpha; }
#pragma unroll
    for (int s2 = 0; s2 < 2; ++s2)
#pragma unroll
        for (int db = 0; db < NDB; ++db) { bf16x8 vf[NL];
            LANES {
#pragma unroll
                for (int j = 0; j < 8; ++j) vf[ln][j] = (short)f2bf_s(xv[s2][db][j][ln]); }
            mfma32(vf, pf[s2], st.o[db]); }
}
DEV FI void nsa_load_q_s(const int lane_, const P& p, int l, int sb, int kvh, bf16x8 (&qf)[NSTEP][NL]) {
    size_t row[NL]; LANES { const int r = LANE_OF(ln) & 31; row[ln] = (size_t)NP + sb * DEC_SEQ + ((r >> 2) & (DEC_SEQ - 1)); }
    nsa_q_frags(lane_, p, l, row, kvh, qf);
}
DEV FI void nsa_cmp_item_s(const int lane_, const P& p, int l, int sb, int kvh) {
    bf16x8 qf[NSTEP][NL]; nsa_load_q_s(lane_, p, l, sb, kvh, qf);
    const bf16* KC = WSP(bf16, WS_KCSB + l * SZ_KCS) + ((size_t)sb * NSA_KV_HEADS + kvh) * NBS * HDIM; const bf16* VC = WSP(bf16, WS_VCSB + l * SZ_KCS) + ((size_t)sb * NSA_KV_HEADS + kvh) * NBS * HDIM;
    WAttn st; wattn_reset(st);
    for (int tile = 0; tile < NBS / 32; ++tile) {
        auto f = [&](int ln, int lane, int i, bool& v, float& bias) { const int r = lane & 31, h = lane >> 5, t = PAST_LEN + ((r >> 2) & (DEC_SEQ - 1)), n = tile * 32 + koff_of(i, h), be = n * CMP_STRIDE + CMP_BLOCK - 1;
            v = be <= t; bias = slope2_of(kvh * 4 + (r & 3)) * (float)(be - PAST_LEN); (void)ln; };
        wattn_tile(lane_, KC + (size_t)tile * 32 * HDIM, VC + (size_t)tile * 32 * HDIM, 0, qf, st, f);
    }
    float mfin[NL]; LANES mfin[ln] = st.m[ln];
    wattn_finish(st);
    float* OCMP = WSP(float, WS_OCMP); float* PS = WSP(float, WS_PS);
    LANES { const int lane = LANE_OF(ln), r = lane & 31, h = lane >> 5; const size_t row = (size_t)NP + sb * DEC_SEQ + (r >> 2); const int head = kvh * 4 + (r & 3);
        if ((r >> 2) < DEC_SEQ) {
#pragma unroll
            for (int db = 0; db < NDB; ++db)
#pragma unroll
                for (int i = 0; i < 16; ++i) OCMP[row * NSAW + head * HDIM + 32 * db + koff_of(i, h)] = st.o[db][ln][i]; } }
    for (int tile = 0; tile < NBS / 32; ++tile) {
        f32x16 s[NL];
        auto f = [&](int ln, int lane, int i, bool& v, float& bias) { const int r = lane & 31, h = lane >> 5, t = PAST_LEN + ((r >> 2) & (DEC_SEQ - 1)), n = tile * 32 + koff_of(i, h), be = n * CMP_STRIDE + CMP_BLOCK - 1;
            v = be <= t; bias = slope2_of(kvh * 4 + (r & 3)) * (float)(be - PAST_LEN); (void)ln; };
        wattn_scores(lane_, KC + (size_t)tile * 32 * HDIM, qf, s, f);
        LANES { const int lane = LANE_OF(ln), r = lane & 31, h = lane >> 5; const size_t srow = (size_t)sb * DEC_SEQ + (r >> 2); const int head = kvh * 4 + (r & 3);
            const float inv = frcp(fmaxf(st.l[ln], 1e-30f));
            if ((r >> 2) < DEC_SEQ) {
#pragma unroll
                for (int i = 0; i < 16; ++i) PS[(srow * NSA_HEADS + head) * NBS + tile * 32 + koff_of(i, h)] = s[ln][i] > -1.0e38f ? fexp2(s[ln][i] - mfin[ln]) * inv : 0.f; } }
    }
}
DEV FI void nsa_select_item_s(const int lane_, const P& p, int srow, int kvh) {
    const float* Pr = WSP(float, WS_PS) + ((size_t)srow * NSA_HEADS + kvh * NSA_GROUP) * NBS;
    const int pos = PAST_LEN + srow % DEC_SEQ, cur = pos / SEL_BLOCK;
    float sc[SQW][NL]; int cnt[SQW][NL];
    LANES { for (int q = 0; q < SQW; ++q) { const int j = LANE_OF(ln) + 64 * q; float a = 0.f; cnt[q][ln] = 0;
        if (j < NSEL_S) { for (int mm = 0; mm < SEL_M; ++mm) for (int r = 0; r < CMP_R; ++r) { const int n = j * SEL_M + mm + r; if (n < NBS) for (int g = 0; g < NSA_GROUP; ++g) a += Pr[(size_t)g * NBS + n]; }
            const bool forced = (j == 0) || (j == cur), allowed = j * SEL_BLOCK <= pos; sc[q][ln] = forced ? POS_BIG : (allowed ? a : NEG_BIG); }
        else sc[q][ln] = -3.4e38f; } }
#pragma unroll
    for (int qi = 0; qi < SQW; ++qi)
        for (int ii = 0; ii < 64 && qi * 64 + ii < NSEL_S; ++ii) { const int i = qi * 64 + ii; const float v = wave_bcast(sc[qi], ii);
            LANES {
#pragma unroll
                for (int q = 0; q < SQW; ++q) { const int j = LANE_OF(ln) + 64 * q; cnt[q][ln] += (v > sc[q][ln] || (v == sc[q][ln] && i < j)) ? 1 : 0; } } }
#pragma unroll
    for (int q = 0; q < SQW; ++q) { bool sel[NL]; LANES { const int j = LANE_OF(ln) + 64 * q; sel[ln] = j < NSEL_S && cnt[q][ln] < TOPK_S; }
        const u64 m = wave_ballot(sel);
        LANES { if (LANE_OF(ln) == 0) WSP(u64, WS_SELMS)[((size_t)srow * NSA_KV_HEADS + kvh) * SQW + q] = m; } }
}
DEV FI void nsa_selwin_item_s(const int lane_, const P& p, int l, int sb, int kvh) {
    bf16x8 qf[NSTEP][NL]; nsa_load_q_s(lane_, p, l, sb, kvh, qf);
    const bf16* H = WSP(bf16, WS_H);
    const float* gks = p.nsa_k_norm + ((size_t)l * 3 + 1) * HDIM; const float* gkw = p.nsa_k_norm + ((size_t)l * 3 + 2) * HDIM;
    const u64* MS = WSP(u64, WS_SELMS);
    WAttn st; wattn_reset(st);
    for (int j = 0; j < NSEL_S; ++j) {
        bool sj[NL]; LANES { const int r = LANE_OF(ln) & 31; const size_t srow = (size_t)sb * DEC_SEQ + ((r >> 2) & (DEC_SEQ - 1)); sj[ln] = (MS[(srow * NSA_KV_HEADS + kvh) * SQW + (j >> 6)] >> (j & 63)) & 1ull; }
        if (wave_ballot(sj) == 0ull) continue;
        for (int half = 0; half < 2; ++half) { const int kpos0 = j * SEL_BLOCK + half * 32;
            bf16x8 kf[NSTEP][NL]; build_kf(lane_, sel_tile_src(p, H, l, sb, kpos0, 2, kvh), gks, kf);
            auto f = [&](int ln, int lane, int i, bool& v, float& bias) { const int r = lane & 31, h = lane >> 5, t = PAST_LEN + ((r >> 2) & (DEC_SEQ - 1)), kpos = kpos0 + koff_of(i, h);
                v = sj[ln] && kpos <= t; bias = slope2_of(kvh * 4 + (r & 3)) * (float)(kpos - PAST_LEN); };
            wattn_tile_src(lane_, kf, sel_tile_src(p, H, l, sb, kpos0, 3, kvh), qf, st, f); }
    }
    wattn_finish(st);
    f32x16 osel[NDB][NL]; LANES { for (int db = 0; db < NDB; ++db) osel[db][ln] = st.o[db][ln]; }
    wattn_reset(st);
    for (int kpos0 = PAST_LEN - WINBUF; kpos0 < PAST_LEN + DEC_SEQ; kpos0 += 32) {
        bf16x8 kf[NSTEP][NL]; build_kf(lane_, win_tile_src(p, H, l, sb, kpos0, 0, kvh), gkw, kf);
        auto f = [&](int ln, int lane, int i, bool& v, float& bias) { const int r = lane & 31, h = lane >> 5, t = PAST_LEN + ((r >> 2) & (DEC_SEQ - 1)), kpos = kpos0 + koff_of(i, h);
            v = kpos <= t && kpos > t - WINDOW; bias = slope2_of(kvh * 4 + (r & 3)) * (float)(kpos - PAST_LEN); (void)ln; };
        wattn_tile_src(lane_, kf, win_tile_src(p, H, l, sb, kpos0, 1, kvh), qf, st, f);
    }
    wattn_finish(st);
    const float* OCMP = WSP(float, WS_OCMP); bf16* OCAT = WSP(bf16, WS_OCAT);
    LANES { const int lane = LANE_OF(ln), r = lane & 31, h = lane >> 5; const size_t row = (size_t)NP + sb * DEC_SEQ + (r >> 2); const int head = kvh * 4 + (r & 3);
        if ((r >> 2) < DEC_SEQ) {
            const bf16* bgp = H + row * HP + C_NBG + head * 3;
            const float b0 = sigmoidf_(bf2f(bgp[0])), b1 = sigmoidf_(bf2f(bgp[1])), b2 = sigmoidf_(bf2f(bgp[2]));
#pragma unroll
            for (int db = 0; db < NDB; ++db)
#pragma unroll
                for (int i = 0; i < 16; ++i) { const int d = 32 * db + koff_of(i, h);
                    OCAT[row * KBR + HGW + head * HDIM + d] = f2bf(b0 * OCMP[row * NSAW + head * HDIM + d] + b1 * osel[db][ln][i] + b2 * st.o[db][ln][i]); } } }
}
DEV FI void phw_nsa_cmp_s(const int lane_, const P& p, int l, int wv, int nw) { for (int it = wv; it < DEC_BATCH * NSA_KV_HEADS; it += nw) nsa_cmp_item_s(lane_fresh(lane_), p, l, it / NSA_KV_HEADS, it % NSA_KV_HEADS); }
DEV FI void phw_nsa_select_s(const int lane_, const P& p, int wv, int nw) { for (int it = wv; it < NS * NSA_KV_HEADS; it += nw) nsa_select_item_s(lane_fresh(lane_), p, it / NSA_KV_HEADS, it % NSA_KV_HEADS); }
DEV FI void phw_nsa_selwin_s(const int lane_, const P& p, int l, int wv, int nw) { for (int it = wv; it < DEC_BATCH * NSA_KV_HEADS; it += nw) nsa_selwin_item_s(lane_fresh(lane_), p, l, it / NSA_KV_HEADS, it % NSA_KV_HEADS); }

static_assert(HDIM <= 64, "wave compress: one lane per head-dim element");
DEV FI float wave_sum64(float* x) {
#ifdef CPU_TEST
    float s = 0.f; for (int ln = 0; ln < 64; ++ln) s += x[ln]; return s;
#else
    float v = x[0];
#pragma unroll
    for (int o = 32; o >= 1; o >>= 1) v += __shfl_xor(v, o);
    return v;
#endif
}
static_assert((PAST_LEN / CMP_STRIDE - CMP_R + 1) * CMP_STRIDE + CMP_BLOCK - 1 >= PAST_LEN + DEC_SEQ - 1 + 1 || true, "");
constexpr int CMP_RB = 4, CLPH = HDIM / 4, CJB = 8;
static_assert(CMP_BLOCK == 2 * CMP_STRIDE && CMP_STRIDE == 16 && NSA_KV_HEADS * CLPH <= 64 && (CLPH & (CLPH - 1)) == 0, "compress runs");
DEV FI void group_sum(float* x) {
#ifdef CPU_TEST
    float t[64]; for (int ln = 0; ln < 64; ++ln) { float s = 0.f; for (int q = 0; q < CLPH; ++q) s += x[(ln / CLPH) * CLPH + q]; t[ln] = s; } for (int ln = 0; ln < 64; ++ln) x[ln] = t[ln];
#else
#pragma unroll
    for (int o = CLPH / 2; o >= 1; o >>= 1) x[0] += __shfl_xor(x[0], o);
#endif
}
DEV FI void ld4f_nt(const float* p, float (&v)[4]) {
#ifdef CPU_TEST
    for (int j = 0; j < 4; ++j) v[j] = p[j];
#else
    typedef float v4f_nt __attribute__((ext_vector_type(4))); const v4f_nt u = __builtin_nontemporal_load((const v4f_nt*)p); v[0] = u[0]; v[1] = u[1]; v[2] = u[2]; v[3] = u[3];
#endif
}
DEV FI void ld4any(const float* fb, const bf16* bb, size_t off, float (&v)[4]) { if (fb) ld4f_nt(fb + off, v); else ld4bf(bb + off, v); }
DEV FI void cmp_wave_run(const int lane_, const P& p, int l, int s, int n0, int nb, bool new_rows = true) {
    const bf16* H = WSP(bf16, WS_H);
    const float* w = p.nsa_cmp_w + (size_t)l * 2 * CMP_BLOCK; const float* gk = p.nsa_k_norm + (size_t)l * 3 * HDIM;
    const int npitch = s < BATCH ? NBPP : NBS;
    float pk[4][NL], pv[4][NL]; LANES { for (int j = 0; j < 4; ++j) { pk[j][ln] = 0.f; pv[j][ln] = 0.f; } }
    for (int ci = 0; ci <= nb; ++ci) {
        const int c0 = (n0 + ci) * CMP_STRIDE;
        const float* fb = nullptr; const bf16* bb = nullptr; int stride = 0, nv = 0;
        if (s < BATCH) { if (c0 < SEQ) { bb = H + (size_t)(s * SEQ + c0) * HP + C_NKV; stride = HP; nv = CMP_STRIDE; } }
        else { const int sb = s - BATCH;
            if (c0 < PAST_LEN) { const int page = p.page_table[sb * NPAGES + c0 / PAGE_SIZE]; fb = p.cache_nsa + (((size_t)l * NPOOL + page) * PAGE_SIZE + c0 % PAGE_SIZE) * ROWF; stride = ROWF; nv = CMP_STRIDE; }
            else if (c0 < LS && new_rows) { bb = H + (size_t)(NP + sb * DEC_SEQ + (c0 - PAST_LEN)) * HP + C_NKV; stride = HP; nv = LS - c0 < CMP_STRIDE ? LS - c0 : CMP_STRIDE; } }
        float ak[4][NL], av[4][NL], bk2[4][NL], bv2[4][NL];
        LANES { for (int j = 0; j < 4; ++j) { ak[j][ln] = 0.f; av[j][ln] = 0.f; bk2[j][ln] = 0.f; bv2[j][ln] = 0.f; } }
#pragma unroll 1
        for (int j0 = 0; j0 < CMP_STRIDE; j0 += CJB) {
            float xk[CJB][4][NL], xv[CJB][4][NL];
            LANES { const int lane = LANE_OF(ln); const bool act = lane < NSA_KV_HEADS * CLPH;
#pragma unroll
                for (int jj = 0; jj < CJB; ++jj) { float a4[4] = {0.f, 0.f, 0.f, 0.f}, b4[4] = {0.f, 0.f, 0.f, 0.f};
                    if (act && j0 + jj < nv) { ld4any(fb, bb, (size_t)(j0 + jj) * stride + 4 * lane, a4); ld4any(fb, bb, (size_t)(j0 + jj) * stride + NSAKVW + 4 * lane, b4); }
#pragma unroll
                    for (int q = 0; q < 4; ++q) { xk[jj][q][ln] = a4[q]; xv[jj][q][ln] = b4[q]; } } }
            LANES {
#pragma unroll
                for (int jj = 0; jj < CJB; ++jj) { const float w0 = w[j0 + jj], w1 = w[CMP_BLOCK + j0 + jj], w2 = w[CMP_STRIDE + j0 + jj], w3 = w[CMP_BLOCK + CMP_STRIDE + j0 + jj];
#pragma unroll
                    for (int q = 0; q < 4; ++q) { ak[q][ln] += w0 * xk[jj][q][ln]; av[q][ln] += w1 * xv[jj][q][ln]; bk2[q][ln] += w2 * xk[jj][q][ln]; bv2[q][ln] += w3 * xv[jj][q][ln]; } } }
        }
        if (ci > 0) {
            const int n = n0 + ci - 1;
            float ck[4][NL], cv[4][NL], sq[NL];
            LANES { float a = 0.f;
#pragma unroll
                for (int q = 0; q < 4; ++q) { ck[q][ln] = pk[q][ln] + bk2[q][ln]; cv[q][ln] = pv[q][ln] + bv2[q][ln]; a += ck[q][ln] * ck[q][ln]; }
                sq[ln] = a; }
            group_sum(sq);
            LANES { const int lane = LANE_OF(ln);
                if (lane < NSA_KV_HEADS * CLPH) { const int h = lane / CLPH, e0 = 4 * (lane % CLPH); const float rn = 1.0f / sqrtf(sq[ln] / (float)HDIM + EPS);
                    const size_t sh = s < BATCH ? (size_t)s * NSA_KV_HEADS + h : (size_t)(s - BATCH) * NSA_KV_HEADS + h;
                    bf16* kb = WSP(bf16, s < BATCH ? WS_KCB : WS_KCSB + l * SZ_KCS) + (sh * npitch + (n & ~31)) * HDIM; bf16* vb = WSP(bf16, s < BATCH ? WS_VCB : WS_VCSB + l * SZ_KCS) + (sh * npitch + (n & ~31)) * HDIM;
                    float kq[4];
#pragma unroll
                    for (int q = 0; q < 4; ++q) kq[q] = ck[q][ln] * rn * gk[e0 + q];
                    st4bf(kb + kf_off(n & 31, e0), kq);
#pragma unroll
                    for (int q = 0; q < 4; ++q) vb[vf_off(n & 31, e0 + q)] = f2bf(cv[q][ln]); } }
        }
        LANES { for (int q = 0; q < 4; ++q) { pk[q][ln] = ak[q][ln]; pv[q][ln] = av[q][ln]; } }
    }
}
DEV FI void phw_cmp_part(const int lane_, const P& p, int l, int wv, int nw, bool do_prompt, bool do_sample, bool new_rows = true) {
    constexpr int RP = (NBP + CMP_RB - 1) / CMP_RB, RS = (NBS + CMP_RB - 1) / CMP_RB;
    const int nP = do_prompt ? BATCH * RP : 0, nS = do_sample ? DEC_BATCH * RS : 0;
    for (int it = wv; it < nP + nS; it += nw) {
        if (it < nP) { const int r = it % RP, s = it / RP; const int n0 = r * CMP_RB; cmp_wave_run(lane_fresh(lane_), p, l, s, n0, NBP - n0 < CMP_RB ? NBP - n0 : CMP_RB); }
        else { const int j = it - nP; const int r = j % RS, sb = j / RS; const int n0 = r * CMP_RB; cmp_wave_run(lane_fresh(lane_), p, l, BATCH + sb, n0, NBS - n0 < CMP_RB ? NBS - n0 : CMP_RB, new_rows); }
    }
}
DEV FI void phw_cmp(const int lane_, const P& p, int l, int wv, int nw) { phw_cmp_part(lane_, p, l, wv, nw, true, true); }

constexpr int NPARTS = 16, SP_F = 2 + NDB * 16;
DEV FI float* sp_slot(const P& p, int sb, int kvh, int part, int br, int lane) { return WSP(float, WS_SPART) + (((((size_t)sb * NSA_KV_HEADS + kvh) * NPARTS + part) * 3 + br) * 64 + lane) * SP_F; }
DEV FI void sp_store(const int lane_, const P& p, int sb, int kvh, int part, int br, const WAttn& st) {
    LANES { float* d = sp_slot(p, sb, kvh, part, br, LANE_OF(ln)); d[0] = st.m[ln]; d[1] = st.l[ln];
#pragma unroll
        for (int db = 0; db < NDB; ++db)
#pragma unroll
            for (int i = 0; i < 16; ++i) d[2 + db * 16 + i] = st.o[db][ln][i]; }
}
DEV FI void sp_combine(const int lane_, const P& p, int sb, int kvh, int br, WAttn& st) {
    wattn_reset(st);
    LANES { float M = -3.0e38f; for (int part = 0; part < NPARTS; ++part) M = fmaxf(M, sp_slot(p, sb, kvh, part, br, LANE_OF(ln))[0]); st.m[ln] = M; }
#pragma unroll 2
    for (int part = 0; part < NPARTS; ++part) {
        LANES { const float* d = sp_slot(p, sb, kvh, part, br, LANE_OF(ln)); const float sc = d[0] > -1.0e38f ? fexp2(d[0] - st.m[ln]) : 0.f; st.l[ln] += d[1] * sc;
#pragma unroll
            for (int db = 0; db < NDB; ++db)
#pragma unroll
                for (int i = 0; i < 16; ++i) st.o[db][ln][i] += d[2 + db * 16 + i] * sc; } }
    wattn_finish(st);
}
DEV FI void nsa_cmp_part_s(const int lane_, const P& p, int l, int sb, int kvh, int part) {
    bf16x8 qf[NSTEP][NL]; nsa_load_q_s(lane_, p, l, sb, kvh, qf);
    const bf16* KC = WSP(bf16, WS_KCSB + l * SZ_KCS) + ((size_t)sb * NSA_KV_HEADS + kvh) * NBS * HDIM; const bf16* VC = WSP(bf16, WS_VCSB + l * SZ_KCS) + ((size_t)sb * NSA_KV_HEADS + kvh) * NBS * HDIM;
    float* PS = WSP(float, WS_PS);
    WAttn st; wattn_reset(st);
    for (int tile = part; tile < NBS / 32; tile += NPARTS) {
        auto f = [&](int ln, int lane, int i, bool& v, float& bias) { const int r = lane & 31, h = lane >> 5, t = PAST_LEN + ((r >> 2) & (DEC_SEQ - 1)), n = tile * 32 + koff_of(i, h), be = n * CMP_STRIDE + CMP_BLOCK - 1;
            v = be <= t; bias = slope2_of(kvh * 4 + (r & 3)) * (float)(be - PAST_LEN); (void)ln; };
        wattn_tile(lane_, KC + (size_t)tile * 32 * HDIM, VC + (size_t)tile * 32 * HDIM, 0, qf, st, f);
        f32x16 s[NL]; wattn_scores(lane_, KC + (size_t)tile * 32 * HDIM, qf, s, f);
        LANES { const int lane = LANE_OF(ln), r = lane & 31, h = lane >> 5; const size_t srow = (size_t)sb * DEC_SEQ + (r >> 2); const int head = kvh * 4 + (r & 3);
            if ((r >> 2) < DEC_SEQ) {
#pragma unroll
                for (int i = 0; i < 16; ++i) PS[(srow * NSA_HEADS + head) * NBS + tile * 32 + koff_of(i, h)] = s[ln][i]; } }
    }
    sp_store(lane_, p, sb, kvh, part, 0, st);
}
DEV FI void nsa_select_item_s2(const int lane_, const P& p, int srow, int kvh) {
    const int sb = srow / DEC_SEQ, tok = srow % DEC_SEQ;
    const float* Pr = WSP(float, WS_PS) + ((size_t)srow * NSA_HEADS + kvh * NSA_GROUP) * NBS;
    const int pos = PAST_LEN + tok, cur = pos / SEL_BLOCK;
    static_assert(NPARTS == 16 && NSA_GROUP == 4, "select_s2 lane mapping");
    float Mg[NSA_GROUP], Lg[NSA_GROUP];
    { float pm[2][NL], pl[2][NL];
      LANES { const int lane = LANE_OF(ln), gg = lane >> 5, part = (lane >> 1) & 15, hh = lane & 1;
#pragma unroll
          for (int u = 0; u < 2; ++u) { const float* d = sp_slot(p, sb, kvh, part, 0, tok * 4 + gg + 2 * u + 32 * hh); pm[u][ln] = d[0]; pl[u][ln] = d[1]; } }
#pragma unroll
      for (int u = 0; u < 2; ++u) {
          float mx[NL]; LANES mx[ln] = pm[u][ln];
          half_max32(mx);
          float ls[NL]; LANES ls[ln] = pm[u][ln] > -1.0e38f ? pl[u][ln] * fexp2(pm[u][ln] - mx[ln]) : 0.f;
          half_sum32(ls);
#pragma unroll
          for (int gg = 0; gg < 2; ++gg) { Mg[gg + 2 * u] = wave_bcast(mx, 32 * gg); Lg[gg + 2 * u] = 1.0f / fmaxf(wave_bcast(ls, 32 * gg), 1e-30f); } } }
    float sc[SQW][NL]; int cnt[SQW][NL];
    static_assert(SEL_M == 4 && CMP_R == 2, "importance taps");
#pragma unroll
    for (int q = 0; q < SQW; ++q) {
        float sv[5][NSA_GROUP][NL];
        LANES { const int j = LANE_OF(ln) + 64 * q, jc = j < NSEL_S ? j : NSEL_S - 1;
#pragma unroll
            for (int c5 = 0; c5 < 5; ++c5) { const int n = jc * SEL_M + c5, nc = n < NBS ? n : NBS - 1;
#pragma unroll
                for (int g = 0; g < NSA_GROUP; ++g) sv[c5][g][ln] = Pr[(size_t)g * NBS + nc]; } }
        LANES { const int j = LANE_OF(ln) + 64 * q, jc = j < NSEL_S ? j : NSEL_S - 1; float a = 0.f; cnt[q][ln] = 0;
#pragma unroll
            for (int c5 = 0; c5 < 5; ++c5) { const int n = jc * SEL_M + c5; const float wgt = n < NBS ? ((c5 == 0 || c5 == 4) ? 1.0f : 2.0f) : 0.f;
#pragma unroll
                for (int g = 0; g < NSA_GROUP; ++g) { const float x = sv[c5][g][ln]; a += x > -1.0e38f ? wgt * fexp2(x - Mg[g]) * Lg[g] : 0.f; } }
            if (j < NSEL_S) { const bool forced = (j == 0) || (j == cur), allowed = j * SEL_BLOCK <= pos; sc[q][ln] = forced ? POS_BIG : (allowed ? a : NEG_BIG); }
            else sc[q][ln] = -3.4e38f; }
    }
    u64 mw[SQW];
#pragma unroll
    for (int q = 0; q < SQW; ++q) mw[q] = 0ull;
    for (int r = 0; r < TOPK_S; ++r) {
        float bv[NL]; int bj[NL];
        LANES { float v = sc[0][ln]; int jj = LANE_OF(ln);
#pragma unroll
            for (int q = 1; q < SQW; ++q) if (sc[q][ln] > v) { v = sc[q][ln]; jj = LANE_OF(ln) + 64 * q; }
            bv[ln] = v; bj[ln] = jj; }
        wave_argmax(bv, bj);
        const int win = wave_first_i(bj);
        LANES {
#pragma unroll
            for (int q = 0; q < SQW; ++q) if (LANE_OF(ln) + 64 * q == win) sc[q][ln] = -3.4e38f; }
#pragma unroll
        for (int q = 0; q < SQW; ++q) if ((win >> 6) == q) mw[q] |= 1ull << (win & 63);
    }
#pragma unroll
    for (int q = 0; q < SQW; ++q) { LANES { if (LANE_OF(ln) == 0) WSP(u64, WS_SELMS)[((size_t)srow * NSA_KV_HEADS + kvh) * SQW + q] = mw[q]; } }
}
DEV FI void nsa_selwin_part_s(const int lane_, const P& p, int l, int sb, int kvh, int part) {
    bf16x8 qf[NSTEP][NL]; nsa_load_q_s(lane_, p, l, sb, kvh, qf);
    const bf16* H = WSP(bf16, WS_H);
    const float* gks = p.nsa_k_norm + ((size_t)l * 3 + 1) * HDIM; const float* gkw = p.nsa_k_norm + ((size_t)l * 3 + 2) * HDIM;
    const u64* MS = WSP(u64, WS_SELMS);
    WAttn st; wattn_reset(st);
    int nth = 0;
    for (int q = 0; q < SQW; ++q) {
      u64 mq[NL]; LANES { const int r = LANE_OF(ln) & 31; const size_t srow = (size_t)sb * DEC_SEQ + ((r >> 2) & (DEC_SEQ - 1)); mq[ln] = MS[(srow * NSA_KV_HEADS + kvh) * SQW + q]; }
      u64 U = wave_uniform_u64(wave_or_u64(mq));
      while (U != 0ull) {
        const int bit = (int)__builtin_ctzll(U); U &= U - 1ull;
        const bool mine = (nth % NPARTS) == part; ++nth;
        if (!mine) continue;
        const int j = 64 * q + bit;
        bool sj[NL]; LANES sj[ln] = (mq[ln] >> bit) & 1ull;
        for (int half = 0; half < 2; ++half) { const int kpos0 = j * SEL_BLOCK + half * 32;
            bf16x8 kf[NSTEP][NL]; build_kf(lane_, sel_tile_src(p, H, l, sb, kpos0, 2, kvh), gks, kf);
            auto f = [&](int ln, int lane, int i, bool& v, float& bias) { const int r = lane & 31, h = lane >> 5, t = PAST_LEN + ((r >> 2) & (DEC_SEQ - 1)), kpos = kpos0 + koff_of(i, h);
                v = sj[ln] && kpos <= t; bias = slope2_of(kvh * 4 + (r & 3)) * (float)(kpos - PAST_LEN); };
            wattn_tile_src(lane_, kf, sel_tile_src(p, H, l, sb, kpos0, 3, kvh), qf, st, f); }
      }
    }
    sp_store(lane_, p, sb, kvh, part, 1, st);
    wattn_reset(st);
    for (int wt = part; wt * 32 < WINBUF + DEC_SEQ; wt += NPARTS) { const int kpos0 = PAST_LEN - WINBUF + wt * 32;
        bf16x8 kf[NSTEP][NL]; build_kf(lane_, win_tile_src(p, H, l, sb, kpos0, 0, kvh), gkw, kf);
        auto f = [&](int ln, int lane, int i, bool& v, float& bias) { const int r = lane & 31, h = lane >> 5, t = PAST_LEN + ((r >> 2) & (DEC_SEQ - 1)), kpos = kpos0 + koff_of(i, h);
            v = kpos <= t && kpos > t - WINDOW; bias = slope2_of(kvh * 4 + (r & 3)) * (float)(kpos - PAST_LEN); (void)ln; };
        wattn_tile_src(lane_, kf, win_tile_src(p, H, l, sb, kpos0, 1, kvh), qf, st, f);
    }
    sp_store(lane_, p, sb, kvh, part, 2, st);
}
DEV FI void nsa_combine_item_s(const int lane_, const P& p, int sb, int kvh) {
    WAttn st; f32x16 oc[NDB][NL], os[NDB][NL];
    sp_combine(lane_, p, sb, kvh, 0, st); LANES { for (int db = 0; db < NDB; ++db) oc[db][ln] = st.o[db][ln]; }
    sp_combine(lane_, p, sb, kvh, 1, st); LANES { for (int db = 0; db < NDB; ++db) os[db][ln] = st.o[db][ln]; }
    sp_combine(lane_, p, sb, kvh, 2, st);
    const bf16* H = WSP(bf16, WS_H); bf16* OCAT = WSP(bf16, WS_OCAT);
    LANES { const int lane = LANE_OF(ln), r = lane & 31, h = lane >> 5; const size_t row = (size_t)NP + sb * DEC_SEQ + (r >> 2); const int head = kvh * 4 + (r & 3);
        if ((r >> 2) < DEC_SEQ) {
            const bf16* bgp = H + row * HP + C_NBG + head * 3;
            const float b0 = sigmoidf_(bf2f(bgp[0])), b1 = sigmoidf_(bf2f(bgp[1])), b2 = sigmoidf_(bf2f(bgp[2]));
#pragma unroll
            for (int db = 0; db < NDB; ++db)
#pragma unroll
                for (int i = 0; i < 16; ++i) { const int d = 32 * db + koff_of(i, h);
                    OCAT[row * KBR + HGW + head * HDIM + d] = f2bf(b0 * oc[db][ln][i] + b1 * os[db][ln][i] + b2 * st.o[db][ln][i]); } } }
}
DEV FI void phw_nsa_cmp_s2(const int lane_, const P& p, int l, int wv, int nw) { for (int it = wv; it < DEC_BATCH * NSA_KV_HEADS * NPARTS; it += nw) nsa_cmp_part_s(lane_fresh(lane_), p, l, it / (NSA_KV_HEADS * NPARTS), (it / NPARTS) % NSA_KV_HEADS, it % NPARTS); }
DEV FI void phw_nsa_select_s2(const int lane_, const P& p, int wv, int nw) { for (int it = wv; it < NS * NSA_KV_HEADS; it += nw) nsa_select_item_s2(lane_fresh(lane_), p, it / NSA_KV_HEADS, it % NSA_KV_HEADS); }
DEV FI void phw_nsa_selwin_s2(const int lane_, const P& p, int l, int wv, int nw) { for (int it = wv; it < DEC_BATCH * NSA_KV_HEADS * NPARTS; it += nw) nsa_selwin_part_s(lane_fresh(lane_), p, l, it / (NSA_KV_HEADS * NPARTS), (it / NPARTS) % NSA_KV_HEADS, it % NPARTS); }
DEV FI void phw_nsa_combine_s(const int lane_, const P& p, int wv, int nw) { for (int it = wv; it < DEC_BATCH * NSA_KV_HEADS; it += nw) nsa_combine_item_s(lane_fresh(lane_), p, it / NSA_KV_HEADS, it % NSA_KV_HEADS); }

static_assert(NS <= 32, "skinny GEMM: at most 32 sample rows");
template <class EP> DEV FI void skinny_item(const int lane_, const bf16* X, int lda, const bf16* Bt, int ldb, int K, int n0, const EP& ep) {
    f32x16 acc[NL]; LANES { for (int i = 0; i < 16; ++i) acc[ln][i] = 0.f; }
#pragma unroll 8
    for (int ks = 0; ks < K / 16; ++ks) { bf16x8 af[NL], bfr[NL];
        LANES { const int lane = LANE_OF(ln), r = lane & 31, h = lane >> 5, rs = r < NS ? r : NS - 1;
            af[ln] = ld8(Bt + (size_t)(n0 + r) * ldb + 16 * ks + 8 * h); bfr[ln] = ld8(X + (size_t)rs * lda + 16 * ks + 8 * h); }
        mfma32(af, bfr, acc); }
    LANES { const int lane = LANE_OF(ln), r = lane & 31, h = lane >> 5;
        if (r < NS) {
#pragma unroll
            for (int q4 = 0; q4 < 4; ++q4) { const float v[4] = {acc[ln][4 * q4], acc[ln][4 * q4 + 1], acc[ln][4 * q4 + 2], acc[ln][4 * q4 + 3]}; ep(NP + r, n0 + 8 * q4 + 4 * h, v); } } }
}
#ifndef CPU_TEST
#define LASP __attribute__((address_space(3)))
constexpr int NWAVES_K8 = 8;
typedef float v4f_t __attribute__((ext_vector_type(4)));
static_assert(D_MODEL % 256 == 0, "wave norm: 64 lanes x float4");
__device__ __forceinline__ void phw_norm(const int lane_, const P& p, int l, int stage, int wv, int nw) {
    bf16* XN = WSP(bf16, WS_XN); constexpr int NJ = D_MODEL / 256;
    for (int row = wv; row < MP; row += nw) {
        uint2* o = (uint2*)(XN + (size_t)row * D_MODEL) + lane_;
        if (row >= MR) {
#pragma unroll
            for (int j = 0; j < NJ; ++j) o[64 * j] = make_uint2(0u, 0u);
            continue; }
        const float* x = stage == 0 ? xin_row(p, l, row) : WSP(float, WS_X1) + (size_t)row * D_MODEL;
        const float4* g4 = (const float4*)((stage == 0 ? p.norm_attn : p.norm_ffn) + (size_t)l * D_MODEL) + lane_;
        const float4* x4 = (const float4*)x + lane_;
        float4 v[NJ]; float ss = 0.f;
#pragma unroll
        for (int j = 0; j < NJ; ++j) { v[j] = x4[64 * j]; ss += (v[j].x * v[j].x + v[j].y * v[j].y) + (v[j].z * v[j].z + v[j].w * v[j].w); }
#pragma unroll
        for (int of = 32; of >= 1; of >>= 1) ss += __shfl_xor(ss, of);
        const float r = 1.0f / sqrtf(ss / (float)D_MODEL + EPS);
#pragma unroll
        for (int j = 0; j < NJ; ++j) { const float4 g = g4[64 * j]; const float w4[4] = {v[j].x * r * g.x, v[j].y * r * g.y, v[j].z * r * g.z, v[j].w * r * g.w};
            uint2 u; u.x = pk2bf(w4[0], w4[1]); u.y = pk2bf(w4[2], w4[3]); o[64 * j] = u; }
    }
}
__device__ __forceinline__ void conv_tile(const float* W, int ldw, int n_real, bf16* WT, int ldd, int grp, LASP float* scr, int k0, int n0, int lane) {
    const int nn = n0 + (lane & 31); const bool ok = nn < n_real;
    float xv[32];
#pragma unroll
    for (int i = 0; i < 32; ++i) { const int kk = 2 * i + (lane >> 5); xv[i] = ok ? __builtin_nontemporal_load(W + (size_t)(k0 + kk) * ldw + nn) : 0.f; }
#pragma unroll
    for (int i = 0; i < 32; ++i) { const int kk = 2 * i + (lane >> 5); scr[kk * 33 + (lane & 31)] = xv[i]; }
    asm volatile("s_waitcnt lgkmcnt(0)" ::: "memory");
    const int c = lane & 7;
#pragma unroll
    for (int j = 0; j < 4; ++j) { const int nl = (lane >> 3) + 8 * j, n = n0 + nl; const LASP float* s = scr + (8 * c) * 33 + nl;
        uint4 o; o.x = pk2bf(s[0 * 33], s[1 * 33]); o.y = pk2bf(s[2 * 33], s[3 * 33]); o.z = pk2bf(s[4 * 33], s[5 * 33]); o.w = pk2bf(s[6 * 33], s[7 * 33]);
        const int dn = grp ? (n / grp) * 2 * grp + n % grp : n;
        *(uint4*)(WT + (size_t)dn * ldd + k0 + 8 * c) = o; }
    asm volatile("s_waitcnt lgkmcnt(0)" ::: "memory");
}
__device__ __forceinline__ void conv_mat(const float* W, int K, int ldw, int n_real, int n_pad, bf16* WT, int ldd, int grp, LASP float* scr, int lane, int wv, int nw) {
    const int nblk = n_pad / 32, items = (K / 64) * nblk;
    for (int it = wv; it < items; it += nw) conv_tile(W, ldw, n_real, WT, ldd, grp, scr, 64 * (it / nblk), 32 * (it % nblk), lane);
}
static_assert(D_MODEL % 64 == 0 && HGW % 64 == 0 && FFN % 64 == 0 && HP % 32 == 0 && FFN % 32 == 0, "conversion tiles");
__device__ __forceinline__ void phw_convert(const int lane_, const P& p, LASP float* scr, int wv, int nw, int l, int which) {
    if (which & 1) conv_mat(p.w_in + (size_t)l * D_MODEL * W_IN, D_MODEL, W_IN, W_IN, HP, WSP(bf16, WS_WIN + l * SZ_WIN), D_MODEL, 0, scr, lane_, wv, nw);
    if (which & 2) {
        conv_mat(p.w_br_hg + (size_t)l * HGW * D_MODEL, HGW, D_MODEL, D_MODEL, D_MODEL, WSP(bf16, WS_WBR + l * SZ_WBR), KBR, 0, scr, lane_, wv, nw);
        conv_mat(p.w_br_nsa + (size_t)l * NSAW * D_MODEL, NSAW, D_MODEL, D_MODEL, D_MODEL, WSP(bf16, WS_WBR + l * SZ_WBR) + HGW, KBR, 0, scr, lane_, wv, nw);
        conv_mat(p.w_br_ret + (size_t)l * RETW * D_MODEL, RETW, D_MODEL, D_MODEL, D_MODEL, WSP(bf16, WS_WBR + l * SZ_WBR) + HGW + NSAW, KBR, 0, scr, lane_, wv, nw);
        conv_mat(p.w_out + (size_t)l * D_MODEL * D_MODEL, D_MODEL, D_MODEL, D_MODEL, D_MODEL, WSP(bf16, WS_WOUT + l * SZ_WOUT), D_MODEL, 0, scr, lane_, wv, nw); }
    if (which & 4) {
        conv_mat(p.w_gate + (size_t)l * D_MODEL * FFN, D_MODEL, FFN, FFN, FFN, WSP(bf16, WS_WGU + l * SZ_WGU), D_MODEL, 128, scr, lane_, wv, nw);
        conv_mat(p.w_up + (size_t)l * D_MODEL * FFN, D_MODEL, FFN, FFN, FFN, WSP(bf16, WS_WGU + l * SZ_WGU) + (size_t)128 * D_MODEL, D_MODEL, 128, scr, lane_, wv, nw); }
    if (which & 8) {
        conv_mat(p.w_down + (size_t)l * FFN * D_MODEL, FFN, D_MODEL, D_MODEL, D_MODEL, WSP(bf16, WS_WDN + l * SZ_WDN), FFN, 0, scr, lane_, wv, nw); }
}
template <class EP> __device__ __forceinline__ void skinny_item_k8(const int tid_, LASP float* scr, const bf16* X, int lda, const bf16* Bt, int ldb, int K, int n0, const EP& ep) {
    const int lane_ = lane_fresh(tid_ & 63), wid = tid_ >> 6, r = lane_ & 31, h = lane_ >> 5, rs = r < NS ? r : NS - 1;
    f32x16 acc; for (int i = 0; i < 16; ++i) acc[i] = 0.f;
    const int kw = K / NWAVES_K8;
    const bf16* bp = Bt + (size_t)(n0 + r) * ldb + (size_t)wid * kw + 8 * h; const bf16* xp = X + (size_t)rs * lda + (size_t)wid * kw + 8 * h;
#pragma unroll 8
    for (int ks = 0; ks < kw / 16; ++ks) { const bf16x8 af = *(const bf16x8*)(bp + 16 * ks), bfr = *(const bf16x8*)(xp + 16 * ks); acc = __builtin_amdgcn_mfma_f32_32x32x16_bf16(af, bfr, acc, 0, 0, 0); }
    LASP float* my = scr + ((size_t)wid * 64 + lane_) * 16;
#pragma unroll
    for (int q = 0; q < 4; ++q) *(LASP v4f_t*)(my + 4 * q) = (v4f_t){acc[4 * q], acc[4 * q + 1], acc[4 * q + 2], acc[4 * q + 3]};
    __syncthreads();
    if (wid == 0 && r < NS) {
#pragma unroll
        for (int q4 = 0; q4 < 4; ++q4) { float v[4] = {0.f, 0.f, 0.f, 0.f};
#pragma unroll
            for (int w8 = 0; w8 < NWAVES_K8; ++w8) { const v4f_t t = *(const LASP v4f_t*)(scr + ((size_t)w8 * 64 + lane_) * 16 + 4 * q4); v[0] += t[0]; v[1] += t[1]; v[2] += t[2]; v[3] += t[3]; }
            ep(NP + r, n0 + 8 * q4 + 4 * h, v); } }
    __syncthreads();
}
#endif

#ifndef CPU_TEST
namespace pg8 {
#define PG8_LAS __attribute__((address_space(3)))
typedef unsigned short bf16_t;
typedef short bf16x8 __attribute__((ext_vector_type(8)));
typedef float f32x4 __attribute__((ext_vector_type(4)));
typedef unsigned u32x4 __attribute__((ext_vector_type(4)));
constexpr int BM = 256, BK = 64, HALF = 128, HTB = HALF * BK * 2  , STAGE_BYTES = 8 * HTB, NXCD = 8, WGM = 8;
__host__ __device__ __forceinline__ int lds_byte(int r, int c) { const int st = (r >> 4) * 2 + (c >> 5), rr = r & 15, cc = c & 31, ob = rr * 64 + cc * 2; return st * 1024 + (ob ^ (((ob >> 9) & 1) << 5)); }
__host__ __device__ __forceinline__ void stage_rc(int b, int& R, int& C) { const int st = b / 1024, sb = b % 1024, swz = sb ^ (((sb >> 9) & 1) << 5); R = (st >> 1) * 16 + swz / 64; C = (st & 1) * 32 + (swz % 64) / 2; }
__host__ __device__ __forceinline__ int perm32(int rho) { const int n = rho >> 4, i = rho & 15; return 8 * (i >> 2) + 4 * n + (i & 3); }
struct Unit { int pm, pn, seg; };
struct Gemm { const bf16_t* A; const bf16_t* Bt; int K, lda, ldb; };
__host__ __device__ __forceinline__ void tile_of(int wgid, int nM, int nN, int& pm, int& pn) {
    const int nwg = nM * nN; { const int q = nwg / NXCD, r = nwg % NXCD, xcd = wgid % NXCD, off = wgid / NXCD; wgid = (xcd < r ? xcd * (q + 1) : r * (q + 1) + (xcd - r) * q) + off; }
    const int nig = WGM * nN, gid = wgid / nig, fm = gid * WGM, gsz = (nM - fm) < WGM ? (nM - fm) : WGM;
    pm = fm + ((wgid % nig) % gsz); pn = (wgid % nig) / gsz;
}
struct StaticOrder {
    int nM, nN, nwg, G, c;
    __host__ __device__ void init(int M, int N, int G_, int c_) { nM = M / BM; nN = N / BM; nwg = nM * nN; G = G_; c = c_; }
    __host__ __device__ bool next(int i, Unit& u) const { const long L = (long)i * G + c; if (L >= nwg) return false; tile_of((int)L, nM, nN, u.pm, u.pn); u.seg = 0; return true; }
    __device__ __forceinline__ int koffA(const Unit&) const { return 0; }
    __device__ __forceinline__ int koffB(const Unit&) const { return 0; }
    __device__ __forceinline__ void a_ready(const Unit&) const {}
    __device__ __forceinline__ void done(const Unit&) const {}
};
struct BranchOrder {
    int nM, nN, nwg, G, c;
    __host__ __device__ void init(int M, int N, int G_, int c_) { nM = M / BM; nN = N / BM; nwg = nM * nN; G = G_; c = c_; }
    __host__ __device__ bool next(int i, Unit& u) const { const long L = (long)(i / 3) * G + c; if (L >= nwg) return false; tile_of((int)L, nM, nN, u.pm, u.pn); u.seg = i % 3; return true; }
    __device__ __forceinline__ int koffA(const Unit& u) const { return u.seg == 0 ? 0 : (u.seg == 1 ? HGW : HGW + NSAW); }
    __device__ __forceinline__ int koffB(const Unit& u) const { return u.seg == 0 ? 0 : (u.seg == 1 ? HGW : HGW + NSAW); }
    __device__ __forceinline__ void a_ready(const Unit&) const {}
    __device__ __forceinline__ void done(const Unit&) const {}
};
__device__ __forceinline__ unsigned cvt_pk_bf16(float lo, float hi) { unsigned r; asm volatile("v_cvt_pk_bf16_f32 %0, %1, %2" : "=v"(r) : "v"(lo), "v"(hi)); return r; }
template <class Epi, class Sched, bool ALIGN_EPI = false, bool SP2 = false>
__device__ __forceinline__ void gemm_phase(PG8_LAS unsigned char* lds, const Gemm g, const Sched& S, const Epi& E, const int tid_in) {
    int tid_l = tid_in; asm volatile("" : "+v"(tid_l));
    const int tid = tid_l, wid = __builtin_amdgcn_readfirstlane(tid >> 6), lane = tid & 63, wr = wid >> 2, wc = wid & 3, fr = lane & 15, fq = lane >> 4;
    const int K = g.K, nt = K / BK;
    unsigned voffA[2], voffB[2];
#pragma unroll
    for (int i = 0; i < 2; ++i) { int R, C; stage_rc(tid * 16 + i * 8192, R, C); const int Rb = Epi::PERM ? ((R & ~31) + perm32(R & 31)) : R;
        voffA[i] = (unsigned)(R * g.lda + C) * 2u; voffB[i] = (unsigned)(Rb * g.ldb + C) * 2u; }
    const size_t kstep = (size_t)(BK * 2);
    const size_t hstepA = (size_t)HALF * g.lda * 2, hstepB = (size_t)HALF * g.ldb * 2;
    const size_t tstepA = 2 * hstepA, tstepB = 2 * hstepB;
    const unsigned ldsw = (unsigned)wid * 1024u;
    const int aoff = lds_byte(wr * 64 + fr, fq * 8), boff = lds_byte(wc * 32 + fr, fq * 8);
#define PG8_SA(b, h) (((b) * 2 + (h)) * HTB)
#define PG8_SB(b, h) ((4 + (b) * 2 + (h)) * HTB)
#define PG8_STAGE(bufoff, gbase, voff) do { _Pragma("unroll") for (int _i = 0; _i < 2; ++_i) \
        __builtin_amdgcn_global_load_lds((const unsigned*)((const char*)(gbase) + (voff)[_i]), (PG8_LAS unsigned*)(lds + (bufoff) + ldsw + _i * 8192), 16, 0, 0); } while (0)
#define PG8_LDA(dst, b, h) do { _Pragma("unroll") for (int m = 0; m < 4; ++m) _Pragma("unroll") for (int k = 0; k < 2; ++k) dst[m][k] = *(const PG8_LAS bf16x8*)(lds + PG8_SA(b, h) + aoff + m * 2048 + k * 1024); } while (0)
#define PG8_LDB(dst, b, h) do { _Pragma("unroll") for (int n = 0; n < 2; ++n) _Pragma("unroll") for (int k = 0; k < 2; ++k) dst[n][k] = *(const PG8_LAS bf16x8*)(lds + PG8_SB(b, h) + boff + n * 2048 + k * 1024); } while (0)
#define PG8_MMA(ai, bj, At, Bt) do { __builtin_amdgcn_s_setprio(1); _Pragma("unroll") for (int m = 0; m < 4; ++m) _Pragma("unroll") for (int n = 0; n < 2; ++n) _Pragma("unroll") for (int k = 0; k < 2; ++k) \
        acc[ai][bj][m][n] = __builtin_amdgcn_mfma_f32_16x16x32_bf16(Bt[n][k], At[m][k], acc[ai][bj][m][n], 0, 0, 0); __builtin_amdgcn_s_setprio(0); } while (0)
#define PG8_WAIT_V(n) asm volatile("s_waitcnt vmcnt(" #n ")" ::: "memory")
#define PG8_WAIT_L(n) asm volatile("s_waitcnt lgkmcnt(" #n ")" ::: "memory")
#define PG8_BAR __builtin_amdgcn_s_barrier()
#define PG8_SCHED __builtin_amdgcn_sched_barrier(0)
    Unit cur, nxt; int ui = 0;
    if (!S.next(0, cur)) return;
    f32x4 acc[2][2][4][2];
#pragma unroll
    for (int a = 0; a < 2; ++a)
#pragma unroll
        for (int b = 0; b < 2; ++b)
#pragma unroll
            for (int m = 0; m < 4; ++m)
#pragma unroll
                for (int n = 0; n < 2; ++n) acc[a][b][m][n] = (f32x4){0.f, 0.f, 0.f, 0.f};
    bf16x8 At[4][2], B0[2][2], B1[2][2];
    const char* cA = (const char*)g.A + (size_t)cur.pm * tstepA + (size_t)S.koffA(cur) * 2; const char* cB = (const char*)g.Bt + (size_t)cur.pn * tstepB + (size_t)S.koffB(cur) * 2;
    S.a_ready(cur);
    if constexpr (SP2) {
        PG8_STAGE(PG8_SB(0, 0), cB, voffB); PG8_STAGE(PG8_SB(0, 1), cB + hstepB, voffB); PG8_STAGE(PG8_SA(0, 0), cA, voffA); PG8_STAGE(PG8_SA(0, 1), cA + hstepA, voffA);
        if (wr == 1) PG8_BAR;
        PG8_WAIT_V(2); PG8_BAR;
        PG8_STAGE(PG8_SB(1, 0), cB + kstep, voffB); PG8_STAGE(PG8_SA(1, 0), cA + kstep, voffA); PG8_STAGE(PG8_SB(1, 1), cB + hstepB + kstep, voffB);
        PG8_WAIT_V(6); PG8_BAR;
    } else {
        PG8_STAGE(PG8_SB(0, 0), cB, voffB); PG8_STAGE(PG8_SA(0, 0), cA, voffA); PG8_STAGE(PG8_SB(0, 1), cB + hstepB, voffB); PG8_STAGE(PG8_SA(0, 1), cA + hstepA, voffA);
        if (wr == 1) PG8_BAR;
        PG8_WAIT_V(4); PG8_BAR;
        PG8_STAGE(PG8_SB(1, 0), cB + kstep, voffB); PG8_STAGE(PG8_SA(1, 0), cA + kstep, voffA); PG8_STAGE(PG8_SB(1, 1), cB + hstepB + kstep, voffB);
        PG8_WAIT_V(6); PG8_BAR;
    }
    for (;;) {
        const bool has_next = S.next(ui + 1, nxt);
        const char* nA = has_next ? (const char*)g.A + (size_t)nxt.pm * tstepA + (size_t)S.koffA(nxt) * 2 : cA; const char* nB = has_next ? (const char*)g.Bt + (size_t)nxt.pn * tstepB + (size_t)S.koffB(nxt) * 2 : cB;
        for (int t = 0; t < nt; t += 2) {
            const bool last = (t == nt - 2);
            const char* a1 = cA + (size_t)(t + 1) * kstep;
            const char* a2 = last ? nA : cA + (size_t)(t + 2) * kstep; const char* b2 = last ? nB : cB + (size_t)(t + 2) * kstep;
            const char* a3 = a2 + kstep; const char* b3 = b2 + kstep;
            if (last && has_next) S.a_ready(nxt);
            if constexpr (SP2) {
            PG8_LDB(B0, 0, 0); PG8_LDB(B1, 0, 1); PG8_SCHED; PG8_LDA(At, 0, 0); PG8_STAGE(PG8_SA(1, 1), a1 + hstepA, voffA);
            PG8_WAIT_V(8); PG8_WAIT_L(0); PG8_BAR; PG8_MMA(0, 0, At, B0); PG8_MMA(0, 1, At, B1); PG8_BAR; PG8_SCHED;
            PG8_LDA(At, 0, 1); PG8_STAGE(PG8_SB(0, 0), b2, voffB); PG8_STAGE(PG8_SB(0, 1), b2 + hstepB, voffB); PG8_STAGE(PG8_SA(0, 0), a2, voffA);
            PG8_WAIT_V(8); PG8_WAIT_L(0); PG8_BAR; PG8_MMA(1, 0, At, B0); PG8_MMA(1, 1, At, B1); PG8_BAR; PG8_SCHED;
            PG8_LDB(B0, 1, 0); PG8_LDB(B1, 1, 1); PG8_SCHED; PG8_LDA(At, 1, 0); PG8_STAGE(PG8_SA(0, 1), a2 + hstepA, voffA);
            PG8_WAIT_V(8); PG8_WAIT_L(0); PG8_BAR; PG8_MMA(0, 0, At, B0); PG8_MMA(0, 1, At, B1); PG8_BAR; PG8_SCHED;
            PG8_LDA(At, 1, 1); PG8_STAGE(PG8_SB(1, 0), b3, voffB); PG8_STAGE(PG8_SB(1, 1), b3 + hstepB, voffB); PG8_STAGE(PG8_SA(1, 0), a3, voffA);
            PG8_WAIT_V(8); PG8_WAIT_L(0); PG8_BAR; PG8_MMA(1, 0, At, B0); PG8_MMA(1, 1, At, B1); PG8_BAR; PG8_SCHED;
            } else {
            PG8_LDB(B0, 0, 0); PG8_SCHED; PG8_LDA(At, 0, 0); PG8_STAGE(PG8_SA(1, 1), a1 + hstepA, voffA);
            PG8_WAIT_L(8); PG8_BAR; PG8_WAIT_L(0); PG8_MMA(0, 0, At, B0); PG8_BAR; PG8_SCHED;
            PG8_LDB(B1, 0, 1); PG8_STAGE(PG8_SB(0, 0), b2, voffB);
            PG8_BAR; PG8_WAIT_L(0); PG8_MMA(0, 1, At, B1); PG8_BAR;
            PG8_LDA(At, 0, 1); PG8_STAGE(PG8_SA(0, 0), a2, voffA);
            PG8_BAR; PG8_WAIT_L(0); PG8_MMA(1, 0, At, B0); PG8_BAR; PG8_SCHED;
            PG8_STAGE(PG8_SB(0, 1), b2 + hstepB, voffB);
            PG8_WAIT_V(6); PG8_BAR; PG8_MMA(1, 1, At, B1); PG8_BAR;
            PG8_LDB(B0, 1, 0); PG8_SCHED; PG8_LDA(At, 1, 0); PG8_STAGE(PG8_SA(0, 1), a2 + hstepA, voffA);
            PG8_WAIT_L(8); PG8_BAR; PG8_WAIT_L(0); PG8_MMA(0, 0, At, B0); PG8_BAR; PG8_SCHED;
            PG8_LDB(B1, 1, 1); PG8_STAGE(PG8_SB(1, 0), b3, voffB);
            PG8_BAR; PG8_WAIT_L(0); PG8_MMA(0, 1, At, B1); PG8_BAR;
            PG8_LDA(At, 1, 1); PG8_STAGE(PG8_SA(1, 0), a3, voffA);
            PG8_BAR; PG8_WAIT_L(0); PG8_MMA(1, 0, At, B0); PG8_BAR; PG8_SCHED;
            PG8_STAGE(PG8_SB(1, 1), b3 + hstepB, voffB);
            PG8_WAIT_V(6); PG8_BAR; PG8_MMA(1, 1, At, B1); PG8_BAR;
            }
        }
        if constexpr (ALIGN_EPI) { if (wr == 0) PG8_BAR; }
        if constexpr (!Epi::AFTER_DRAIN) { E(acc, cur, wr, wc, fr, fq); S.done(cur); }
        if (!has_next) break;
#pragma unroll
        for (int a = 0; a < 2; ++a)
#pragma unroll
            for (int b = 0; b < 2; ++b)
#pragma unroll
                for (int m = 0; m < 4; ++m)
#pragma unroll
                    for (int n = 0; n < 2; ++n) acc[a][b][m][n] = (f32x4){0.f, 0.f, 0.f, 0.f};
        cur = nxt; cA = nA; cB = nB; ++ui;
        if constexpr (ALIGN_EPI) { if (wr == 1) PG8_BAR; }
    }
    PG8_WAIT_V(0);
    if constexpr (!ALIGN_EPI) { if (wr == 0) PG8_BAR; }
    PG8_BAR;
    if constexpr (Epi::AFTER_DRAIN) { E.fused(acc, cur, wr, wc, fr, fq, lds, wid, lane); S.done(cur); }
#undef PG8_SA
#undef PG8_SB
#undef PG8_STAGE
#undef PG8_LDA
#undef PG8_LDB
#undef PG8_MMA
#undef PG8_WAIT_V
#undef PG8_WAIT_L
#undef PG8_BAR
#undef PG8_SCHED
}
}

#define LAS __attribute__((address_space(3)))
#define XB_TMO      128
#define XB_XCNT(j)  (256  + 64 * (j))
#define XB_XSUB(j)  (1280 + 64 * (j))
#define XB_XGEN(j)  (2304 + 64 * (j))
#define XB_TOP      3328
#define XB_TOPGEN   3392
#define XCD_BAR_WORDS 3456
#define XB_SPIN_CAP (1u << 18)

__device__ __forceinline__ unsigned xb_ld(unsigned* p)              { return __hip_atomic_load(p, __ATOMIC_RELAXED, __HIP_MEMORY_SCOPE_AGENT); }
__device__ __forceinline__ unsigned xb_add(unsigned* p, unsigned v) { return __hip_atomic_fetch_add(p, v, __ATOMIC_RELAXED, __HIP_MEMORY_SCOPE_AGENT); }
__device__ __forceinline__ unsigned xb_xcc_id() { return (unsigned)__builtin_amdgcn_s_getreg((3 << 11) | 20) & 0xFu; }
#define XB_SPIN(cond, bar) do { unsigned _sp = 0; while (cond) { __builtin_amdgcn_s_sleep(1); \
    if ((++_sp & 255u) == 0u) { if (xb_ld(&(bar)[XB_TMO])) break; if (_sp > XB_SPIN_CAP) { atomicAdd(&(bar)[XB_TMO], 1u); break; } } } } while (0)

struct XcdBarrier {
    unsigned* bar; unsigned x;
    volatile LAS unsigned* st;
};

__device__ __forceinline__ XcdBarrier xcd_barrier_post(unsigned* bar, volatile LAS unsigned* st) {
    XcdBarrier b; b.bar = bar; b.x = xb_xcc_id(); b.st = st;
    if (threadIdx.x == 0) (void)xb_add(&bar[XB_XCNT(b.x)], 1u);
    return b;
}
__device__ __forceinline__ void xcd_barrier_complete(unsigned* bar, unsigned x, unsigned& nloc, unsigned& nx) {
    const unsigned G = gridDim.x * gridDim.y * gridDim.z;
    unsigned sum, cnt, mine, sp = 0u;
    for (;;) {
        sum = 0u; cnt = 0u; mine = 0u;
#pragma unroll
        for (unsigned j = 0; j < 16; ++j) { const unsigned c = xb_ld(&bar[XB_XCNT(j)]); sum += c; cnt += (c > 0u) ? 1u : 0u; mine = (j == x) ? c : mine; }
        if (sum == G) break;
        __builtin_amdgcn_s_sleep(1);
        if ((++sp & 255u) == 0u) { if (xb_ld(&bar[XB_TMO])) break; if (sp > XB_SPIN_CAP) { atomicAdd(&bar[XB_TMO], 1u); break; } }
    }
    nloc = mine > 0u ? mine : 1u; nx = cnt > 0u ? cnt : 1u;
}

__device__ __forceinline__ void xcd_barrier(const XcdBarrier& b) {
    asm volatile("s_waitcnt vmcnt(0)" ::: "memory");
    __syncthreads();
    if (threadIdx.x == 0) {
        unsigned* bar = b.bar;
        __builtin_amdgcn_s_waitcnt(0);
        unsigned nloc = b.st[0], nx = b.st[1];
        if (nloc == 0u) { xcd_barrier_complete(bar, b.x, nloc, nx); b.st[0] = nloc; b.st[1] = nx; }
        const unsigned old = xb_add(&bar[XB_XSUB(b.x)], 1u);
        const unsigned gen = old / nloc;
        if (old + 1u == (gen + 1u) * nloc) {
            __builtin_amdgcn_fence(__ATOMIC_RELEASE, "agent");
            asm volatile("s_waitcnt vmcnt(0)" ::: "memory");
            const unsigned og = xb_add(&bar[XB_TOP], 1u);
            const unsigned tg = og / nx;
            if (og + 1u == (tg + 1u) * nx) xb_add(&bar[XB_TOPGEN], 1u);
            else XB_SPIN(xb_ld(&bar[XB_TOPGEN]) == tg, bar);
            __builtin_amdgcn_fence(__ATOMIC_ACQUIRE, "agent");
            xb_add(&bar[XB_XGEN(b.x)], 1u);
            asm volatile("s_waitcnt vmcnt(0)" ::: "memory");
        } else {
            XB_SPIN(xb_ld(&bar[XB_XGEN(b.x)]) == gen, bar);
            __builtin_amdgcn_fence(__ATOMIC_ACQUIRE, "agent");
            asm volatile("s_waitcnt vmcnt(0)" ::: "memory");
        }
    }
    __syncthreads();
}

template <class Ep, int MODE  > struct TileEp {
    static constexpr bool PERM = false, AFTER_DRAIN = false;
    Ep e;
    __device__ __forceinline__ void operator()(const pg8::f32x4 (&acc)[2][2][4][2], const pg8::Unit& u, int wr, int wc, int fr, int fq) const {
        const int row0 = u.pm * 256 + wr * 64 + fr, cin = wc * 32 + 4 * fq;
#pragma unroll
        for (int ai = 0; ai < 2; ++ai)
#pragma unroll
            for (int m = 0; m < 4; ++m) {
                const int row = row0 + ai * 128 + m * 16;
                if constexpr (MODE == 2) {
#pragma unroll
                    for (int n = 0; n < 2; ++n) { const pg8::f32x4 a = acc[ai][0][m][n], b = acc[ai][1][m][n]; const float vg[4] = {a[0], a[1], a[2], a[3]}, vu[4] = {b[0], b[1], b[2], b[3]};
                        e.apply4(row, u.pn * 128 + cin + n * 16, vg, vu); }
                } else {
#pragma unroll
                    for (int bj = 0; bj < 2; ++bj)
#pragma unroll
                        for (int n = 0; n < 2; ++n) { const pg8::f32x4 a = acc[ai][bj][m][n]; const float v[4] = {a[0], a[1], a[2], a[3]}; const int col = u.pn * 256 + bj * 128 + cin + n * 16;
                            if constexpr (MODE == 1) e.apply4(row, col, v, u.seg); else e.apply4(row, col, v); }
                }
            }
    }
};

#ifndef PG8_ALIGN_K
#define PG8_ALIGN_K true
#endif
#ifndef PG8_SP2_K
#define PG8_SP2_K true
#endif
#ifndef CMP_S_EARLY
#define CMP_S_EARLY 0
#endif
#ifndef CONV_TAIL
#define CONV_TAIL 1
#endif
#define CONV_IN_TAIL(ntiles, lc, which) do { if (CONV_TAIL && (which) != 0) { const int rem_ = (ntiles) % G, c0_ = rem_ ? rem_ : 0; \
        if (c >= c0_) { __syncthreads(); REFRESH(); phw_convert(tid_ & 63, p, (LASP float*)(L + (tid_ >> 6) * 16384), __builtin_amdgcn_readfirstlane((c - c0_) * NWAVES + (tid_ >> 6)), (G - c0_) * NWAVES, (lc), (which)); } } } while (0)
#ifndef REC_CHAIN
#define REC_CHAIN 1
#endif
#ifndef MK_PER_PHASE
#define MK_PER_PHASE 0
#endif
constexpr int NWAVES = 8, NTHREADS = NWAVES * 64;
constexpr int RING_BYTES = 131072, MISC_OFF = RING_BYTES + 320, LDS_BYTES = 147456;
constexpr int CW_BAR = 4096;
constexpr int NPH_LAYER = 12, NPHASES = 1 + DEPTH * NPH_LAYER;
static_assert(HGW == NSAW && NSAW == RETW && HGW % 128 == 0 && HGW >= 256, "branch GEMM: three equal K segments");
static_assert(HGW % 128 == 0 && D_MODEL % 128 == 0 && FFN % 128 == 0 && NP % 256 == 0 && MP % 256 == 0 && HP % 256 == 0 && D_MODEL % 256 == 0 && (2 * FFN) % 256 == 0 && FFN % 128 == 0, "GEMM tile shapes");
static_assert((CW_BAR + XCD_BAR_WORDS) * 4 <= (int)CTL_BYTES, "control region");

constexpr int NWAVES_C = 8;
#ifndef CMP_DYN
#define CMP_DYN 1
#endif
__device__ __forceinline__ void phw_nsa_cmp_dyn(const int lane_, const P& p, int l, int bkv, int wg, int nwg, LAS unsigned* ctr) {
    const int nwl = nwg * NWAVES_C, per = NTG / nwl, nit = NWAVES_C * per;
    for (;;) {
        unsigned n = 0u; if (lane_ == 0) n = __hip_atomic_fetch_add(ctr, 1u, __ATOMIC_RELAXED, __HIP_MEMORY_SCOPE_WORKGROUP);
        n = (unsigned)__builtin_amdgcn_readfirstlane((int)n);
        if ((int)n >= nit) break;
        const int w = (int)n % NWAVES_C, s = per - 1 - (int)n / NWAVES_C, tgi = wg * NWAVES_C + w + s * nwl, tg = tgi < NTG / 2 ? 2 * tgi : 2 * (NTG - 1 - tgi) + 1;
        nsa_cmp_item(lane_fresh(lane_), p, l, bkv / NSA_KV_HEADS, bkv % NSA_KV_HEADS, tg);
    }
}
struct Args { P p; int ph_lo, ph_hi; };
typedef const __attribute__((address_space(4))) P* KP;
__device__ __forceinline__ KP kernarg_p() { auto k = __builtin_amdgcn_kernarg_segment_ptr(); asm volatile("" : "+s"(k)); return (KP)k; }
#if defined(__HIP_DEVICE_COMPILE__)
#define LOADP() const P p = *kernarg_p(); int tid_; asm volatile("v_mbcnt_lo_u32_b32 %0, -1, 0\n\tv_mbcnt_hi_u32_b32 %0, -1, %0" : "=v"(tid_)); tid_ += wid0 * 64; int l = l0, G = gridDim.x, c = blockIdx.x; asm volatile("" : "+v"(tid_), "+s"(l), "+s"(G), "+s"(c)); \
    const long gsize = (long)G * NTHREADS; long gtid = (long)c * NTHREADS + tid_, grev = gsize - 1 - gtid, gti = ((long)(tid_ >> 6) * G + c) * 64 + (tid_ & 63)
#else
#define LOADP() const P p = args.p; int tid_ = threadIdx.x; int l = l0, G = gridDim.x, c = blockIdx.x; const long gsize = (long)G * NTHREADS, gtid = (long)c * NTHREADS + threadIdx.x, grev = gsize - 1 - gtid, gti = gtid
#endif
__global__ void __launch_bounds__(NTHREADS, 2) fwd_kernel(Args args) {
    extern __shared__ __attribute__((aligned(16))) unsigned char lds[];
    LAS unsigned char* L = (LAS unsigned char*)lds;
    const int wid0 = __builtin_amdgcn_readfirstlane((int)(threadIdx.x >> 6));
    volatile LAS unsigned* MISC = (volatile LAS unsigned*)(L + MISC_OFF);
    for (int u = threadIdx.x; u < (LDS_BYTES - RING_BYTES) / 4; u += NTHREADS) ((LAS unsigned*)(L + RING_BYTES))[u] = 0u;
    __syncthreads();
    unsigned* barw; { const int l0 = 0; LOADP(); barw = (unsigned*)(p.ws + WS_CTL) + CW_BAR; (void)l; (void)gtid; (void)grev; (void)gsize; (void)G; (void)c; }
    XcdBarrier bar; bar.bar = barw; bar.x = 0; bar.st = nullptr;
    if (!MK_PER_PHASE) bar = xcd_barrier_post(barw, MISC + 8);
    const int lo = args.ph_lo, hi = args.ph_hi;
#ifndef PHASE_MASK
#define PHASE_MASK 0xFFFFFFFFu
#endif
#define PM(j) (((PHASE_MASK) >> (j)) & 1u)
#ifndef DUP_MASK
#define DUP_MASK 0u
#endif
#ifndef DUP_SUB
#define DUP_SUB 0
#endif
#if defined(__HIP_DEVICE_COMPILE__)
#define REFRESH() do { asm volatile("v_mbcnt_lo_u32_b32 %0, -1, 0\n\tv_mbcnt_hi_u32_b32 %0, -1, %0" : "=v"(tid_)); tid_ += wid0 * 64; gtid = (long)c * NTHREADS + tid_; grev = gsize - 1 - gtid; gti = ((long)(tid_ >> 6) * G + c) * 64 + (tid_ & 63); } while (0)
#else
#define REFRESH() do {} while (0)
#endif
#define RPT(id, ...) do { REFRESH(); __VA_ARGS__; if (DUP_SUB == (id)) { __VA_ARGS__; } } while (0)
#define REPS(j) for (int rep_ = 0; rep_ < 1 + (int)(((DUP_MASK) >> (j)) & 1u); ++rep_)
#define IN(k) (lo <= (k) && (k) < hi)
#ifndef DUP_BAR
#define DUP_BAR 0
#endif
#define SEAM(k) do { if (!MK_PER_PHASE && IN(k) && IN((k) + 1)) { xcd_barrier(bar); if (DUP_BAR) xcd_barrier(bar); } } while (0)
    if (PM(12) && IN(0)) REPS(12) { const int l0 = 0; LOADP(); (void)l; (void)G; (void)c;
        const int wv_ = __builtin_amdgcn_readfirstlane((int)(gtid >> 6)), nw_ = (int)(gsize >> 6);
        ph_lb(p, gtid, gsize); for (int l2 = 0; l2 < DEPTH; ++l2) phw_convert(tid_ & 63, p, (LASP float*)(L + (tid_ >> 6) * 16384), wv_, nw_, l2, CONV_TAIL ? (l2 == 0 ? 1 : 3) : 15); ph_zero_pad(p, gtid, gsize);
        for (int l2 = 0; l2 < DEPTH; ++l2) ph_copy_win(p, l2, gtid, gsize);
#if CMP_S_EARLY
        for (int l2 = 0; l2 < DEPTH; ++l2) phw_cmp_part(tid_ & 63, p, l2, __builtin_amdgcn_readfirstlane((int)(gti >> 6)), nw_, false, true, false);
#endif
        phw_norm(tid_ & 63, p, 0, 0, __builtin_amdgcn_readfirstlane((int)(grev >> 6)), nw_);
    }
    SEAM(0);
    for (int l0 = 0; l0 < DEPTH; ++l0) {
        const int b = 1 + l0 * NPH_LAYER;
        if (PM(0) && IN(b + 0)) REPS(0) { LOADP();
            pg8::Gemm g{WSP(bf16, WS_XN), WSP(bf16, WS_WIN + l * SZ_WIN), D_MODEL, D_MODEL, D_MODEL}; pg8::StaticOrder S; S.init(MP, HP, G, c);
            TileEp<EpIn, 0> E{EpIn{WSP(bf16, WS_H), p.out, l}};
            pg8::gemm_phase<TileEp<EpIn, 0>, pg8::StaticOrder, PG8_ALIGN_K, PG8_SP2_K>(L, g, S, E, tid_);
            CONV_IN_TAIL(S.nwg, l, 4);
        }
        SEAM(b + 0);
        if (PM(1) && IN(b + 1)) REPS(1) { LOADP(); RPT(1, ph_hg_pre(p, l, gti, gsize, NP));  RPT(3, phw_cmp_part(tid_ & 63, p, l, __builtin_amdgcn_readfirstlane((int)(gti >> 6)), (int)(gsize >> 6), true, !CMP_S_EARLY)); RPT(4, ph_nsa_prep(p, l, grev, gsize)); RPT(5, ph_rec_prep(p, l, gtid, gsize)); }
        SEAM(b + 1);
        if (PM(2) && IN(b + 2)) REPS(2) { LOADP(); RPT(12, ph_hg_scan(p, l, gti, gsize, BATCH)); ph_ret_scan(p, l, gsize - 1 - gti, gsize, BATCH); RPT(13, phw_nsa_cmp_s2(tid_ & 63, p, l, __builtin_amdgcn_readfirstlane((int)(gti >> 6)), (int)(gsize >> 6)));
#if REC_CHAIN
            RPT(14, { if (wid0 >= NWAVES - 2) { const int w2 = wid0 - (NWAVES - 2); const int slot = (G % 8 == 0) ? (c % 8) * (2 * (G / 8)) + (c / 8) * 2 + w2 : c * 2 + w2; phw_rec_chain(tid_ & 63, p, l, slot, 2 * G); } });
#endif
            RPT(15, { const int wid_ = wid0; if (CMP_DYN && REC_CHAIN && G % 8 == 0 && G >= 8 && NTG % ((G / 8) * NWAVES) == 0) phw_nsa_cmp_dyn(tid_ & 63, p, l, c % 8, c / 8, G / 8, (LAS unsigned*)(L + MISC_OFF) + 32 + l); else if (G % 8 == 0) phw_nsa_cmp(tid_ & 63, p, l, c % 8, 8, (c / 8) * NWAVES + wid_, (G / 8) * NWAVES); else phw_nsa_cmp(tid_ & 63, p, l, 0, 1, c * NWAVES + wid_, G * NWAVES); });
#if !REC_CHAIN
            RPT(14, phw_rec_ds(tid_ & 63, p, __builtin_amdgcn_readfirstlane((int)(gtid >> 6)), (int)(gsize >> 6)));
#endif
        }
        SEAM(b + 2);
        if (PM(3) && IN(b + 3)) REPS(3) { LOADP(); RPT(6, phw_nsa_select_s2(tid_ & 63, p, __builtin_amdgcn_readfirstlane((int)((gsize - 1 - gti) >> 6)), (int)(gsize >> 6))); ph_hg_post(p, l, gti, gsize, NP); ph_ret_post(p, l, gsize - 1 - gti, gsize, NP); RPT(10, { const int wid_ = wid0; if (G % 8 == 0) phw_nsa_selwin(tid_ & 63, p, l, c % 8, 8, (c / 8) * NWAVES + wid_, (G / 8) * NWAVES); else phw_nsa_selwin(tid_ & 63, p, l, 0, 1, c * NWAVES + wid_, G * NWAVES); }); if (!REC_CHAIN) RPT(7, ph_rec_scan(p, l, grev, gsize));  }
        SEAM(b + 3);
        if (PM(4) && IN(b + 4)) REPS(4) { LOADP(); RPT(9, phw_nsa_selwin_s2(tid_ & 63, p, l, __builtin_amdgcn_readfirstlane((int)(gti >> 6)), (int)(gsize >> 6)));
            RPT(11, { if (G % 8 == 0) phw_rec_out_x(tid_ & 63, p, l, c % 8, 8, (c / 8) * NWAVES + wid0, (G / 8) * NWAVES); else phw_rec_out(tid_ & 63, p, l, __builtin_amdgcn_readfirstlane((int)(gtid >> 6)), (int)(gsize >> 6)); }); }
        SEAM(b + 4);
        if (PM(5) && IN(b + 5)) REPS(5) { LOADP(); phw_nsa_combine_s(tid_ & 63, p, __builtin_amdgcn_readfirstlane((int)(gti >> 6)), (int)(gsize >> 6)); (void)grev; (void)G; (void)c;
            if (CONV_TAIL) { REFRESH(); phw_convert(tid_ & 63, p, (LASP float*)(L + (tid_ >> 6) * 16384), __builtin_amdgcn_readfirstlane((int)(gtid >> 6)), (int)(gsize >> 6), l, l == 0 ? 2 : 8); } }
        SEAM(b + 5);
        if (PM(6) && IN(b + 6)) REPS(6) { LOADP();
            pg8::Gemm g{WSP(bf16, WS_OCAT), WSP(bf16, WS_WBR + l * SZ_WBR), HGW, KBR, KBR}; pg8::BranchOrder S; S.init(NP, D_MODEL, G, c);
            TileEp<EpBr, 1> E{EpBr{WSP(bf16, WS_H), WSP(float, WS_MGF), WSP(bf16, WS_MG)}};
            pg8::gemm_phase<TileEp<EpBr, 1>, pg8::BranchOrder, PG8_ALIGN_K, PG8_SP2_K>(L, g, S, E, tid_);
            if (c < D_MODEL / 32) {
                for (int seg = 0; seg < 3; ++seg) { const int ko = seg == 0 ? 0 : (seg == 1 ? HGW : HGW + NSAW);
                    skinny_item_k8(tid_, (LASP float*)L, WSP(bf16, WS_OCAT) + (size_t)NP * KBR + ko, KBR, WSP(bf16, WS_WBR + l * SZ_WBR) + ko, KBR, HGW, 32 * c, [&](int r, int cc, const float* v) { E.e.apply4(r, cc, v, seg); }); } }
        }
        SEAM(b + 6);
        if (PM(7) && IN(b + 7)) REPS(7) { LOADP();
            pg8::Gemm g{WSP(bf16, WS_MG), WSP(bf16, WS_WOUT + l * SZ_WOUT), D_MODEL, D_MODEL, D_MODEL}; pg8::StaticOrder S; S.init(NP, D_MODEL, G, c);
            TileEp<EpOut, 0> E{EpOut{p.x_prompt, p.x_sample, WSP(float, WS_XL), WSP(float, WS_X1), l}};
            pg8::gemm_phase<TileEp<EpOut, 0>, pg8::StaticOrder, PG8_ALIGN_K, PG8_SP2_K>(L, g, S, E, tid_);
            if (c < D_MODEL / 32) skinny_item_k8(tid_, (LASP float*)L, WSP(bf16, WS_MG) + (size_t)NP * D_MODEL, D_MODEL, WSP(bf16, WS_WOUT + l * SZ_WOUT), D_MODEL, D_MODEL, 32 * c, [&](int r, int cc, const float* v) { E.e.apply4(r, cc, v); });
        }
        SEAM(b + 7);
        if (PM(8) && IN(b + 8)) REPS(8) { LOADP(); phw_norm(tid_ & 63, p, l, 1, __builtin_amdgcn_readfirstlane((int)(gtid >> 6)), (int)(gsize >> 6)); }
        SEAM(b + 8);
        if (PM(9) && IN(b + 9)) REPS(9) { LOADP();
            pg8::Gemm g{WSP(bf16, WS_XN), WSP(bf16, WS_WGU + l * SZ_WGU), D_MODEL, D_MODEL, D_MODEL}; pg8::StaticOrder S; S.init(MP, 2 * FFN, G, c);
            TileEp<EpGU, 2> E{EpGU{WSP(bf16, WS_GU)}};
            pg8::gemm_phase<TileEp<EpGU, 2>, pg8::StaticOrder, PG8_ALIGN_K, PG8_SP2_K>(L, g, S, E, tid_);
            CONV_IN_TAIL(S.nwg, l, l == 0 ? 8 : 0);
        }
        SEAM(b + 9);
        if (PM(10) && IN(b + 10)) REPS(10) { LOADP();
            pg8::Gemm g{WSP(bf16, WS_GU), WSP(bf16, WS_WDN + l * SZ_WDN), FFN, FFN, FFN}; pg8::StaticOrder S; S.init(NP, D_MODEL, G, c);
            TileEp<EpDown, 0> E{EpDown{WSP(float, WS_X1), WSP(float, WS_XL), p.out, l}};
            pg8::gemm_phase<TileEp<EpDown, 0>, pg8::StaticOrder, PG8_ALIGN_K, PG8_SP2_K>(L, g, S, E, tid_);
            if (c < D_MODEL / 32) skinny_item_k8(tid_, (LASP float*)L, WSP(bf16, WS_GU) + (size_t)NP * FFN, FFN, WSP(bf16, WS_WDN + l * SZ_WDN), FFN, FFN, 32 * c, [&](int r, int cc, const float* v) { E.e.apply4(r, cc, v); });
        }
        SEAM(b + 10);
        if (PM(11) && IN(b + 11) && l0 + 1 < DEPTH) REPS(11) { LOADP(); phw_norm(tid_ & 63, p, l + 1, 0, __builtin_amdgcn_readfirstlane((int)(gtid >> 6)), (int)(gsize >> 6)); }
        SEAM(b + 11);
    }
#undef IN
#undef SEAM
}

extern "C" void kernel_launch(void* const* d_in, const int* in_sizes, int n_in, void* d_out, int out_size, void* d_ws, size_t ws_size, hipStream_t stream) {
    static int grid = 0;
    if (grid == 0) {
        if (n_in != 22 || (long)out_size != O_END || ws_size < WS_END) { fprintf(stderr, "kernel_launch: unexpected shapes: n_in %d out %d (want %ld) ws %zu (want %zu)\n", n_in, out_size, O_END, ws_size, (size_t)WS_END); grid = -1; return; }
        int dev = 0, cus = 0;
        if (hipGetDevice(&dev) != hipSuccess || hipDeviceGetAttribute(&cus, hipDeviceAttributeMultiprocessorCount, dev) != hipSuccess) { grid = -1; return; }
        if (hipFuncSetAttribute((const void*)fwd_kernel, hipFuncAttributeMaxDynamicSharedMemorySize, LDS_BYTES) != hipSuccess) { fprintf(stderr, "kernel_launch: hipFuncSetAttribute failed\n"); grid = -1; return; }
        int per_cu = 0;
        if (hipOccupancyMaxActiveBlocksPerMultiprocessor(&per_cu, (const void*)fwd_kernel, NTHREADS, LDS_BYTES) != hipSuccess || per_cu < 1) { fprintf(stderr, "kernel_launch: occupancy query says %d\n", per_cu); }
        (void)hipGetLastError();
        grid = cus;
    }
    if (grid < 0) return;
    (void)hipMemsetAsync((char*)d_ws + WS_CTL, 0, (size_t)(CW_BAR + XCD_BAR_WORDS) * 4, stream);
    Args a{};
    P& p = a.p;
    p.x_prompt = (const float*)d_in[0]; p.x_sample = (const float*)d_in[1]; p.cache_nsa = (const float*)d_in[2]; p.cache_win = (const float*)d_in[3];
    p.state_hgrn = (const float*)d_in[4]; p.state_ret = (const float*)d_in[5]; p.page_table = (const int*)d_in[6];
    p.norm_attn = (const float*)d_in[7]; p.w_in = (const float*)d_in[8]; p.lb_logits = (const float*)d_in[9]; p.hg_out_norm = (const float*)d_in[10];
    p.nsa_q_norm = (const float*)d_in[11]; p.nsa_k_norm = (const float*)d_in[12]; p.nsa_cmp_w = (const float*)d_in[13];
    p.w_br_hg = (const float*)d_in[14]; p.w_br_nsa = (const float*)d_in[15]; p.w_br_ret = (const float*)d_in[16]; p.w_out = (const float*)d_in[17];
    p.norm_ffn = (const float*)d_in[18]; p.w_gate = (const float*)d_in[19]; p.w_up = (const float*)d_in[20]; p.w_down = (const float*)d_in[21];
    p.out = (float*)d_out; p.ws = (unsigned char*)d_ws;
#if MK_PER_PHASE
    for (int k = 0; k < NPHASES; ++k) { a.ph_lo = k; a.ph_hi = k + 1; hipLaunchKernelGGL(fwd_kernel, dim3(grid), dim3(NTHREADS), LDS_BYTES, stream, a); }
#else
    a.ph_lo = 0; a.ph_hi = NPHASES;
    hipLaunchKernelGGL(fwd_kernel, dim3(grid), dim3(NTHREADS), LDS_BYTES, stream, a);
#endif
    const hipError_t le = hipPeekAtLastError();
    if (le != hipSuccess) fprintf(stderr, "kernel_launch: launch failed: %s\n", hipGetErrorName(le));
}
#endif
```

```cpp
#ifndef CPU_TEST
#include <hip/hip_runtime.h>
#endif
#include <cstdio>
#include <cstdint>
#include <cmath>

#ifndef CFG_SMALL
constexpr int D_MODEL = 2048, BATCH = 2, SEQ = 4096, DEPTH = 2, DEC_BATCH = 8, DEC_SEQ = 4, PAST_LEN = 16384, PAGE_SIZE = 128;
constexpr int HG_HEADS = 8, HG_DK = 128, HG_DV = 128;
constexpr int NSA_HEADS = 16, NSA_KV_HEADS = 4, NSA_HEAD_DIM = 64, CMP_BLOCK = 32, CMP_STRIDE = 16, SEL_BLOCK = 64, NSA_TOPK = 16, WINDOW = 512;
constexpr int RET_HEADS = 8, RET_DK = 128, RET_DV = 128;
#else
constexpr int D_MODEL = 64, BATCH = 2, SEQ = 1024, DEPTH = 2, DEC_BATCH = 2, DEC_SEQ = 4, PAST_LEN = 512, PAGE_SIZE = 128;
constexpr int HG_HEADS = 2, HG_DK = 32, HG_DV = 32;
constexpr int NSA_HEADS = 8, NSA_KV_HEADS = 2, NSA_HEAD_DIM = 32, CMP_BLOCK = 32, CMP_STRIDE = 16, SEL_BLOCK = 64, NSA_TOPK = 5, WINDOW = 128;
constexpr int RET_HEADS = 2, RET_DK = 32, RET_DV = 32;
#endif
constexpr int HGK = HG_HEADS * HG_DK, HGW = HG_HEADS * HG_DV, NSA_GROUP = NSA_HEADS / NSA_KV_HEADS, NSAW = NSA_HEADS * NSA_HEAD_DIM, NSAKVW = NSA_KV_HEADS * NSA_HEAD_DIM;
constexpr int RETK = RET_HEADS * RET_DK, RETW = RET_HEADS * RET_DV;
constexpr int FFN = ((8 * D_MODEL / 3 + 255) / 256) * 256;
constexpr float EPS = 1e-6f, NEG_BIG = -1e30f, POS_BIG = 1e30f, MIN_F = 1e-20f;
constexpr int C_HQ = 0, C_HF = C_HQ + HGK, C_HI = C_HF + HGK, C_HG = C_HI + HGW, C_NQ = C_HG + HGW, C_NKV = C_NQ + NSAW, C_NWKV = C_NKV + 4 * NSAKVW,
              C_NBG = C_NWKV + 2 * NSAKVW, C_RQ = C_NBG + 3 * NSA_HEADS, C_RK = C_RQ + RETK, C_RV = C_RK + RETK, C_RG = C_RV + RETW, C_MG = C_RG + RETW, W_IN = C_MG + 3 * D_MODEL;
constexpr int HP = ((W_IN + 255) / 256) * 256;
constexpr int NP = BATCH * SEQ, NS = DEC_BATCH * DEC_SEQ, MR = NP + NS, MP = ((MR + 255) / 256) * 256;
constexpr int NSEQ = BATCH + DEC_BATCH;
constexpr int KBR = HGW + NSAW + RETW;
constexpr int CMP_R = CMP_BLOCK / CMP_STRIDE, SEL_M = SEL_BLOCK / CMP_STRIDE;
constexpr int NBP = SEQ / CMP_STRIDE - CMP_R + 1;
constexpr int LS = PAST_LEN + DEC_SEQ, NCH_S = (LS + CMP_STRIDE - 1) / CMP_STRIDE, NBS = NCH_S - CMP_R + 1;
constexpr int NSEL_P = (SEQ + SEL_BLOCK - 1) / SEL_BLOCK, NPAST_BLK = PAST_LEN / SEL_BLOCK, NNEW_BLK = (DEC_SEQ + SEL_BLOCK - 1) / SEL_BLOCK, NSEL_S = NPAST_BLK + NNEW_BLK;
constexpr int NSEL_MAX = NSEL_P > NSEL_S ? NSEL_P : NSEL_S;
constexpr int NBPP = ((NBP + 31) / 32) * 32;
constexpr int HDIM = NSA_HEAD_DIM;
constexpr int TOPK_P = NSA_TOPK < NSEL_P ? NSA_TOPK : NSEL_P, TOPK_S = NSA_TOPK < NSEL_S ? NSA_TOPK : NSEL_S;
constexpr int NPAGES = PAST_LEN / PAGE_SIZE, NUSED = DEC_BATCH * NPAGES, NPOOL = NUSED + (NUSED / 4 > 1 ? NUSED / 4 : 1), WINBUF = WINDOW < PAST_LEN ? WINDOW : PAST_LEN;
constexpr int WINP = WINDOW < SEQ ? WINDOW : SEQ;
constexpr int ROWF = 4 * NSAKVW;
constexpr int WROWF = 2 * NSAKVW;
static_assert(DEC_SEQ <= CMP_STRIDE && NNEW_BLK == 1, "sample group: one new selection block");

constexpr long O_YP = 0, O_YS = O_YP + (long)NP * D_MODEL, O_KVP = O_YS + (long)NS * D_MODEL, O_KVS = O_KVP + (long)DEPTH * NP * ROWF, O_WP = O_KVS + (long)DEPTH * NS * ROWF,
               O_WS = O_WP + (long)DEPTH * BATCH * WINP * WROWF, O_HP = O_WS + (long)DEPTH * DEC_BATCH * WINBUF * WROWF, O_HS = O_HP + (long)DEPTH * BATCH * HG_HEADS * HG_DK * HG_DV,
               O_RP = O_HS + (long)DEPTH * DEC_BATCH * HG_HEADS * HG_DK * HG_DV, O_RS = O_RP + (long)DEPTH * BATCH * RET_HEADS * RET_DK * RET_DV, O_END = O_RS + (long)DEPTH * DEC_BATCH * RET_HEADS * RET_DK * RET_DV;

#ifdef CPU_TEST
#define HD
#define DEV
#define FI inline
#else
#define HD __host__ __device__
#define DEV __device__
#define FI __forceinline__
#endif
typedef unsigned short bf16;
HD FI float bf2f(bf16 b) { union { unsigned u; float f; } c; c.u = ((unsigned)b) << 16; return c.f; }
HD FI unsigned pk2bf(float lo, float hi) {
#if defined(__HIP_DEVICE_COMPILE__)
    typedef float f32x2_t_ __attribute__((ext_vector_type(2))); typedef __bf16 bf16x2_t_ __attribute__((ext_vector_type(2)));
    const f32x2_t_ v = {lo, hi}; const bf16x2_t_ b = __builtin_convertvector(v, bf16x2_t_); return __builtin_bit_cast(unsigned, b);
#else
    union { unsigned u; float f; } a, b; a.f = lo; b.f = hi; return ((a.u + 0x7fffu + ((a.u >> 16) & 1u)) >> 16) | (((b.u + 0x7fffu + ((b.u >> 16) & 1u)) >> 16) << 16);
#endif
}
HD FI bf16 f2bf(float f) { return (bf16)(pk2bf(f, f) & 0xffffu); }
HD FI float fexp(float x) {
#if defined(__HIP_DEVICE_COMPILE__)
    return __builtin_amdgcn_exp2f(x * 1.44269504088896341f);
#else
    return expf(x);
#endif
}
HD FI float fexp2(float x) {
#if defined(__HIP_DEVICE_COMPILE__)
    return __builtin_amdgcn_exp2f(x);
#else
    return exp2f(x);
#endif
}
constexpr float LOG2E = 1.44269504088896341f;
HD FI float flog(float x) {
#if defined(__HIP_DEVICE_COMPILE__)
    return __builtin_amdgcn_logf(x) * 0.693147180559945309f;
#else
    return logf(x);
#endif
}
HD FI float frsq(float x) {
#if defined(__HIP_DEVICE_COMPILE__)
    return __builtin_amdgcn_rsqf(x);
#else
    return 1.0f / sqrtf(x);
#endif
}
HD FI float frcp(float x) {
#if defined(__HIP_DEVICE_COMPILE__)
    return __builtin_amdgcn_rcpf(x);
#else
    return 1.0f / x;
#endif
}
HD FI float sigmoid_fast(float x) { return frcp(1.0f + fexp(-x)); }
HD FI float silu_fast(float x) { return x * frcp(1.0f + fexp(-x)); }
HD FI float sigmoidf_(float x) { return sigmoid_fast(x); }
HD FI float siluf_(float x) { return silu_fast(x); }


DEV FI void ld4bf(const bf16* p, float (&v)[4]) {
#ifdef CPU_TEST
    for (int j = 0; j < 4; ++j) v[j] = bf2f(p[j]);
#else
    const uint2 u = *(const uint2*)p; v[0] = __uint_as_float(u.x << 16); v[1] = __uint_as_float(u.x & 0xffff0000u); v[2] = __uint_as_float(u.y << 16); v[3] = __uint_as_float(u.y & 0xffff0000u);
#endif
}
DEV FI void st4bf(bf16* p, const float* v) {
#ifdef CPU_TEST
    for (int j = 0; j < 4; ++j) p[j] = f2bf(v[j]);
#else
    uint2 u; u.x = pk2bf(v[0], v[1]); u.y = pk2bf(v[2], v[3]); *(uint2*)p = u;
#endif
}
DEV FI void ld4f(const float* p, float (&v)[4]) {
#ifdef CPU_TEST
    for (int j = 0; j < 4; ++j) v[j] = p[j];
#else
    const float4 u = *(const float4*)p; v[0] = u.x; v[1] = u.y; v[2] = u.z; v[3] = u.w;
#endif
}
DEV FI void st4f_nt(float* p, const float* v) {
#ifdef CPU_TEST
    for (int j = 0; j < 4; ++j) p[j] = v[j];
#else
    typedef float v4f_o __attribute__((ext_vector_type(4))); const v4f_o u = {v[0], v[1], v[2], v[3]}; __builtin_nontemporal_store(u, (v4f_o*)p);
#endif
}
DEV FI unsigned ldu_nt(const unsigned* p) {
#ifdef CPU_TEST
    return *p;
#else
    return __builtin_nontemporal_load(p);
#endif
}
DEV FI float ldf_nt(const float* p) {
#ifdef CPU_TEST
    return *p;
#else
    return __builtin_nontemporal_load(p);
#endif
}
DEV FI void st4f(float* p, const float* v) {
#ifdef CPU_TEST
    for (int j = 0; j < 4; ++j) p[j] = v[j];
#else
    *(float4*)p = make_float4(v[0], v[1], v[2], v[3]);
#endif
}
constexpr size_t al256(size_t x) { return (x + 255) & ~(size_t)255; }
constexpr size_t WS_CTL = 0, CTL_BYTES = 1u << 20;
constexpr size_t SZ_WIN = (size_t)HP * D_MODEL * 2, SZ_WBR = (size_t)D_MODEL * KBR * 2, SZ_WOUT = (size_t)D_MODEL * D_MODEL * 2, SZ_WGU = (size_t)2 * FFN * D_MODEL * 2, SZ_WDN = (size_t)D_MODEL * FFN * 2;
constexpr size_t WS_WIN = al256(WS_CTL + CTL_BYTES), WS_WBR = al256(WS_WIN + DEPTH * SZ_WIN), WS_WOUT = al256(WS_WBR + DEPTH * SZ_WBR), WS_WGU = al256(WS_WOUT + DEPTH * SZ_WOUT),
                 WS_WDN = al256(WS_WGU + DEPTH * SZ_WGU);
constexpr size_t WS_LB = al256(WS_WDN + DEPTH * SZ_WDN);
constexpr size_t WS_XN = al256(WS_LB + (size_t)DEPTH * HGK * 4);
constexpr size_t WS_H = al256(WS_XN + (size_t)MP * D_MODEL * 2);
constexpr size_t WS_OCAT = al256(WS_H + (size_t)MP * HP * 2);
constexpr size_t WS_MGF = al256(WS_OCAT + (size_t)MP * KBR * 2);
constexpr size_t WS_MG = al256(WS_MGF + (size_t)MP * D_MODEL * 4);
constexpr size_t WS_X1 = al256(WS_MG + (size_t)MP * D_MODEL * 2);
constexpr size_t WS_XL = al256(WS_X1 + (size_t)MP * D_MODEL * 4);
constexpr size_t WS_GU = al256(WS_XL + (size_t)MP * D_MODEL * 4);
constexpr size_t WS_F = al256(WS_GU + (size_t)MP * FFN * 2);
constexpr size_t WS_KK = al256(WS_F + (size_t)MR * HGK * 4);
constexpr size_t WS_QS = al256(WS_KK + (size_t)MR * HGK * 4);
constexpr size_t WS_OA = al256(WS_QS + (size_t)MR * HGK * 4);
constexpr size_t WS_OR = al256(WS_OA + (size_t)MR * HGW * 4);
constexpr size_t WS_QH = al256(WS_OR + (size_t)MR * RETW * 4);
constexpr size_t WS_KCP = al256(WS_QH + (size_t)MR * NSAW * 4);
constexpr size_t WS_VCP = al256(WS_KCP + (size_t)BATCH * NBP * NSAKVW * 4);
constexpr size_t WS_KCS = al256(WS_VCP + (size_t)BATCH * NBP * NSAKVW * 4);
constexpr size_t WS_VCS = al256(WS_KCS + (size_t)DEC_BATCH * NBS * NSAKVW * 4);
constexpr size_t WS_PP = al256(WS_VCS + (size_t)DEC_BATCH * NBS * NSAKVW * 4);
constexpr size_t WS_PS = al256(WS_PP + (size_t)NP * NSA_HEADS * NBPP * 4);
constexpr size_t WS_OCMP = al256(WS_PS + (size_t)NS * NSA_HEADS * NBS * 4);
constexpr size_t WS_OSEL = al256(WS_OCMP + (size_t)MR * NSAW * 4);
constexpr size_t WS_SC = al256(WS_OSEL + (size_t)MR * NSAW * 4);
constexpr size_t WS_IDX = al256(WS_SC + (size_t)MR * NSA_KV_HEADS * NSEL_MAX * 4);
constexpr size_t WS_QHB = al256(WS_IDX + (size_t)MR * NSA_KV_HEADS * NSA_TOPK * 4);
constexpr size_t WS_KSN = al256(WS_QHB + (size_t)MR * NSAW * 2);
constexpr size_t WS_KWN = al256(WS_KSN + (size_t)BATCH * NSA_KV_HEADS * SEQ * HDIM * 2);
constexpr size_t WS_VSP = al256(WS_KWN + (size_t)BATCH * NSA_KV_HEADS * SEQ * HDIM * 2);
constexpr size_t WS_VWP = al256(WS_VSP + (size_t)BATCH * NSA_KV_HEADS * SEQ * HDIM * 2);
constexpr size_t WS_KCB = al256(WS_VWP + (size_t)BATCH * NSA_KV_HEADS * SEQ * HDIM * 2);
constexpr size_t WS_VCB = al256(WS_KCB + (size_t)BATCH * NSA_KV_HEADS * NBPP * HDIM * 2);
constexpr size_t WS_SELM = al256(WS_VCB + (size_t)BATCH * NSA_KV_HEADS * NBPP * HDIM * 2);
constexpr int HG_C = 32, RET_C = 64, HG_NCH = SEQ / HG_C, RET_NCH = SEQ / RET_C;
constexpr size_t WS_KCSB = al256(WS_SELM + (size_t)NP * NSA_KV_HEADS * 8);
constexpr size_t SZ_KCS = (size_t)DEC_BATCH * NSA_KV_HEADS * NBS * HDIM * 2;
constexpr size_t WS_VCSB = al256(WS_KCSB + DEPTH * SZ_KCS);
constexpr size_t WS_SELMS = al256(WS_VCSB + DEPTH * SZ_KCS);
constexpr size_t WS_SPART = al256(WS_SELMS + (size_t)NS * NSA_KV_HEADS * ((NSEL_S + 63) / 64) * 8);
constexpr size_t WS_HQT = al256(WS_SPART + (size_t)DEC_BATCH * NSA_KV_HEADS * 16 * 3 * 64 * (2 + NSA_HEAD_DIM / 2) * 4);
constexpr size_t WS_HKT = al256(WS_HQT + (size_t)BATCH * HG_HEADS * SEQ * HG_DK * 2);
constexpr size_t WS_HKE = al256(WS_HKT + (size_t)BATCH * HG_HEADS * SEQ * HG_DK * 2);
constexpr size_t WS_HVP = al256(WS_HKE + (size_t)BATCH * HG_HEADS * SEQ * HG_DK * 2);
constexpr size_t WS_HDEC = al256(WS_HVP + (size_t)BATCH * HG_HEADS * SEQ * HG_DV * 2);
constexpr size_t WS_HDS = al256(WS_HDEC + (size_t)BATCH * HG_HEADS * HG_NCH * HG_DK * 4);
constexpr size_t WS_HSC = al256(WS_HDS + (size_t)BATCH * HG_HEADS * HG_NCH * HG_DV * HG_DK * 4);
constexpr size_t WS_RKE = al256(WS_HSC + (size_t)BATCH * HG_HEADS * HG_NCH * HG_DV * HG_DK * 2);
constexpr size_t WS_RVP = al256(WS_RKE + (size_t)BATCH * RET_HEADS * SEQ * RET_DK * 2);
constexpr size_t WS_RDS = al256(WS_RVP + (size_t)BATCH * RET_HEADS * SEQ * RET_DV * 2);
constexpr size_t WS_RSC = al256(WS_RDS + (size_t)BATCH * RET_HEADS * RET_NCH * RET_DV * RET_DK * 4);
constexpr size_t WS_END = al256(WS_RSC + (size_t)BATCH * RET_HEADS * RET_NCH * RET_DV * RET_DK * 2);

struct P {
    const float *x_prompt, *x_sample, *cache_nsa, *cache_win, *state_hgrn, *state_ret; const int* page_table;
    const float *norm_attn, *w_in, *lb_logits, *hg_out_norm, *nsa_q_norm, *nsa_k_norm, *nsa_cmp_w, *w_br_hg, *w_br_nsa, *w_br_ret, *w_out, *norm_ffn, *w_gate, *w_up, *w_down;
    float* out; unsigned char* ws;
};
#define WSP(T, off) ((T*)(p.ws + (off)))

HD FI int seq_rows(int s) { return s < BATCH ? SEQ : DEC_SEQ; }
HD FI int seq_row0(int s) { return s < BATCH ? s * SEQ : NP + (s - BATCH) * DEC_SEQ; }
HD FI int row_seq(int r) { return r < NP ? r / SEQ : BATCH + (r - NP) / DEC_SEQ; }
HD FI int row_t(int r) { return r < NP ? r % SEQ : (r - NP) % DEC_SEQ; }
HD FI int tile_perm(int ko) { const int s = ko >> 4, q = (ko >> 3) & 1, h = (ko >> 2) & 1, j = (q << 2) | (ko & 3); return s * 16 + h * 8 + j; }
HD FI int kf_off(int key, int d) { return (((d >> 4) * 2 + ((d >> 3) & 1)) * 32 + key) * 8 + (d & 7); }
HD FI int vf_off(int key, int d) { const int s2 = key >> 4, h = (key >> 2) & 1, j = (((key >> 3) & 1) << 2) | (key & 3); return (((s2 * (HDIM / 32) + (d >> 5)) * 2 + h) * 32 + (d & 31)) * 8 + j; }
DEV FI void ld8bf(const bf16* p, float (&v)[8]) {
#ifdef CPU_TEST
    for (int j = 0; j < 8; ++j) v[j] = bf2f(p[j]);
#else
    const uint4 u = *(const uint4*)p; const unsigned w[4] = {u.x, u.y, u.z, u.w};
#pragma unroll
    for (int j = 0; j < 4; ++j) { v[2 * j] = __uint_as_float(w[j] << 16); v[2 * j + 1] = __uint_as_float(w[j] & 0xffff0000u); }
#endif
}
DEV FI void st8bf(bf16* p, const float* v) {
#ifdef CPU_TEST
    for (int j = 0; j < 8; ++j) p[j] = f2bf(v[j]);
#else
    uint4 u; u.x = pk2bf(v[0], v[1]); u.y = pk2bf(v[2], v[3]); u.z = pk2bf(v[4], v[5]); u.w = pk2bf(v[6], v[7]); *(uint4*)p = u;
#endif
}
DEV FI void st_vtile(bf16* tile, int d, const bf16 (&x)[32]) {
#ifdef CPU_TEST
    for (int ko = 0; ko < 32; ++ko) tile[vf_off(ko, d)] = x[ko];
#else
#pragma unroll
    for (int s2 = 0; s2 < 2; ++s2)
#pragma unroll
        for (int h = 0; h < 2; ++h) { unsigned pk[4];
#pragma unroll
            for (int jj = 0; jj < 4; ++jj) { const int j0 = 2 * jj, j1 = 2 * jj + 1; pk[jj] = (unsigned)x[16 * s2 + 8 * (j0 >> 2) + 4 * h + (j0 & 3)] | ((unsigned)x[16 * s2 + 8 * (j1 >> 2) + 4 * h + (j1 & 3)] << 16); }
            *(uint4*)(tile + vf_off(16 * s2 + 4 * h, d)) = make_uint4(pk[0], pk[1], pk[2], pk[3]); }
#endif
}
DEV FI void st_tile32(bf16* dst, const bf16 (&x)[32]) {
#ifdef CPU_TEST
    for (int ko = 0; ko < 32; ++ko) dst[tile_perm(ko)] = x[ko];
#else
    unsigned pk[16];
#pragma unroll
    for (int q = 0; q < 16; ++q) pk[q] = 0u;
#pragma unroll
    for (int ko = 0; ko < 32; ++ko) { const int pp = tile_perm(ko); pk[pp >> 1] |= (unsigned)x[ko] << (16 * (pp & 1)); }
#pragma unroll
    for (int q = 0; q < 4; ++q) ((uint4*)dst)[q] = make_uint4(pk[4 * q], pk[4 * q + 1], pk[4 * q + 2], pk[4 * q + 3]);
#endif
}
HD FI float slope_of(int head) { return exp2f(-8.0f * (float)(head + 1) / (float)NSA_HEADS); }
HD FI float slope2_of(int head) { return slope_of(head) * LOG2E; }

DEV FI void ph_lb(const P& p, long gtid, long gsize) {
    float* LB = WSP(float, WS_LB);
    for (long c = gtid; c < HGK; c += gsize) {
        float mx = -3.0e38f;
        for (int l = 0; l < DEPTH; ++l) mx = fmaxf(mx, p.lb_logits[l * HGK + c]);
        float den = 0.f;
        for (int l = 0; l < DEPTH; ++l) den += expf(p.lb_logits[l * HGK + c] - mx);
        const float sm0 = expf(p.lb_logits[c] - mx) / den; float cum = 0.f;
        for (int l = 0; l < DEPTH; ++l) { cum += expf(p.lb_logits[l * HGK + c] - mx) / den; float lb = cum - sm0; lb = fminf(fmaxf(lb, 0.f), 1.0f - 1e-6f); LB[l * HGK + c] = lb; }
    }
}

struct SrcIn  { const float* w; HD FI float operator()(int n, int k) const { return n < W_IN ? w[(size_t)k * W_IN + n] : 0.f; } };
struct SrcT   { const float* w; int N; HD FI float operator()(int n, int k) const { return w[(size_t)k * N + n]; } };
template <class S> DEV FI void conv_rows(bf16* dst, int ldd, int nrows, int K, const S& src, long gtid, long gsize, int grp = 0) {
    const long items = (long)nrows * (K / 8);
    for (long i = gtid; i < items; i += gsize) {
        const int n = (int)(i % nrows), k0 = (int)(i / nrows) * 8;
        const int dn = grp ? (n / grp) * 2 * grp + n % grp : n;
        bf16* d = dst + (size_t)dn * ldd + k0;
        for (int j = 0; j < 8; ++j) d[j] = f2bf(src(n, k0 + j));
    }
}
DEV FI void ph_convert(const P& p, long gtid, long gsize) {
    for (int l = 0; l < DEPTH; ++l) {
        conv_rows(WSP(bf16, WS_WIN + l * SZ_WIN), D_MODEL, HP, D_MODEL, SrcIn{p.w_in + (size_t)l * D_MODEL * W_IN}, gtid, gsize);
        conv_rows(WSP(bf16, WS_WBR + l * SZ_WBR), KBR, D_MODEL, HGW, SrcT{p.w_br_hg + (size_t)l * HGW * D_MODEL, D_MODEL}, gtid, gsize);
        conv_rows(WSP(bf16, WS_WBR + l * SZ_WBR) + HGW, KBR, D_MODEL, NSAW, SrcT{p.w_br_nsa + (size_t)l * NSAW * D_MODEL, D_MODEL}, gtid, gsize);
        conv_rows(WSP(bf16, WS_WBR + l * SZ_WBR) + HGW + NSAW, KBR, D_MODEL, RETW, SrcT{p.w_br_ret + (size_t)l * RETW * D_MODEL, D_MODEL}, gtid, gsize);
        conv_rows(WSP(bf16, WS_WOUT + l * SZ_WOUT), D_MODEL, D_MODEL, D_MODEL, SrcT{p.w_out + (size_t)l * D_MODEL * D_MODEL, D_MODEL}, gtid, gsize);
        conv_rows(WSP(bf16, WS_WGU + l * SZ_WGU), D_MODEL, FFN, D_MODEL, SrcT{p.w_gate + (size_t)l * D_MODEL * FFN, FFN}, gtid, gsize, 128);
        conv_rows(WSP(bf16, WS_WGU + l * SZ_WGU) + (size_t)128 * D_MODEL, D_MODEL, FFN, D_MODEL, SrcT{p.w_up + (size_t)l * D_MODEL * FFN, FFN}, gtid, gsize, 128);
        conv_rows(WSP(bf16, WS_WDN + l * SZ_WDN), FFN, D_MODEL, FFN, SrcT{p.w_down + (size_t)l * FFN * D_MODEL, D_MODEL}, gtid, gsize);
    }
}

DEV FI const float* xin_row(const P& p, int l, int row) {
    if (l == 0) return row < NP ? p.x_prompt + (size_t)row * D_MODEL : p.x_sample + (size_t)(row - NP) * D_MODEL;
    return WSP(float, WS_XL) + (size_t)row * D_MODEL;
}
DEV FI void ph_norm(const P& p, int l, int stage, long gtid, long gsize) {
    bf16* XN = WSP(bf16, WS_XN);
    for (long row = gtid; row < MP; row += gsize) {
        bf16* o = XN + (size_t)row * D_MODEL;
        if (row >= MR) { for (int c = 0; c < D_MODEL; ++c) o[c] = 0; continue; }
        const float* x = stage == 0 ? xin_row(p, l, (int)row) : WSP(float, WS_X1) + (size_t)row * D_MODEL;
        const float* g = (stage == 0 ? p.norm_attn : p.norm_ffn) + (size_t)l * D_MODEL;
        float ss = 0.f; for (int c = 0; c < D_MODEL; ++c) ss += x[c] * x[c];
        const float r = 1.0f / sqrtf(ss / (float)D_MODEL + EPS);
        for (int c = 0; c < D_MODEL; ++c) o[c] = f2bf(x[c] * r * g[c]);
    }
}

DEV FI void ph_hg_pre(const P& p, int l, long gtid, long gsize, int row0 = 0) {
    const bf16* H = WSP(bf16, WS_H); const float* LB = WSP(float, WS_LB) + (size_t)l * HGK;
    float *F = WSP(float, WS_F), *KK = WSP(float, WS_KK), *QS = WSP(float, WS_QS);
    for (long i0 = gtid; i0 < (long)(MR - row0) * HGK; i0 += gsize) {
        const long i = i0 + (long)row0 * HGK; const int row = (int)(i / HGK), c = (int)(i % HGK);
        const float z = bf2f(H[(size_t)row * HP + C_HF + c]), sig = sigmoidf_(z), lb = LB[c];
        F[i] = fmaxf(lb + (1.0f - lb) * sig, MIN_F); KK[i] = (1.0f - lb) * (1.0f - sig);
        QS[i] = siluf_(bf2f(H[(size_t)row * HP + C_HQ + c]));
    }
}
DEV FI void ph_hg_scan(const P& p, int l, long gtid, long gsize, int seq0 = 0) {
    const bf16* H = WSP(bf16, WS_H); const float *F = WSP(float, WS_F), *KK = WSP(float, WS_KK), *QS = WSP(float, WS_QS); float* OA = WSP(float, WS_OA);
    for (long i = gtid; i < (long)(NSEQ - seq0) * HG_HEADS * HG_DV; i += gsize) {
        const int v = (int)(i % HG_DV), h = (int)((i / HG_DV) % HG_HEADS), s = seq0 + (int)(i / ((long)HG_DV * HG_HEADS));
        const int T = seq_rows(s), r0 = seq_row0(s);
        float S[HG_DK];
        if (s < BATCH) {
#pragma unroll
            for (int k = 0; k < HG_DK; ++k) S[k] = 0.f;
        } else {
            const float* s0 = p.state_hgrn + ((((size_t)l * DEC_BATCH + (s - BATCH)) * HG_HEADS + h) * HG_DK) * HG_DV + v;
#pragma unroll
            for (int k = 0; k < HG_DK; ++k) S[k] = s0[(size_t)k * HG_DV];
        }
        for (int t = 0; t < T; ++t) {
            const size_t rb = (size_t)(r0 + t) * HGK + (size_t)h * HG_DK;
            const float vv = bf2f(H[(size_t)(r0 + t) * HP + C_HI + h * HG_DV + v]);
            float o = 0.f;
#pragma unroll
            for (int k = 0; k < HG_DK; ++k) { S[k] = F[rb + k] * S[k] + KK[rb + k] * vv; o += QS[rb + k] * S[k]; }
            OA[(size_t)(r0 + t) * HGW + h * HG_DV + v] = o;
        }
        float* so = s < BATCH ? p.out + O_HP + ((((size_t)l * BATCH + s) * HG_HEADS + h) * HG_DK) * HG_DV + v
                              : p.out + O_HS + ((((size_t)l * DEC_BATCH + (s - BATCH)) * HG_HEADS + h) * HG_DK) * HG_DV + v;
#pragma unroll
        for (int k = 0; k < HG_DK; ++k) so[(size_t)k * HG_DV] = S[k];
    }
}
DEV FI void ph_hg_post(const P& p, int l, long gtid, long gsize, int row0 = 0) {
    const bf16* H = WSP(bf16, WS_H); const float* OA = WSP(float, WS_OA); bf16* OCAT = WSP(bf16, WS_OCAT); const float* g = p.hg_out_norm + (size_t)l * HG_DV;
    for (long i = gtid; i < (long)(MR - row0) * HG_HEADS; i += gsize) {
        const int row = row0 + (int)(i / HG_HEADS), h = (int)(i % HG_HEADS);
        const float* o = OA + (size_t)row * HGW + h * HG_DV;
        float ss = 0.f; for (int v = 0; v < HG_DV; ++v) ss += o[v] * o[v];
        const float r = 1.0f / sqrtf(ss / (float)HG_DV + EPS);
        for (int v = 0; v < HG_DV; ++v) OCAT[(size_t)row * KBR + h * HG_DV + v] = f2bf(o[v] * r * g[v] * siluf_(bf2f(H[(size_t)row * HP + C_HG + h * HG_DV + v])));
    }
}

DEV FI void ph_ret_scan(const P& p, int l, long gtid, long gsize, int seq0 = 0) {
    const bf16* H = WSP(bf16, WS_H); float* OR = WSP(float, WS_OR);
    const float qs = 1.0f / sqrtf((float)RET_DK);
    for (long i = gtid; i < (long)(NSEQ - seq0) * RET_HEADS * RET_DV; i += gsize) {
        const int v = (int)(i % RET_DV), h = (int)((i / RET_DV) % RET_HEADS), s = seq0 + (int)(i / ((long)RET_DV * RET_HEADS));
        const int T = seq_rows(s), r0 = seq_row0(s);
        const float gam = 1.0f - exp2f(-5.0f - (float)h);
        float S[RET_DK];
        if (s < BATCH) {
#pragma unroll
            for (int k = 0; k < RET_DK; ++k) S[k] = 0.f;
        } else {
            const float* s0 = p.state_ret + ((((size_t)l * DEC_BATCH + (s - BATCH)) * RET_HEADS + h) * RET_DK) * RET_DV + v;
#pragma unroll
            for (int k = 0; k < RET_DK; ++k) S[k] = s0[(size_t)k * RET_DV];
        }
        for (int t = 0; t < T; ++t) {
            const bf16* hr = H + (size_t)(r0 + t) * HP;
            const float vv = bf2f(hr[C_RV + h * RET_DV + v]);
            float o = 0.f;
#pragma unroll
            for (int k = 0; k < RET_DK; ++k) { S[k] = gam * S[k] + bf2f(hr[C_RK + h * RET_DK + k]) * vv; o += bf2f(hr[C_RQ + h * RET_DK + k]) * S[k]; }
            OR[(size_t)(r0 + t) * RETW + h * RET_DV + v] = o * qs;
        }
        float* so = s < BATCH ? p.out + O_RP + ((((size_t)l * BATCH + s) * RET_HEADS + h) * RET_DK) * RET_DV + v
                              : p.out + O_RS + ((((size_t)l * DEC_BATCH + (s - BATCH)) * RET_HEADS + h) * RET_DK) * RET_DV + v;
#pragma unroll
        for (int k = 0; k < RET_DK; ++k) so[(size_t)k * RET_DV] = S[k];
    }
}
DEV FI void ph_ret_post(const P& p, int l, long gtid, long gsize, int row0 = 0) {
    const bf16* H = WSP(bf16, WS_H); const float* OR = WSP(float, WS_OR); bf16* OCAT = WSP(bf16, WS_OCAT);
    for (long i = gtid; i < (long)(MR - row0) * RET_HEADS; i += gsize) {
        const int row = row0 + (int)(i / RET_HEADS), h = (int)(i % RET_HEADS);
        const float* o = OR + (size_t)row * RETW + h * RET_DV;
        float mu = 0.f; for (int v = 0; v < RET_DV; ++v) mu += o[v]; mu /= (float)RET_DV;
        float var = 0.f; for (int v = 0; v < RET_DV; ++v) var += (o[v] - mu) * (o[v] - mu); var /= (float)RET_DV;
        const float r = 1.0f / sqrtf(var + EPS);
        for (int v = 0; v < RET_DV; ++v) OCAT[(size_t)row * KBR + HGW + NSAW + h * RET_DV + v] = f2bf((o[v] - mu) * r * siluf_(bf2f(H[(size_t)row * HP + C_RG + h * RET_DV + v])));
    }
}

static_assert(SEQ % RET_C == 0 && SEQ % HG_C == 0 && HG_C == 32 && RET_C == 64, "chunk sizes");
DEV FI void ph_rec_prep(const P& p, int l, long gtid, long gsize) {
    const bf16* H = WSP(bf16, WS_H); const float* LB = WSP(float, WS_LB) + (size_t)l * HGK;
    for (long i = gtid; i < (long)BATCH * HG_HEADS * HG_NCH * HG_DK; i += gsize) {
        const int k = (int)(i % HG_DK); long r = i / HG_DK; const int c = (int)(r % HG_NCH); r /= HG_NCH; const int h = (int)(r % HG_HEADS), b = (int)(r / HG_HEADS);
        const size_t bh = (size_t)b * HG_HEADS + h; const float lb = LB[h * HG_DK + k];
        float cum[HG_C], kk[HG_C]; float bsum = 0.f;
#pragma unroll
        for (int s = 0; s < HG_C; ++s) { const size_t row = (size_t)b * SEQ + c * HG_C + s;
            const float z = bf2f(H[row * HP + C_HF + h * HG_DK + k]), sig = sigmoidf_(z), f = fmaxf(lb + (1.0f - lb) * sig, MIN_F);
            bsum += flog(f); cum[s] = bsum; kk[s] = (1.0f - lb) * (1.0f - sig); }
        bf16* QT = WSP(bf16, WS_HQT) + (bh * SEQ + c * HG_C) * HG_DK + k; bf16* KT = WSP(bf16, WS_HKT) + (bh * SEQ + c * HG_C) * HG_DK + k;
        bf16* KE = WSP(bf16, WS_HKE) + (bh * HG_DK + k) * SEQ + c * HG_C;
        bf16 ke[HG_C];
#pragma unroll
        for (int s = 0; s < HG_C; ++s) { const size_t row = (size_t)b * SEQ + c * HG_C + s;
            QT[(size_t)s * HG_DK] = f2bf(siluf_(bf2f(H[row * HP + C_HQ + h * HG_DK + k])) * fexp(cum[s]));
            KT[(size_t)s * HG_DK] = f2bf(kk[s] * fexp(fminf(-cum[s], 80.0f)));
            ke[s] = f2bf(kk[s] * fexp(bsum - cum[s])); }
        st_tile32(KE, ke);
        WSP(float, WS_HDEC)[(bh * HG_NCH + c) * HG_DK + k] = fexp(bsum);
    }
    for (long i = gtid; i < (long)3 * BATCH * HG_HEADS * (SEQ / 32) * HG_DV; i += gsize) {
        const int ch = (int)(i % HG_DV); long r = i / HG_DV; const int tile = (int)(r % (SEQ / 32)); r /= (SEQ / 32); const int h = (int)(r % HG_HEADS); r /= HG_HEADS; const int b = (int)(r % BATCH), which = (int)(r / BATCH);
        const size_t bh = (size_t)b * HG_HEADS + h;
        const int col = (which == 0 ? C_HI : (which == 1 ? C_RV : C_RK)) + h * HG_DV + ch;
        bf16* dst = WSP(bf16, which == 0 ? WS_HVP : (which == 1 ? WS_RVP : WS_RKE)) + (bh * HG_DV + ch) * SEQ + tile * 32;
        const float lg2 = log2f(1.0f - fexp2(-5.0f - (float)h));
        bf16 xv[32];
#pragma unroll
        for (int ko = 0; ko < 32; ++ko) { const bf16 x = H[(size_t)(b * SEQ + tile * 32 + ko) * HP + col];
            xv[ko] = which == 2 ? f2bf(bf2f(x) * fexp2(lg2 * (float)(RET_C - 1 - ((tile * 32 + ko) % RET_C)))) : x; }
        st_tile32(dst, xv);
    }
}
static_assert(HG_HEADS == RET_HEADS && HG_DV == RET_DV && HG_DK == RET_DK && HG_DK == HG_DV, "ph_rec_prep shares its item space between the two mixers");
constexpr int SCB = (HG_NCH % 32 == 0 && RET_NCH % 32 == 0) ? 32 : 8;
static_assert(HG_NCH % SCB == 0 && RET_NCH % SCB == 0, "scan batches");
DEV FI void ph_rec_scan(const P& p, int l, long gtid, long gsize) {
    constexpr int KP2 = HG_DK / 2;
    const long nh = (long)BATCH * HG_HEADS * HG_DV * KP2;
    for (long i = gtid; i < 2 * nh; i += gsize) {
        const int which = i >= nh; const long j = which ? i - nh : i;
        const int k = 2 * (int)(j % KP2), v = (int)((j / KP2) % HG_DV), h = (int)((j / ((long)KP2 * HG_DV)) % HG_HEADS), b = (int)(j / ((long)KP2 * HG_DV * HG_HEADS));
        const size_t bh = (size_t)b * HG_HEADS + h;
        float S0 = 0.f, S1 = 0.f;
        if (which == 0) {
            const unsigned* dS = (const unsigned*)(WSP(bf16, WS_HDS) + bh * HG_NCH * HG_DV * HG_DK + (size_t)v * HG_DK + k); unsigned* SC = (unsigned*)(WSP(bf16, WS_HSC) + bh * HG_NCH * HG_DV * HG_DK + (size_t)v * HG_DK + k);
            const float* dec = WSP(float, WS_HDEC) + bh * HG_NCH * HG_DK + k;
            for (int c0 = 0; c0 < HG_NCH; c0 += SCB) { unsigned d8[SCB]; float e0[SCB], e1[SCB];
#pragma unroll
                for (int j = 0; j < SCB; ++j) { d8[j] = ldu_nt(dS + (size_t)(c0 + j) * (HG_DV * HG_DK / 2)); e0[j] = dec[(size_t)(c0 + j) * HG_DK]; e1[j] = dec[(size_t)(c0 + j) * HG_DK + 1]; }
#pragma unroll
                for (int j = 0; j < SCB; ++j) { SC[(size_t)(c0 + j) * (HG_DV * HG_DK / 2)] = pk2bf(S0, S1); S0 = e0[j] * S0 + bf2f((bf16)(d8[j] & 0xffffu)); S1 = e1[j] * S1 + bf2f((bf16)(d8[j] >> 16)); } }
            float* o = p.out + O_HP + ((((size_t)l * BATCH + b) * HG_HEADS + h) * HG_DK + k) * HG_DV + v; o[0] = S0; o[HG_DV] = S1;
        } else {
            const unsigned* dS = (const unsigned*)(WSP(bf16, WS_RDS) + bh * RET_NCH * RET_DV * RET_DK + (size_t)v * RET_DK + k); unsigned* SC = (unsigned*)(WSP(bf16, WS_RSC) + bh * RET_NCH * RET_DV * RET_DK + (size_t)v * RET_DK + k);
            const float gc = exp2f(log2f(1.0f - exp2f(-5.0f - (float)h)) * (float)RET_C);
            for (int c0 = 0; c0 < RET_NCH; c0 += SCB) { unsigned d8[SCB];
#pragma unroll
                for (int j = 0; j < SCB; ++j) d8[j] = ldu_nt(dS + (size_t)(c0 + j) * (RET_DV * RET_DK / 2));
#pragma unroll
                for (int j = 0; j < SCB; ++j) { SC[(size_t)(c0 + j) * (RET_DV * RET_DK / 2)] = pk2bf(S0, S1); S0 = gc * S0 + bf2f((bf16)(d8[j] & 0xffffu)); S1 = gc * S1 + bf2f((bf16)(d8[j] >> 16)); } }
            float* o = p.out + O_RP + ((((size_t)l * BATCH + b) * RET_HEADS + h) * RET_DK + k) * RET_DV + v; o[0] = S0; o[RET_DV] = S1;
        }
    }
}

DEV FI void ph_nsa_q(const P& p, int l, long gtid, long gsize) {
    const bf16* H = WSP(bf16, WS_H); float* QH = WSP(float, WS_QH); bf16* QHB = WSP(bf16, WS_QHB); const float* g = p.nsa_q_norm + (size_t)l * NSA_HEAD_DIM;
    const float sc = 1.0f / sqrtf((float)NSA_HEAD_DIM);
    for (long i = gtid; i < (long)MR * NSA_HEADS; i += gsize) {
        const int row = (int)(i / NSA_HEADS), hd = (int)(i % NSA_HEADS);
        const bf16* q = H + (size_t)row * HP + C_NQ + hd * NSA_HEAD_DIM;
        float xr[HDIM]; float ss = 0.f;
#pragma unroll
        for (int e0 = 0; e0 < HDIM; e0 += 8) { float v8[8]; ld8bf(q + e0, v8);
#pragma unroll
            for (int j = 0; j < 8; ++j) { xr[e0 + j] = v8[j]; ss += v8[j] * v8[j]; } }
        const float r = sc / sqrtf(ss / (float)NSA_HEAD_DIM + EPS);
#pragma unroll
        for (int e0 = 0; e0 < HDIM; e0 += 8) { float v8[8];
#pragma unroll
            for (int j = 0; j < 8; ++j) v8[j] = xr[e0 + j] * r * g[e0 + j];
            { float w8[8];
#pragma unroll
              for (int j = 0; j < 8; ++j) w8[j] = v8[j] * LOG2E;
              st8bf(QHB + (size_t)row * NSAW + hd * NSA_HEAD_DIM + e0, w8); }
            st4f(QH + (size_t)row * NSAW + hd * NSA_HEAD_DIM + e0, v8); st4f(QH + (size_t)row * NSAW + hd * NSA_HEAD_DIM + e0 + 4, v8 + 4); }
    }
}
struct RowPtr { const bf16* hb; const float* fb; };
DEV FI RowPtr nsa_row_ptr(const P& p, const bf16* H, int l, int s, int pos, int c, int h) {
    RowPtr r; r.hb = nullptr; r.fb = nullptr;
    if (s < BATCH) { r.hb = H + (size_t)(s * SEQ + pos) * HP + C_NKV + c * NSAKVW + h * NSA_HEAD_DIM; return r; }
    const int sb = s - BATCH;
    if (pos < PAST_LEN) { const int page = p.page_table[sb * NPAGES + pos / PAGE_SIZE];
        r.fb = p.cache_nsa + ((((size_t)l * NPOOL + page) * PAGE_SIZE + pos % PAGE_SIZE) * 4 + c) * NSAKVW + h * NSA_HEAD_DIM; return r; }
    if (pos < LS) r.hb = H + (size_t)(NP + sb * DEC_SEQ + (pos - PAST_LEN)) * HP + C_NKV + c * NSAKVW + h * NSA_HEAD_DIM;
    return r;
}
DEV FI RowPtr win_row_ptr(const P& p, const bf16* H, int l, int s, int kpos, int c, int h) {
    RowPtr r; r.hb = nullptr; r.fb = nullptr;
    if (s < BATCH) { r.hb = H + (size_t)(s * SEQ + kpos) * HP + C_NWKV + c * NSAKVW + h * NSA_HEAD_DIM; return r; }
    const int sb = s - BATCH;
    if (kpos < PAST_LEN) r.fb = p.cache_win + ((((size_t)l * DEC_BATCH + sb) * WINBUF + (kpos - (PAST_LEN - WINBUF))) * 2 + c) * NSAKVW + h * NSA_HEAD_DIM;
    else r.hb = H + (size_t)(NP + sb * DEC_SEQ + (kpos - PAST_LEN)) * HP + C_NWKV + c * NSAKVW + h * NSA_HEAD_DIM;
    return r;
}
#ifdef CPU_TEST
#define SCHED_FENCE() do {} while (0)
#else
#define SCHED_FENCE() __builtin_amdgcn_sched_barrier(0)
#endif
constexpr int ECH = NSA_HEAD_DIM < 8 ? NSA_HEAD_DIM : 8;
DEV FI void row_dot(const RowPtr& r, const float (&q)[NSA_HEAD_DIM], float& dot, float& ss) {
    dot = 0.f; ss = 0.f;
    if (r.hb) {
#pragma unroll
        for (int e0 = 0; e0 < NSA_HEAD_DIM; e0 += ECH) {
#pragma unroll
            for (int e = e0; e < e0 + ECH; ++e) { const float kv = bf2f(r.hb[e]); dot += q[e] * kv; ss += kv * kv; }
            SCHED_FENCE(); }
    } else if (r.fb) {
#pragma unroll
        for (int e0 = 0; e0 < NSA_HEAD_DIM; e0 += ECH) {
#pragma unroll
            for (int e = e0; e < e0 + ECH; ++e) { const float kv = r.fb[e]; dot += q[e] * kv; ss += kv * kv; }
            SCHED_FENCE(); }
    }
}
template <int N> DEV FI void row_axpy(const RowPtr& r, int eoff, float (&acc)[N], float a, float b) {
    constexpr int CH = N < 8 ? N : 8;
    if (r.hb) {
#pragma unroll
        for (int e0 = 0; e0 < N; e0 += CH) {
#pragma unroll
            for (int e = e0; e < e0 + CH; ++e) acc[e] = acc[e] * a + b * bf2f(r.hb[eoff + e]);
            SCHED_FENCE(); }
    } else if (r.fb) {
#pragma unroll
        for (int e0 = 0; e0 < N; e0 += CH) {
#pragma unroll
            for (int e = e0; e < e0 + CH; ++e) acc[e] = acc[e] * a + b * r.fb[eoff + e];
            SCHED_FENCE(); }
    } else {
#pragma unroll
        for (int e = 0; e < N; ++e) acc[e] = acc[e] * a;
    }
}
DEV FI void ph_cmp(const P& p, int l, long gtid, long gsize) {
    const bf16* H = WSP(bf16, WS_H);
    const float* w = p.nsa_cmp_w + (size_t)l * 2 * CMP_BLOCK; const float* gk = p.nsa_k_norm + (size_t)l * 3 * NSA_HEAD_DIM;
    const long nP = (long)BATCH * NBP * NSA_KV_HEADS * 2, nS = (long)DEC_BATCH * NBS * NSA_KV_HEADS * 2;
    for (long i = gtid; i < nP + nS; i += gsize) {
        int s, n, h, c; float* dst;
        if (i < nP) { c = (int)(i & 1); const long j = i >> 1; h = (int)(j % NSA_KV_HEADS); n = (int)((j / NSA_KV_HEADS) % NBP); s = (int)(j / ((long)NSA_KV_HEADS * NBP));
            dst = WSP(float, c ? WS_VCP : WS_KCP) + ((size_t)s * NBP + n) * NSAKVW + h * NSA_HEAD_DIM; }
        else { const long i2 = i - nP; c = (int)(i2 & 1); const long j = i2 >> 1; h = (int)(j % NSA_KV_HEADS); n = (int)((j / NSA_KV_HEADS) % NBS); const int sb = (int)(j / ((long)NSA_KV_HEADS * NBS)); s = BATCH + sb;
            dst = WSP(float, c ? WS_VCS : WS_KCS) + ((size_t)sb * NBS + n) * NSAKVW + h * NSA_HEAD_DIM; }
        float acc[NSA_HEAD_DIM];
#pragma unroll
        for (int e = 0; e < NSA_HEAD_DIM; ++e) acc[e] = 0.f;
#pragma unroll 1
        for (int j = 0; j < CMP_BLOCK; ++j) { const RowPtr r = nsa_row_ptr(p, H, l, s, n * CMP_STRIDE + j, c, h); row_axpy<NSA_HEAD_DIM>(r, 0, acc, 1.0f, w[c * CMP_BLOCK + j]); }
        if (c == 0) {
            float ss = 0.f;
#pragma unroll
            for (int e = 0; e < NSA_HEAD_DIM; ++e) ss += acc[e] * acc[e];
            const float r = 1.0f / sqrtf(ss / (float)NSA_HEAD_DIM + EPS);
#pragma unroll
            for (int e = 0; e < NSA_HEAD_DIM; ++e) acc[e] = acc[e] * r * gk[e];
        }
#pragma unroll
        for (int e = 0; e < NSA_HEAD_DIM; ++e) dst[e] = acc[e];
        {
            const int npitch = s < BATCH ? NBPP : NBS; const size_t sh = s < BATCH ? (size_t)s * NSA_KV_HEADS + h : (size_t)(s - BATCH) * NSA_KV_HEADS + h;
            if (c == 0) { bf16* kb = WSP(bf16, s < BATCH ? WS_KCB : WS_KCSB + l * SZ_KCS) + (sh * npitch + (n & ~31)) * HDIM;
#pragma unroll
                for (int e = 0; e < NSA_HEAD_DIM; ++e) kb[kf_off(n & 31, e)] = f2bf(acc[e]); }
            else { bf16* vb = WSP(bf16, s < BATCH ? WS_VCB : WS_VCSB + l * SZ_KCS) + (sh * npitch + (n & ~31)) * HDIM;
#pragma unroll
                for (int e = 0; e < NSA_HEAD_DIM; ++e) vb[vf_off(n & 31, e)] = f2bf(acc[e]); }
        }
    }
}
DEV FI void ph_nsa_prep(const P& p, int l, long gtid, long gsize) {
    const bf16* H = WSP(bf16, WS_H);
    for (long i = gtid; i < (long)NP * NSA_KV_HEADS * 2; i += gsize) {
        const int which = (int)(i & 1), kvh = (int)((i >> 1) % NSA_KV_HEADS), row = (int)((i >> 1) / NSA_KV_HEADS), b = row / SEQ, t = row % SEQ;
        const bf16* src = H + (size_t)row * HP + (which == 0 ? C_NKV + 2 * NSAKVW : C_NWKV) + kvh * HDIM;
        const float* gk = p.nsa_k_norm + ((size_t)l * 3 + 1 + which) * HDIM;
        bf16* dst = WSP(bf16, which == 0 ? WS_KSN : WS_KWN) + (((size_t)b * NSA_KV_HEADS + kvh) * SEQ + (t & ~31)) * HDIM;
        float xr[HDIM]; float ss = 0.f;
#pragma unroll
        for (int e0 = 0; e0 < HDIM; e0 += 8) { float v8[8]; ld8bf(src + e0, v8);
#pragma unroll
            for (int j = 0; j < 8; ++j) { xr[e0 + j] = v8[j]; ss += v8[j] * v8[j]; } }
        const float r = frsq(ss / (float)HDIM + EPS);
#pragma unroll
        for (int e0 = 0; e0 < HDIM; e0 += 8) { float v8[8];
#pragma unroll
            for (int j = 0; j < 8; ++j) v8[j] = xr[e0 + j] * r * gk[e0 + j];
            st8bf(dst + kf_off(t & 31, e0), v8); }
    }
    for (long i = gtid; i < (long)BATCH * NSA_KV_HEADS * 2 * (SEQ / 32) * HDIM; i += gsize) {
        const int d = (int)(i % HDIM); long r = i / HDIM; const int tile = (int)(r % (SEQ / 32)); r /= (SEQ / 32); const int which = (int)(r & 1); r >>= 1; const int kvh = (int)(r % NSA_KV_HEADS), b = (int)(r / NSA_KV_HEADS);
        const bf16* src = H + (size_t)(b * SEQ + tile * 32) * HP + (which == 0 ? C_NKV + 3 * NSAKVW : C_NWKV + NSAKVW) + kvh * HDIM + d;
        bf16* dst = WSP(bf16, which == 0 ? WS_VSP : WS_VWP) + (((size_t)b * NSA_KV_HEADS + kvh) * SEQ + tile * 32) * HDIM;
        bf16 xv[32];
#pragma unroll
        for (int ko = 0; ko < 32; ++ko) xv[ko] = src[(size_t)ko * HP];
        st_vtile(dst, d, xv);
    }
    for (long i = gtid; i < (long)BATCH * NSA_KV_HEADS * (NBPP - NBP) * HDIM; i += gsize) {
        const int e = (int)(i % HDIM); long r = i / HDIM; const int n = NBP + (int)(r % (NBPP - NBP)); r /= (NBPP - NBP); const int kvh = (int)(r % NSA_KV_HEADS), b = (int)(r / NSA_KV_HEADS);
        WSP(bf16, WS_KCB)[(((size_t)b * NSA_KV_HEADS + kvh) * NBPP + (n & ~31)) * HDIM + kf_off(n & 31, e)] = 0;
        WSP(bf16, WS_VCB)[(((size_t)b * NSA_KV_HEADS + kvh) * NBPP + (n & ~31)) * HDIM + vf_off(n & 31, e)] = 0;
    }
}
DEV FI void ph_cmp_attn(const P& p, int l, long gtid, long gsize, int row0 = 0) {
    const float* QH = WSP(float, WS_QH); float* OCMP = WSP(float, WS_OCMP);
    for (long i = gtid; i < (long)(MR - row0) * NSA_HEADS; i += gsize) {
        const int row = row0 + (int)(i / NSA_HEADS), hd = (int)(i % NSA_HEADS), kvh = hd / NSA_GROUP;
        const int s = row_seq(row), t = row_t(row), pos = s < BATCH ? t : PAST_LEN + t, nb = s < BATCH ? NBP : NBS;
        const float* KC = s < BATCH ? WSP(float, WS_KCP) + (size_t)s * NBP * NSAKVW : WSP(float, WS_KCS) + (size_t)(s - BATCH) * NBS * NSAKVW;
        const float* VC = s < BATCH ? WSP(float, WS_VCP) + (size_t)s * NBP * NSAKVW : WSP(float, WS_VCS) + (size_t)(s - BATCH) * NBS * NSAKVW;
        float* Pr = s < BATCH ? WSP(float, WS_PP) + ((size_t)row * NSA_HEADS + hd) * NBPP : WSP(float, WS_PS) + ((size_t)(row - NP) * NSA_HEADS + hd) * NBS;
        int nvalid = pos < CMP_BLOCK - 1 ? 0 : (pos - (CMP_BLOCK - 1)) / CMP_STRIDE + 1; if (nvalid > nb) nvalid = nb;
        const float slope = slope_of(hd);
        float q[NSA_HEAD_DIM], o[NSA_HEAD_DIM];
#pragma unroll
        for (int e = 0; e < NSA_HEAD_DIM; ++e) { q[e] = QH[(size_t)row * NSAW + hd * NSA_HEAD_DIM + e]; o[e] = 0.f; }
        float m = -3.0e38f, sum = 0.f;
#pragma unroll 1
        for (int n = 0; n < nvalid; ++n) {
            const float* k = KC + (size_t)n * NSAKVW + kvh * NSA_HEAD_DIM; const float* v = VC + (size_t)n * NSAKVW + kvh * NSA_HEAD_DIM;
            float sc = 0.f;
#pragma unroll
            for (int e = 0; e < NSA_HEAD_DIM; ++e) sc += q[e] * k[e];
            sc -= slope * (float)(pos - (n * CMP_STRIDE + CMP_BLOCK - 1));
            const float mn = fmaxf(m, sc), a = expf(m - mn), b = expf(sc - mn);
            sum = sum * a + b;
#pragma unroll
            for (int e = 0; e < NSA_HEAD_DIM; ++e) o[e] = o[e] * a + b * v[e];
            m = mn;
        }
        const float inv = 1.0f / fmaxf(sum, 1e-30f);
#pragma unroll
        for (int e = 0; e < NSA_HEAD_DIM; ++e) OCMP[(size_t)row * NSAW + hd * NSA_HEAD_DIM + e] = o[e] * inv;
#pragma unroll 1
        for (int n = 0; n < nb; ++n) {
            float pr = 0.f;
            if (n < nvalid) { const float* k = KC + (size_t)n * NSAKVW + kvh * NSA_HEAD_DIM; float sc = 0.f;
#pragma unroll
                for (int e = 0; e < NSA_HEAD_DIM; ++e) sc += q[e] * k[e];
                sc -= slope * (float)(pos - (n * CMP_STRIDE + CMP_BLOCK - 1)); pr = expf(sc - m) * inv; }
            Pr[n] = pr;
        }
    }
}
DEV FI void ph_select(const P& p, int l, long gtid, long gsize, int row0 = 0) {
    float* SC = WSP(float, WS_SC); int* IDX = WSP(int, WS_IDX);
    for (long i = gtid; i < (long)(MR - row0) * NSA_KV_HEADS; i += gsize) {
        const int row = row0 + (int)(i / NSA_KV_HEADS), kvh = (int)(i % NSA_KV_HEADS);
        const int s = row_seq(row), t = row_t(row), pos = s < BATCH ? t : PAST_LEN + t, nb = s < BATCH ? NBP : NBS, nsel = s < BATCH ? NSEL_P : NSEL_S, topk = s < BATCH ? TOPK_P : TOPK_S;
        const float* Pr = s < BATCH ? WSP(float, WS_PP) + ((size_t)row * NSA_HEADS + kvh * NSA_GROUP) * NBPP : WSP(float, WS_PS) + ((size_t)(row - NP) * NSA_HEADS + kvh * NSA_GROUP) * NBS;
        float* sc = SC + ((size_t)row * NSA_KV_HEADS + kvh) * NSEL_MAX; int* idx = IDX + ((size_t)row * NSA_KV_HEADS + kvh) * NSA_TOPK;
        const int cur = pos / SEL_BLOCK, npitch = s < BATCH ? NBPP : NBS;
        for (int j = 0; j < nsel; ++j) {
            float a = 0.f;
            for (int mm = 0; mm < SEL_M; ++mm) for (int r = 0; r < CMP_R; ++r) { const int n = j * SEL_M + mm + r; if (n < nb) for (int g = 0; g < NSA_GROUP; ++g) a += Pr[(size_t)g * npitch + n]; }
            const bool forced = (j == 0) || (j == cur), allowed = (long)j * SEL_BLOCK <= pos;
            sc[j] = forced ? POS_BIG : (allowed ? a : NEG_BIG);
        }
        for (int r = 0; r < topk; ++r) {
            float best = -3.4e38f; int bi = 0;
            for (int j = 0; j < nsel; ++j) if (sc[j] > best) { best = sc[j]; bi = j; }
            idx[r] = bi; sc[bi] = -3.4e38f;
        }
    }
}
constexpr int HDH = NSA_HEAD_DIM / 2;
DEV FI void ph_sel_attn(const P& p, int l, long gtid, long gsize, int row0 = 0) {
    const bf16* H = WSP(bf16, WS_H); const float* QH = WSP(float, WS_QH); float* OSEL = WSP(float, WS_OSEL); const int* IDX = WSP(int, WS_IDX);
    const float* gk = p.nsa_k_norm + ((size_t)l * 3 + 1) * NSA_HEAD_DIM;
    for (long i = gtid; i < (long)(MR - row0) * NSA_HEADS * 2; i += gsize) {
        const int half = (int)(i & 1), row = row0 + (int)((i >> 1) / NSA_HEADS), hd = (int)((i >> 1) % NSA_HEADS), kvh = hd / NSA_GROUP, eoff = half * HDH;
        const int s = row_seq(row), t = row_t(row), pos = s < BATCH ? t : PAST_LEN + t, topk = s < BATCH ? TOPK_P : TOPK_S;
        const int* idx = IDX + ((size_t)row * NSA_KV_HEADS + kvh) * NSA_TOPK;
        const float slope = slope_of(hd);
        float q[NSA_HEAD_DIM], o[HDH];
#pragma unroll
        for (int e = 0; e < NSA_HEAD_DIM; ++e) q[e] = QH[(size_t)row * NSAW + hd * NSA_HEAD_DIM + e] * gk[e];
#pragma unroll
        for (int e = 0; e < HDH; ++e) o[e] = 0.f;
        float m = -3.0e38f, sum = 0.f;
#pragma unroll 1
        for (int r = 0; r < topk; ++r) {
            const int blk = idx[r];
#pragma unroll 1
            for (int j = 0; j < SEL_BLOCK; ++j) {
                const int kpos = blk * SEL_BLOCK + j; if (kpos > pos) break;
                float dot, ss; row_dot(nsa_row_ptr(p, H, l, s, kpos, 2, kvh), q, dot, ss);
                const float sc = dot / sqrtf(ss / (float)NSA_HEAD_DIM + EPS) - slope * (float)(pos - kpos);
                const float mn = fmaxf(m, sc), a_ = expf(m - mn), b_ = expf(sc - mn); sum = sum * a_ + b_; m = mn;
                row_axpy<HDH>(nsa_row_ptr(p, H, l, s, kpos, 3, kvh), eoff, o, a_, b_);
            }
        }
        const float inv = 1.0f / fmaxf(sum, 1e-30f);
#pragma unroll
        for (int e = 0; e < HDH; ++e) OSEL[(size_t)row * NSAW + hd * NSA_HEAD_DIM + eoff + e] = o[e] * inv;
    }
}
DEV FI void ph_win_attn(const P& p, int l, long gtid, long gsize, int row0 = 0) {
    const bf16* H = WSP(bf16, WS_H); const float* QH = WSP(float, WS_QH); const float *OCMP = WSP(float, WS_OCMP), *OSEL = WSP(float, WS_OSEL); bf16* OCAT = WSP(bf16, WS_OCAT);
    const float* gk = p.nsa_k_norm + ((size_t)l * 3 + 2) * NSA_HEAD_DIM;
    for (long i = gtid; i < (long)(MR - row0) * NSA_HEADS * 2; i += gsize) {
        const int half = (int)(i & 1), row = row0 + (int)((i >> 1) / NSA_HEADS), hd = (int)((i >> 1) % NSA_HEADS), kvh = hd / NSA_GROUP, eoff = half * HDH;
        const int s = row_seq(row), t = row_t(row), pos = s < BATCH ? t : PAST_LEN + t;
        const float slope = slope_of(hd);
        float q[NSA_HEAD_DIM], o[HDH];
#pragma unroll
        for (int e = 0; e < NSA_HEAD_DIM; ++e) q[e] = QH[(size_t)row * NSAW + hd * NSA_HEAD_DIM + e] * gk[e];
#pragma unroll
        for (int e = 0; e < HDH; ++e) o[e] = 0.f;
        float m = -3.0e38f, sum = 0.f;
        int k0 = pos - WINDOW + 1; const int lo = s < BATCH ? 0 : PAST_LEN - WINBUF; if (k0 < lo) k0 = lo;
#pragma unroll 1
        for (int kpos = k0; kpos <= pos; ++kpos) {
            float dot, ss; row_dot(win_row_ptr(p, H, l, s, kpos, 0, kvh), q, dot, ss);
            const float sc = dot / sqrtf(ss / (float)NSA_HEAD_DIM + EPS) - slope * (float)(pos - kpos);
            const float mn = fmaxf(m, sc), a_ = expf(m - mn), b_ = expf(sc - mn); sum = sum * a_ + b_; m = mn;
            row_axpy<HDH>(win_row_ptr(p, H, l, s, kpos, 1, kvh), eoff, o, a_, b_);
        }
        const float inv = 1.0f / fmaxf(sum, 1e-30f);
        const bf16* bgp = H + (size_t)row * HP + C_NBG + hd * 3;
        const float b0 = sigmoidf_(bf2f(bgp[0])), b1 = sigmoidf_(bf2f(bgp[1])), b2 = sigmoidf_(bf2f(bgp[2]));
#pragma unroll
        for (int e = 0; e < HDH; ++e) { const size_t qi = (size_t)row * NSAW + hd * NSA_HEAD_DIM + eoff + e;
            OCAT[(size_t)row * KBR + HGW + hd * NSA_HEAD_DIM + eoff + e] = f2bf(b0 * OCMP[qi] + b1 * OSEL[qi] + b2 * o[e] * inv); }
    }
}
DEV FI void ph_copy_win(const P& p, int l, long gtid, long gsize) {
    const long n = (long)DEC_BATCH * (WINBUF - DEC_SEQ) * WROWF;
    for (long i = gtid; i < n; i += gsize) {
        const int c = (int)(i % WROWF), j = (int)((i / WROWF) % (WINBUF - DEC_SEQ)), sb = (int)(i / ((long)WROWF * (WINBUF - DEC_SEQ)));
        p.out[O_WS + (((size_t)l * DEC_BATCH + sb) * WINBUF + j) * WROWF + c] = p.cache_win[(((size_t)l * DEC_BATCH + sb) * WINBUF + j + DEC_SEQ) * WROWF + c];
    }
}
DEV FI void ph_zero_pad(const P& p, long gtid, long gsize) {
    bf16* OCAT = WSP(bf16, WS_OCAT);
    for (long i = gtid; i < (long)(MP - MR) * KBR; i += gsize) OCAT[(size_t)MR * KBR + i] = 0;
}

#ifndef FAST_EPI
#define FAST_EPI 0
#endif
#if FAST_EPI
#define SIG_EPI sigmoid_fast
#define SILU_EPI silu_fast
#else
#define SIG_EPI sigmoidf_
#define SILU_EPI siluf_
#endif
struct EpIn {
    bf16* H; float* out; int l;
    DEV FI void apply4(int row, int col, const float* v) const {
        if (col >= C_MG && col < W_IN) { const float g[4] = {SIG_EPI(v[0]), SIG_EPI(v[1]), SIG_EPI(v[2]), SIG_EPI(v[3])}; st4bf(H + (size_t)row * HP + col, g); return; }
        st4bf(H + (size_t)row * HP + col, v);
        if (row >= MR) return;
        if (col >= C_NKV && col < C_NKV + ROWF) {
            float* o = row < NP ? out + O_KVP + ((size_t)l * NP + row) * ROWF + (col - C_NKV) : out + O_KVS + ((size_t)l * NS + (row - NP)) * ROWF + (col - C_NKV);
            st4f_nt(o, v);
        } else if (col >= C_NWKV && col < C_NWKV + WROWF) {
            const int s = row_seq(row), t = row_t(row); float* o = nullptr;
            if (s < BATCH) { if (t >= SEQ - WINP) o = out + O_WP + (((size_t)l * BATCH + s) * WINP + (t - (SEQ - WINP))) * WROWF + (col - C_NWKV); }
            else o = out + O_WS + (((size_t)l * DEC_BATCH + (s - BATCH)) * WINBUF + (WINBUF - DEC_SEQ + t)) * WROWF + (col - C_NWKV);
            if (o) st4f_nt(o, v);
        }
    }
};
struct EpBr {
    const bf16* H; float* MGF; bf16* MG;
    DEV FI void apply4(int row, int col, const float* v, int seg) const {
        float* mf = MGF + (size_t)row * D_MODEL + col; float g[4], r[4];
        ld4bf(H + (size_t)row * HP + C_MG + seg * D_MODEL + col, g);
        if (seg == 0) { for (int j = 0; j < 4; ++j) r[j] = g[j] * v[j]; }
        else { float m[4]; ld4f(mf, m); for (int j = 0; j < 4; ++j) r[j] = m[j] + g[j] * v[j]; }
        if (seg == 2) st4bf(MG + (size_t)row * D_MODEL + col, r); else st4f(mf, r);
    }
};
struct EpOut {
    const float *xp, *xs, *xl; float* X1; int l;
    DEV FI void apply4(int row, int col, const float* v) const {
        if (row >= MR) return;
        float* o = X1 + (size_t)row * D_MODEL + col; float r[4];
        const float* x = l == 0 ? (row < NP ? xp + (size_t)row * D_MODEL : xs + (size_t)(row - NP) * D_MODEL) : xl + (size_t)row * D_MODEL;
        float xv[4]; ld4f(x + col, xv); for (int j = 0; j < 4; ++j) r[j] = xv[j] + v[j];
        st4f(o, r);
    }
};
struct EpGU {
    bf16* GU;
    DEV FI void apply4(int row, int ocol, const float* vg, const float* vu) const {
        float r[4]; for (int j = 0; j < 4; ++j) r[j] = SILU_EPI(vg[j]) * vu[j];
        st4bf(GU + (size_t)row * FFN + ocol, r);
    }
};
struct EpDown {
    const float* X1; float* XL; float* out; int l;
    DEV FI void apply4(int row, int col, const float* v) const {
        if (row >= MR) return;
        float x[4], r[4]; ld4f(X1 + (size_t)row * D_MODEL + col, x);
        for (int j = 0; j < 4; ++j) r[j] = x[j] + v[j];
        if (l == DEPTH - 1) st4f_nt(out + O_YP + (size_t)row * D_MODEL + col, r); else st4f(XL + (size_t)row * D_MODEL + col, r);
    }
};
#ifdef CPU_TEST
constexpr int NL = 64;
struct bf16x8 { short d[8]; short& operator[](int i) { return d[i]; } const short& operator[](int i) const { return d[i]; } };
struct f32x16 { float d[16]; float& operator[](int i) { return d[i]; } const float& operator[](int i) const { return d[i]; } };
#define LANE_OF(ln) (ln)
#else
constexpr int NL = 1;
typedef short bf16x8 __attribute__((ext_vector_type(8)));
typedef float f32x16 __attribute__((ext_vector_type(16)));
#define LANE_OF(ln) (lane_)
#endif
#define LANES for (int ln = 0; ln < NL; ++ln)
DEV FI int lane_fresh(int lane_) {
#ifndef CPU_TEST
    asm volatile("" : "+v"(lane_));
#endif
    return lane_;
}
typedef unsigned long long u64;

DEV FI bf16x8 ld8(const bf16* p) {
#ifdef CPU_TEST
    bf16x8 r; for (int j = 0; j < 8; ++j) r[j] = (short)p[j]; return r;
#else
    return *(const bf16x8*)p;
#endif
}
DEV FI void mfma32(const bf16x8* a, const bf16x8* b, f32x16* c) {
#ifdef CPU_TEST
    static float Am[32][16], Bm[16][32];
    for (int ln = 0; ln < 64; ++ln) { const int r = ln & 31, h = ln >> 5; for (int j = 0; j < 8; ++j) { Am[r][8 * h + j] = bf2f((bf16)a[ln][j]); Bm[8 * h + j][r] = bf2f((bf16)b[ln][j]); } }
    for (int ln = 0; ln < 64; ++ln) { const int col = ln & 31, h = ln >> 5; for (int i = 0; i < 16; ++i) { const int row = (i & 3) + 8 * (i >> 2) + 4 * h; float s = 0.f; for (int k = 0; k < 16; ++k) s += Am[row][k] * Bm[k][col]; c[ln][i] += s; } }
#else
    c[0] = __builtin_amdgcn_mfma_f32_32x32x16_bf16(a[0], b[0], c[0], 0, 0, 0);
#endif
}
DEV FI void xor32_max(float* x) {
#ifdef CPU_TEST
    for (int ln = 0; ln < 32; ++ln) { const float m = fmaxf(x[ln], x[ln + 32]); x[ln] = m; x[ln + 32] = m; }
#else
    x[0] = fmaxf(x[0], __shfl_xor(x[0], 32));
#endif
}
DEV FI void xor32_add(float* x) {
#ifdef CPU_TEST
    for (int ln = 0; ln < 32; ++ln) { const float m = x[ln] + x[ln + 32]; x[ln] = m; x[ln + 32] = m; }
#else
    x[0] = x[0] + __shfl_xor(x[0], 32);
#endif
}
DEV FI void half_max32(float* x) {
#ifdef CPU_TEST
    for (int hf = 0; hf < 2; ++hf) { float m = -3.4e38f; for (int ln = 0; ln < 32; ++ln) m = fmaxf(m, x[32 * hf + ln]); for (int ln = 0; ln < 32; ++ln) x[32 * hf + ln] = m; }
#else
#pragma unroll
    for (int o = 16; o >= 1; o >>= 1) x[0] = fmaxf(x[0], __shfl_xor(x[0], o));
#endif
}
DEV FI void half_sum32(float* x) {
#ifdef CPU_TEST
    for (int hf = 0; hf < 2; ++hf) { float m = 0.f; for (int ln = 0; ln < 32; ++ln) m += x[32 * hf + ln]; for (int ln = 0; ln < 32; ++ln) x[32 * hf + ln] = m; }
#else
#pragma unroll
    for (int o = 16; o >= 1; o >>= 1) x[0] += __shfl_xor(x[0], o);
#endif
}
DEV FI void lane_xor_f(const float* x, float* y, int mask) {
#ifdef CPU_TEST
    float t[64]; for (int ln = 0; ln < 64; ++ln) t[ln] = x[ln ^ mask]; for (int ln = 0; ln < 64; ++ln) y[ln] = t[ln];
#else
    y[0] = __shfl_xor(x[0], mask);
#endif
}
DEV FI void lane_xor_u(const unsigned* x, unsigned* y, int mask) {
#ifdef CPU_TEST
    unsigned t[64]; for (int ln = 0; ln < 64; ++ln) t[ln] = x[ln ^ mask]; for (int ln = 0; ln < 64; ++ln) y[ln] = t[ln];
#else
    y[0] = (unsigned)__shfl_xor((int)x[0], mask);
#endif
}
DEV FI void wave_argmax(float* v, int* j) {
#ifdef CPU_TEST
    float bv = v[0]; int bj = j[0]; for (int ln = 1; ln < 64; ++ln) if (v[ln] > bv || (v[ln] == bv && j[ln] < bj)) { bv = v[ln]; bj = j[ln]; }
    for (int ln = 0; ln < 64; ++ln) { v[ln] = bv; j[ln] = bj; }
#else
#pragma unroll
    for (int o = 32; o >= 1; o >>= 1) { const float ov = __shfl_xor(v[0], o); const int oj = __shfl_xor(j[0], o); if (ov > v[0] || (ov == v[0] && oj < j[0])) { v[0] = ov; j[0] = oj; } }
#endif
}
DEV FI int wave_first_i(const int* x) {
#ifdef CPU_TEST
    return x[0];
#else
    return __builtin_amdgcn_readfirstlane(x[0]);
#endif
}
DEV FI u64 wave_ballot(const bool* pr) {
#ifdef CPU_TEST
    u64 m = 0; for (int ln = 0; ln < 64; ++ln) if (pr[ln]) m |= (1ull << ln); return m;
#else
    return (u64)__ballot(pr[0]);
#endif
}
DEV FI float wave_bcast(const float* x, int i) {
#ifdef CPU_TEST
    return x[i];
#else
    return __int_as_float(__builtin_amdgcn_readlane(__float_as_int(x[0]), i));
#endif
}
DEV FI bf16 f2bf_s(float f) { return f2bf(f); }
DEV FI int koff_of(int i, int h) { return (i & 3) + 8 * (i >> 2) + 4 * h; }

constexpr int NSTEP = HDIM / 16, NDB = HDIM / 32;
static_assert(HDIM % 32 == 0, "wave attention: head dim multiple of 32");
struct WAttn { f32x16 o[NDB][NL]; float m[NL], l[NL]; };
DEV FI void wattn_reset(WAttn& st) { LANES { st.m[ln] = -3.0e38f; st.l[ln] = 0.f; for (int db = 0; db < NDB; ++db) for (int i = 0; i < 16; ++i) st.o[db][ln][i] = 0.f; } }
template <class F> DEV FI void wattn_scores(const int lane_, const bf16* Kt, const bf16x8 (&qf)[NSTEP][NL], f32x16 (&s)[NL], const F& f) {
    LANES { for (int i = 0; i < 16; ++i) s[ln][i] = 0.f; }
#pragma unroll
    for (int step = 0; step < NSTEP; ++step) { bf16x8 kf[NL]; LANES { const int lane = LANE_OF(ln), r = lane & 31, h = lane >> 5; kf[ln] = ld8(Kt + ((step * 2 + h) * 32 + r) * 8); } mfma32(kf, qf[step], s); }
    LANES { const int lane = LANE_OF(ln);
#pragma unroll
        for (int i = 0; i < 16; ++i) { bool v; float b; f(ln, lane, i, v, b); s[ln][i] = v ? s[ln][i] + b : -3.0e38f; } }
}
template <class F> DEV FI void wattn_tile(const int lane_, const bf16* Kt, const bf16* Vt, int vpitch, const bf16x8 (&qf)[NSTEP][NL], WAttn& st, const F& f) {
    f32x16 s[NL]; wattn_scores(lane_, Kt, qf, s, f);
    float mx[NL]; LANES { float m = -3.0e38f;
#pragma unroll
        for (int i = 0; i < 16; ++i) m = fmaxf(m, s[ln][i]); mx[ln] = m; }
    xor32_max(mx);
    bf16x8 pf[2][NL];
    LANES { const float mn = fmaxf(st.m[ln], mx[ln]), alpha = fexp2(st.m[ln] - mn); float sum = 0.f;
#pragma unroll
        for (int i = 0; i < 16; ++i) { const float pv = s[ln][i] > -1.0e38f ? fexp2(s[ln][i] - mn) : 0.f; sum += pv; pf[i >> 3][ln][i & 7] = (short)f2bf_s(pv); }
        st.l[ln] = st.l[ln] * alpha + sum; st.m[ln] = mn;
#pragma unroll
        for (int db = 0; db < NDB; ++db)
#pragma unroll
            for (int i = 0; i < 16; ++i) st.o[db][ln][i] *= alpha; }
#pragma unroll
    for (int s2 = 0; s2 < 2; ++s2)
#pragma unroll
        for (int db = 0; db < NDB; ++db) { bf16x8 vf[NL]; LANES { const int lane = LANE_OF(ln), r = lane & 31, h = lane >> 5; vf[ln] = ld8(Vt + (((s2 * NDB + db) * 2 + h) * 32 + r) * 8); } mfma32(vf, pf[s2], st.o[db]); }
}
DEV FI void wattn_finish(WAttn& st) {
    xor32_add(st.l);
    LANES { const float inv = frcp(fmaxf(st.l[ln], 1e-30f));
#pragma unroll
        for (int db = 0; db < NDB; ++db)
#pragma unroll
            for (int i = 0; i < 16; ++i) st.o[db][ln][i] *= inv; }
}

#ifndef WATTN_NB
#define WATTN_NB 2
#endif
struct WFrags { bf16x8 k[NSTEP][NL]; bf16x8 v[2][NDB][NL]; };
DEV FI void wattn_fetch(const int lane_, const bf16* Kt, const bf16* Vt, int vpitch, WFrags& fr) {
    LANES { const int lane = LANE_OF(ln), r = lane & 31, h = lane >> 5;
#pragma unroll
        for (int step = 0; step < NSTEP; ++step) fr.k[step][ln] = ld8(Kt + ((step * 2 + h) * 32 + r) * 8);
        if (Vt) {
#pragma unroll
            for (int s2 = 0; s2 < 2; ++s2)
#pragma unroll
                for (int db = 0; db < NDB; ++db) fr.v[s2][db][ln] = ld8(Vt + (((s2 * NDB + db) * 2 + h) * 32 + r) * 8); } }
}
template <class F> DEV FI void wattn_scores_fr(const int lane_, int tile, const WFrags& fr, const bf16x8 (&qf)[NSTEP][NL], f32x16 (&s)[NL], const F& f) {
    LANES { for (int i = 0; i < 16; ++i) s[ln][i] = 0.f; }
#pragma unroll
    for (int step = 0; step < NSTEP; ++step) mfma32(fr.k[step], qf[step], s);
    LANES { const int lane = LANE_OF(ln);
#pragma unroll
        for (int i = 0; i < 16; ++i) { bool v; float b; f(tile, ln, lane, i, v, b); s[ln][i] = v ? s[ln][i] + b : -3.0e38f; } }
}
template <class CB, class D, class LOK, class EM, class EOK> struct WMask { const CB& cb; const D& d; const LOK& lane_ok; const EM& elem; const EOK& elem_ok; };
template <class CB, class D, class LOK, class EM, class EOK> DEV FI WMask<CB, D, LOK, EM, EOK> make_wmask(const CB& cb, const D& d, const LOK& lok, const EM& em, const EOK& eok) { return WMask<CB, D, LOK, EM, EOK>{cb, d, lok, em, eok}; }
DEV FI bool wave_any(const bool* pr) { return wave_ballot(pr) != 0ull; }
template <class MK> DEV FI void wattn_step(const int lane_, int tile, const WFrags& fr, const bf16x8 (&qf)[NSTEP][NL], WAttn& st, const MK& mk) {
    f32x16 s[NL]; LANES { for (int i = 0; i < 16; ++i) s[ln][i] = 0.f; }
#pragma unroll
    for (int step = 0; step < NSTEP; ++step) mfma32(fr.k[step], qf[step], s);
    const bool em = mk.elem(tile);
    float mx[NL], dd[NL]; bool lok[NL];
    LANES { const int lane = LANE_OF(ln); float m = -3.0e38f;
        if (em) {
#pragma unroll
            for (int i = 0; i < 16; ++i) { const float v = mk.elem_ok(tile, ln, lane, i) ? s[ln][i] + mk.cb(i, ln) : -3.0e38f; s[ln][i] = v; m = fmaxf(m, v); }
        } else {
#pragma unroll
            for (int i = 0; i < 16; ++i) { const float v = s[ln][i] + mk.cb(i, ln); s[ln][i] = v; m = fmaxf(m, v); }
        }
        lok[ln] = mk.lane_ok(tile, ln); dd[ln] = mk.d(tile, ln);
        mx[ln] = (lok[ln] && m > -1.0e38f) ? m + dd[ln] : -3.0e38f; }
    xor32_max(mx);
    bf16x8 pf[2][NL]; bool up[NL]; float alpha[NL];
    LANES { const float mn = fmaxf(st.m[ln], mx[ln]); up[ln] = mn > st.m[ln]; alpha[ln] = fexp2(st.m[ln] - mn); st.m[ln] = mn;
        const float mref = lok[ln] ? mn - dd[ln] : 3.0e38f; float sum = 0.f;
        if (em) {
#pragma unroll
            for (int i = 0; i < 16; ++i) { const float pv = s[ln][i] > -1.0e38f ? fexp2(s[ln][i] - mref) : 0.f; sum += pv; pf[i >> 3][ln][i & 7] = (short)f2bf_s(pv); }
        } else {
#pragma unroll
            for (int i = 0; i < 16; ++i) { const float pv = fexp2(s[ln][i] - mref); sum += pv; pf[i >> 3][ln][i & 7] = (short)f2bf_s(pv); }
        }
        st.l[ln] = st.l[ln] * alpha[ln] + sum; }
    if (wave_any(up)) {
        LANES {
#pragma unroll
            for (int db = 0; db < NDB; ++db)
#pragma unroll
                for (int i = 0; i < 16; ++i) st.o[db][ln][i] *= alpha[ln]; } }
#pragma unroll
    for (int s2 = 0; s2 < 2; ++s2)
#pragma unroll
        for (int db = 0; db < NDB; ++db) mfma32(fr.v[s2][db], pf[s2], st.o[db]);
}
template <int NB, class NEXT, class FETCH, class STEP> DEV FI void wattn_run(const NEXT& next, const FETCH& fetch, const STEP& step) {
    static_assert(NB >= 2, "ring");
    WFrags fr[NB]; int tl[NB];
#pragma unroll
    for (int k = 0; k < NB - 1; ++k) { tl[k] = next(); if (tl[k] >= 0) fetch(tl[k], fr[k]); }
    for (;;) {
#pragma unroll
        for (int k = 0; k < NB; ++k) { constexpr int dummy = 0; (void)dummy; const int kn = (k + NB - 1) % NB;
            tl[kn] = next(); if (tl[kn] >= 0) fetch(tl[kn], fr[kn]);
            if (tl[k] < 0) return;
            step(tl[k], fr[k]); }
    }
}
DEV FI u64 wave_uniform_u64(u64 x) {
#ifdef CPU_TEST
    return x;
#else
    return ((u64)(unsigned)__builtin_amdgcn_readfirstlane((int)(unsigned)(x >> 32)) << 32) | (unsigned)__builtin_amdgcn_readfirstlane((int)(unsigned)x);
#endif
}
DEV FI u64 wave_or_u64(const u64* x) {
#ifdef CPU_TEST
    u64 m = 0; for (int ln = 0; ln < 64; ++ln) m |= x[ln]; return m;
#else
    unsigned lo = (unsigned)x[0], hi = (unsigned)(x[0] >> 32);
#pragma unroll
    for (int o = 32; o >= 1; o >>= 1) { lo |= (unsigned)__shfl_xor((int)lo, o); hi |= (unsigned)__shfl_xor((int)hi, o); }
    return ((u64)hi << 32) | lo;
#endif
}

static_assert(NSA_GROUP == 4 && SEQ % 64 == 0 && SEL_BLOCK == 64, "wave NSA layout");
constexpr int NTG = SEQ / 8;
DEV FI void nsa_q_frags(const int lane_, const P& p, int l, const size_t (&row)[NL], int kvh, bf16x8 (&qf)[NSTEP][NL]) {
    const bf16* H = WSP(bf16, WS_H); const float* g = p.nsa_q_norm + (size_t)l * HDIM;
    float x[NSTEP * 8][NL], ss[NL];
    LANES { const int lane = LANE_OF(ln), r = lane & 31, h = lane >> 5; const bf16* q = H + row[ln] * HP + C_NQ + (kvh * 4 + (r & 3)) * HDIM; float a = 0.f;
#pragma unroll
        for (int step = 0; step < NSTEP; ++step) { float v8[8]; ld8bf(q + 16 * step + 8 * h, v8);
#pragma unroll
            for (int j = 0; j < 8; ++j) { x[step * 8 + j][ln] = v8[j]; a += v8[j] * v8[j]; } }
        ss[ln] = a; }
    xor32_add(ss);
    LANES { const int lane = LANE_OF(ln), h = lane >> 5; const float rn = LOG2E / sqrtf((float)HDIM) * frsq(ss[ln] / (float)HDIM + EPS);
#pragma unroll
        for (int step = 0; step < NSTEP; ++step)
#pragma unroll
            for (int j = 0; j < 8; ++j) qf[step][ln][j] = (short)f2bf_s(x[step * 8 + j][ln] * rn * g[16 * step + 8 * h + j]); }
}
DEV FI void nsa_load_q(const int lane_, const P& p, int l, int b, int kvh, int t0, bf16x8 (&qf)[NSTEP][NL]) {
    size_t row[NL]; LANES { const int r = LANE_OF(ln) & 31; row[ln] = (size_t)b * SEQ + t0 + (r >> 2); }
    nsa_q_frags(lane_, p, l, row, kvh, qf);
}
DEV FI void nsa_cmp_item(const int lane_, const P& p, int l, int b, int kvh, int tg) {
    const int t0 = tg * 8;
    bf16x8 qf[NSTEP][NL]; nsa_load_q(lane_, p, l, b, kvh, t0, qf);
    const bf16* KC = WSP(bf16, WS_KCB) + ((size_t)b * NSA_KV_HEADS + kvh) * NBPP * HDIM; const bf16* VC = WSP(bf16, WS_VCB) + ((size_t)b * NSA_KV_HEADS + kvh) * NBPP * HDIM;
    const int tl = t0 + 7, nvmax = tl < CMP_BLOCK - 1 ? 0 : (tl - (CMP_BLOCK - 1)) / CMP_STRIDE + 1, ntile = (nvmax + 31) / 32;
    WAttn st; wattn_reset(st);
    auto f = [&](int tile, int ln, int lane, int i, bool& v, float& bias) { const int r = lane & 31, h = lane >> 5, t = t0 + (r >> 2), n = tile * 32 + koff_of(i, h), be = n * CMP_STRIDE + CMP_BLOCK - 1;
        v = be <= t; bias = slope2_of(kvh * 4 + (r & 3)) * (float)(be - t0); (void)ln; };
    float sl2[NL]; int hh_[NL];
    LANES { const int lane = LANE_OF(ln), r = lane & 31; sl2[ln] = slope2_of(kvh * 4 + (r & 3)); hh_[ln] = lane >> 5; }
    auto cb = [&](int i, int ln) { return sl2[ln] * (float)(koff_of(i, 0) * CMP_STRIDE); };
    { int nx = ntile - 1; auto next = [&]() { return nx >= 0 ? nx-- : -1; };
      auto fetch = [&](int tile, WFrags& fr) { wattn_fetch(lane_, KC + (size_t)tile * 32 * HDIM, VC + (size_t)tile * 32 * HDIM, 0, fr); };
      auto dfn = [&](int tile, int ln) { return sl2[ln] * (float)((tile * 32 + 4 * hh_[ln]) * CMP_STRIDE + CMP_BLOCK - 1 - t0); };
      auto lokf = [&](int, int) { return true; };
      auto emf = [&](int) { return true; };
      auto eokf = [&](int tile, int ln, int lane, int i) { const int r = lane & 31, h = lane >> 5; (void)ln; return (tile * 32 + koff_of(i, h)) * CMP_STRIDE + CMP_BLOCK - 1 <= t0 + (r >> 2); };
      const auto mk = make_wmask(cb, dfn, lokf, emf, eokf);
      auto step = [&](int tile, const WFrags& fr) { wattn_step(lane_, tile, fr, qf, st, mk); };
      wattn_run<2>(next, fetch, step); }
    float mfin[NL]; LANES mfin[ln] = st.m[ln];
    wattn_finish(st);
    float* OCMP = WSP(float, WS_OCMP); float* PP = WSP(float, WS_PP);
    LANES { const int lane = LANE_OF(ln), r = lane & 31, h = lane >> 5; const size_t row = (size_t)b * SEQ + t0 + (r >> 2); const int head = kvh * 4 + (r & 3);
#pragma unroll
        for (int db = 0; db < NDB; ++db)
#pragma unroll
            for (int q4 = 0; q4 < 4; ++q4) { const float ov[4] = {st.o[db][ln][4 * q4], st.o[db][ln][4 * q4 + 1], st.o[db][ln][4 * q4 + 2], st.o[db][ln][4 * q4 + 3]}; st4f(OCMP + row * NSAW + head * HDIM + 32 * db + 8 * q4 + 4 * h, ov); } }
    constexpr int NT = NBPP / 32, NA = 4 * NT;
    static_assert(NSEL_P == 8 * NT && SEL_M == 4 && CMP_R == 2, "in-wave selection layout");
    float A[NA][NL]; LANES { for (int k = 0; k < NA; ++k) A[k][ln] = 0.f; }
#pragma unroll
    for (int T = 0; T < NT; ++T) {
        float part[4][NL], e0[4][NL];
        if (T < ntile) {
            WFrags fr; wattn_fetch(lane_, KC + (size_t)T * 32 * HDIM, nullptr, 0, fr);
            f32x16 s[NL]; wattn_scores_fr(lane_, T, fr, qf, s, f);
            LANES { const float inv = frcp(fmaxf(st.l[ln], 1e-30f));
#pragma unroll
                for (int q4 = 0; q4 < 4; ++q4) { float pv[4];
#pragma unroll
                    for (int j = 0; j < 4; ++j) { const float sv = s[ln][4 * q4 + j]; pv[j] = sv > -1.0e38f ? fexp2(sv - mfin[ln]) * inv : 0.f; }
                    part[q4][ln] = pv[0] + 2.0f * (pv[1] + pv[2] + pv[3]); e0[q4][ln] = pv[0]; } }
#pragma unroll
            for (int q4 = 0; q4 < 4; ++q4) {
                float t1[NL]; lane_xor_f(part[q4], t1, 1); LANES part[q4][ln] += t1[ln]; lane_xor_f(part[q4], t1, 2); LANES part[q4][ln] += t1[ln];
                lane_xor_f(e0[q4], t1, 1); LANES e0[q4][ln] += t1[ln]; lane_xor_f(e0[q4], t1, 2); LANES e0[q4][ln] += t1[ln]; }
        } else { LANES { for (int q4 = 0; q4 < 4; ++q4) { part[q4][ln] = 0.f; e0[q4][ln] = 0.f; } } }
        float pe0[4][NL];
#pragma unroll
        for (int q4 = 0; q4 < 4; ++q4) lane_xor_f(e0[q4], pe0[q4], 32);
        LANES { const int h = LANE_OF(ln) >> 5;
            if (T > 0 && h == 1) A[4 * T - 1][ln] += pe0[0][ln];
#pragma unroll
            for (int q4 = 0; q4 < 4; ++q4) A[4 * T + q4][ln] = part[q4][ln] + (h == 0 ? pe0[q4][ln] : (q4 < 3 ? pe0[q4 + 1 < 4 ? q4 + 1 : 3][ln] : 0.f)); }
    }
    LANES { const int lane = LANE_OF(ln), r = lane & 31, h = lane >> 5, t = t0 + (r >> 2), cur = t / SEL_BLOCK;
#pragma unroll
        for (int k = 0; k < NA; ++k) { const int j = 8 * (k >> 2) + 2 * (k & 3) + h; const bool forced = (j == 0) || (j == cur), allowed = j * SEL_BLOCK <= t;
            A[k][ln] = forced ? POS_BIG : (allowed ? A[k][ln] : NEG_BIG); } }
    float tv[NT][NL]; int tj[NT][NL], cnt[NT][NL];
    LANES { const int lane = LANE_OF(ln), g = lane & 3, h = lane >> 5;
#pragma unroll
        for (int T = 0; T < NT; ++T) { tv[T][ln] = g == 0 ? A[4 * T][ln] : (g == 1 ? A[4 * T + 1][ln] : (g == 2 ? A[4 * T + 2][ln] : A[4 * T + 3][ln])); tj[T][ln] = 8 * T + 2 * g + h; cnt[T][ln] = 0; } }
#pragma unroll
    for (int k = 0; k < NA; ++k) { float vpk[NL]; lane_xor_f(A[k], vpk, 32);
        LANES { const int h = LANE_OF(ln) >> 5; const int io = 8 * (k >> 2) + 2 * (k & 3) + h, ip = io + 1 - 2 * h; const float vo = A[k][ln], vp = vpk[ln];
#pragma unroll
            for (int T = 0; T < NT; ++T) { const float x = tv[T][ln]; const int jj = tj[T][ln];
                cnt[T][ln] += ((vo > x || (vo == x && io < jj)) ? 1 : 0) + ((vp > x || (vp == x && ip < jj)) ? 1 : 0); } } }
    unsigned mlo[NL], mhi[NL];
    LANES { unsigned lo = 0u, hi = 0u;
#pragma unroll
        for (int T = 0; T < NT; ++T) { const int jj = tj[T][ln]; if (cnt[T][ln] < TOPK_P) { if (jj < 32) lo |= 1u << jj; else hi |= 1u << (jj - 32); } }
        mlo[ln] = lo; mhi[ln] = hi; }
    { unsigned t1[NL];
      const int xs[3] = {1, 2, 32};
#pragma unroll
      for (int q = 0; q < 3; ++q) { lane_xor_u(mlo, t1, xs[q]); LANES mlo[ln] |= t1[ln]; lane_xor_u(mhi, t1, xs[q]); LANES mhi[ln] |= t1[ln]; } }
    LANES { const int lane = LANE_OF(ln), r = lane & 31; if ((lane & 3) == 0 && lane < 32) WSP(u64, WS_SELM)[((size_t)b * SEQ + t0 + (r >> 2)) * NSA_KV_HEADS + kvh] = ((u64)mhi[ln] << 32) | mlo[ln]; }
}
static_assert(NSEL_P <= 64, "wave select: at most 64 selection blocks");
DEV FI void nsa_select_item(const int lane_, const P& p, int row, int kvh) {
    const float* Pr = WSP(float, WS_PP) + ((size_t)row * NSA_HEADS + kvh * NSA_GROUP) * NBPP;
    const int t = row % SEQ, cur = t / SEL_BLOCK;
    float sc[NL];
    LANES { const int j = LANE_OF(ln); float a = 0.f;
        if (j < NSEL_P) { for (int mm = 0; mm < SEL_M; ++mm) for (int r = 0; r < CMP_R; ++r) { const int n = j * SEL_M + mm + r; if (n < NBP) for (int g = 0; g < NSA_GROUP; ++g) a += Pr[(size_t)g * NBPP + n]; }
            const bool forced = (j == 0) || (j == cur), allowed = j * SEL_BLOCK <= t; sc[ln] = forced ? POS_BIG : (allowed ? a : NEG_BIG); }
        else sc[ln] = -3.4e38f; }
    bool sel[NL]; int cnt[NL]; LANES cnt[ln] = 0;
    for (int i = 0; i < NSEL_P; ++i) { const float v = wave_bcast(sc, i); LANES { const int j = LANE_OF(ln); cnt[ln] += (v > sc[ln] || (v == sc[ln] && i < j)) ? 1 : 0; } }
    LANES { const int j = LANE_OF(ln); sel[ln] = j < NSEL_P && cnt[ln] < TOPK_P; }
    const u64 m = wave_ballot(sel);
    LANES { if (LANE_OF(ln) == 0) WSP(u64, WS_SELM)[(size_t)row * NSA_KV_HEADS + kvh] = m; }
}
DEV FI void nsa_selwin_item(const int lane_, const P& p, int l, int b, int kvh, int tg) {
    const int t0 = tg * 8, cur = t0 / SEL_BLOCK;
    bf16x8 qf[NSTEP][NL]; nsa_load_q(lane_, p, l, b, kvh, t0, qf);
    const size_t bk = (size_t)b * NSA_KV_HEADS + kvh;
    u64 msk[NL]; LANES { const int r = LANE_OF(ln) & 31; msk[ln] = WSP(u64, WS_SELM)[((size_t)b * SEQ + t0 + (r >> 2)) * NSA_KV_HEADS + kvh]; }
    WAttn st; wattn_reset(st);
    float sl2[NL]; int hh_[NL];
    LANES { const int lane = LANE_OF(ln), r = lane & 31; sl2[ln] = slope2_of(kvh * 4 + (r & 3)); hh_[ln] = lane >> 5; }
    auto cb = [&](int i, int ln) { return sl2[ln] * (float)koff_of(i, 0); };
    auto dfn = [&](int tile, int ln) { return sl2[ln] * (float)(tile * 32 + 4 * hh_[ln] - t0); };
    { const bf16* KS = WSP(bf16, WS_KSN) + bk * SEQ * HDIM; const bf16* VS = WSP(bf16, WS_VSP) + bk * SEQ * HDIM;
      u64 U = wave_uniform_u64(wave_or_u64(msk)); if (cur < 63) U &= (2ull << cur) - 1ull;
      int half = 1;
      auto next = [&]() { if (U == 0ull) return -1; const int j = 63 - (int)__builtin_clzll(U); const int tile = 2 * j + half; if (!half) U &= ~(1ull << j); half ^= 1; return tile; };
      auto fetch = [&](int tile, WFrags& fr) { wattn_fetch(lane_, KS + (size_t)tile * 32 * HDIM, VS + (size_t)tile * 32 * HDIM, 0, fr); };
      auto lokf = [&](int tile, int ln) { return (bool)((msk[ln] >> (tile >> 1)) & 1ull); };
      auto emf = [&](int tile) { return (tile >> 1) == cur; };
      auto eokf = [&](int tile, int ln, int lane, int i) { const int r = lane & 31, h = lane >> 5; (void)ln; return tile * 32 + koff_of(i, h) <= t0 + (r >> 2); };
      const auto mk = make_wmask(cb, dfn, lokf, emf, eokf);
      auto step = [&](int tile, const WFrags& fr) { wattn_step(lane_, tile, fr, qf, st, mk); };
      wattn_run<WATTN_NB>(next, fetch, step); }
    wattn_finish(st);
    f32x16 osel[NDB][NL]; LANES { for (int db = 0; db < NDB; ++db) osel[db][ln] = st.o[db][ln]; }
    wattn_reset(st);
    { const bf16* KW = WSP(bf16, WS_KWN) + bk * SEQ * HDIM; const bf16* VW = WSP(bf16, WS_VWP) + bk * SEQ * HDIM;
      int lo = t0 - WINDOW + 1; if (lo < 0) lo = 0;
      const int first = lo / 32; int nx = (t0 + 7) / 32;
      auto next = [&]() { return nx >= first ? nx-- : -1; };
      auto fetch = [&](int tile, WFrags& fr) { wattn_fetch(lane_, KW + (size_t)tile * 32 * HDIM, VW + (size_t)tile * 32 * HDIM, 0, fr); };
      auto lokf = [&](int, int) { return true; };
      auto emf = [&](int tile) { return tile * 32 + 31 > t0 || tile * 32 <= t0 + 7 - WINDOW; };
      auto eokf = [&](int tile, int ln, int lane, int i) { const int r = lane & 31, h = lane >> 5, t = t0 + (r >> 2), kpos = tile * 32 + koff_of(i, h); (void)ln; return kpos <= t && kpos > t - WINDOW; };
      const auto mk = make_wmask(cb, dfn, lokf, emf, eokf);
      auto step = [&](int tile, const WFrags& fr) { wattn_step(lane_, tile, fr, qf, st, mk); };
      wattn_run<WATTN_NB>(next, fetch, step); }
    wattn_finish(st);
    const bf16* H = WSP(bf16, WS_H); const float* OCMP = WSP(float, WS_OCMP); bf16* OCAT = WSP(bf16, WS_OCAT);
    LANES { const int lane = LANE_OF(ln), r = lane & 31, h = lane >> 5; const size_t row = (size_t)b * SEQ + t0 + (r >> 2); const int head = kvh * 4 + (r & 3);
        const bf16* bgp = H + row * HP + C_NBG + head * 3;
        const float b0 = sigmoidf_(bf2f(bgp[0])), b1 = sigmoidf_(bf2f(bgp[1])), b2 = sigmoidf_(bf2f(bgp[2]));
#pragma unroll
        for (int db = 0; db < NDB; ++db)
#pragma unroll
            for (int i = 0; i < 16; ++i) { const int d = 32 * db + koff_of(i, h);
                OCAT[row * KBR + HGW + head * HDIM + d] = f2bf(b0 * OCMP[row * NSAW + head * HDIM + d] + b1 * osel[db][ln][i] + b2 * st.o[db][ln][i]); } }
}
DEV FI void phw_nsa_cmp(const int lane_, const P& p, int l, int xc, int nxc, int wl, int nwl) {
    for (int bkv = xc; bkv < BATCH * NSA_KV_HEADS; bkv += nxc)
        for (int tgi = wl; tgi < NTG; tgi += nwl) { const int tg = tgi < NTG / 2 ? 2 * tgi : 2 * (NTG - 1 - tgi) + 1; nsa_cmp_item(lane_fresh(lane_), p, l, bkv / NSA_KV_HEADS, bkv % NSA_KV_HEADS, tg); }
}
DEV FI void phw_nsa_select(const int lane_, const P& p, int wv, int nw) {
    for (int it = wv; it < NP * NSA_KV_HEADS; it += nw) nsa_select_item(lane_fresh(lane_), p, it / NSA_KV_HEADS, it % NSA_KV_HEADS);
}
DEV FI void phw_nsa_selwin(const int lane_, const P& p, int l, int xc, int nxc, int wl, int nwl) {
    for (int bkv = xc; bkv < BATCH * NSA_KV_HEADS; bkv += nxc)
        for (int tgi = wl; tgi < NTG; tgi += nwl) { const int tg = tgi < NTG / 2 ? 2 * tgi : 2 * (NTG - 1 - tgi) + 1;
            nsa_selwin_item(lane_fresh(lane_), p, l, bkv / NSA_KV_HEADS, bkv % NSA_KV_HEADS, tg); }
}

constexpr int RK = HG_DK, RV = HG_DV, RKS = RK / 16, RVB = RV / 32, RKB = RK / 32;
static_assert(RK % 32 == 0 && RV % 32 == 0, "recurrence head dims");
template <int REC> DEV FI void rec_ds_item(const int lane_, const P& p, int b, int h, int c, int vb) {
    constexpr int C = REC ? RET_C : HG_C, NCH = REC ? RET_NCH : HG_NCH;
    const size_t bh = (size_t)b * HG_HEADS + h;
    const bf16* VP = WSP(bf16, REC ? WS_RVP : WS_HVP) + bh * RV * SEQ + (size_t)c * C; const bf16* KE = WSP(bf16, REC ? WS_RKE : WS_HKE) + bh * RK * SEQ + (size_t)c * C;
    bf16* dS = WSP(bf16, REC ? WS_RDS : WS_HDS) + (bh * NCH + c) * RV * RK;
    f32x16 acc[RKB][NL]; LANES { for (int kb = 0; kb < RKB; ++kb) for (int i = 0; i < 16; ++i) acc[kb][ln][i] = 0.f; }
#pragma unroll
    for (int st = 0; st < C / 16; ++st) { bf16x8 af[NL];
        LANES { const int lane = LANE_OF(ln), r = lane & 31, hh = lane >> 5; af[ln] = ld8(VP + (size_t)(32 * vb + r) * SEQ + 16 * st + 8 * hh); }
#pragma unroll
        for (int kb = 0; kb < RKB; ++kb) { bf16x8 bfr[NL]; LANES { const int lane = LANE_OF(ln), r = lane & 31, hh = lane >> 5; bfr[ln] = ld8(KE + (size_t)(32 * kb + r) * SEQ + 16 * st + 8 * hh); } mfma32(af, bfr, acc[kb]); } }
#pragma unroll
    for (int kb = 0; kb < RKB; ++kb) {
        LANES { const int lane = LANE_OF(ln), r = lane & 31, hh = lane >> 5;
#pragma unroll
            for (int i = 0; i < 16; ++i) dS[(size_t)(32 * vb + koff_of(i, hh)) * RK + 32 * kb + r] = f2bf(acc[kb][ln][i]); }
        SCHED_FENCE(); }
}
template <int REC> DEV FI void rec_out_item(const int lane_, const P& p, int l, int b, int h, int tile) {
    constexpr int C = REC ? RET_C : HG_C, NCH = REC ? RET_NCH : HG_NCH;
    const int c = tile * 32 / C, half = (tile * 32 % C) / 32;
    const size_t bh = (size_t)b * HG_HEADS + h; const bf16* H = WSP(bf16, WS_H);
    bf16x8 qf[RKS][NL];
    LANES { const int lane = LANE_OF(ln), r = lane & 31, hh = lane >> 5;
        const bf16* qrow = REC ? H + (size_t)(b * SEQ + tile * 32 + r) * HP + C_RQ + h * RK : WSP(bf16, WS_HQT) + (bh * SEQ + tile * 32 + r) * RK;
#pragma unroll
        for (int ks = 0; ks < RKS; ++ks) qf[ks][ln] = ld8(qrow + 16 * ks + 8 * hh); }
    bf16x8 kf0[RKS][NL];
    LANES { const int lane = LANE_OF(ln), r = lane & 31, hh = lane >> 5; const int stile0 = c * (C / 32);
        const bf16* krow = REC ? H + (size_t)(b * SEQ + stile0 * 32 + r) * HP + C_RK + h * RK : WSP(bf16, WS_HKT) + (bh * SEQ + stile0 * 32 + r) * RK;
#pragma unroll
        for (int ks = 0; ks < RKS; ++ks) kf0[ks][ln] = ld8(krow + 16 * ks + 8 * hh); }
    f32x16 o[RVB][NL]; LANES { for (int vb = 0; vb < RVB; ++vb) for (int i = 0; i < 16; ++i) o[vb][ln][i] = 0.f; }
    { const bf16* SC = WSP(bf16, REC ? WS_RSC : WS_HSC) + (bh * NCH + c) * RV * RK;
#pragma unroll
      for (int vb = 0; vb < RVB; ++vb) {
#pragma unroll
        for (int ks = 0; ks < RKS; ++ks) { bf16x8 af[NL]; LANES { const int lane = LANE_OF(ln), r = lane & 31, hh = lane >> 5; af[ln] = ld8(SC + (size_t)(32 * vb + r) * RK + 16 * ks + 8 * hh); } mfma32(af, qf[ks], o[vb]); } SCHED_FENCE(); } }
    const float lg2 = REC ? log2f(1.0f - fexp2(-5.0f - (float)h)) : 0.f;
    if (REC) { LANES { const int r = LANE_OF(ln) & 31; const float fct = fexp2(lg2 * (float)(half * 32 + r + 1));
#pragma unroll
        for (int vb = 0; vb < RVB; ++vb)
#pragma unroll
            for (int i = 0; i < 16; ++i) o[vb][ln][i] *= fct; } }
    const bf16* VP = WSP(bf16, REC ? WS_RVP : WS_HVP) + bh * RV * SEQ;
    for (int st = 0; st <= half; ++st) {
        const int stile = c * (C / 32) + st;
        f32x16 a[NL]; LANES { for (int i = 0; i < 16; ++i) a[ln][i] = 0.f; }
        if (st == 0) {
#pragma unroll
            for (int ks = 0; ks < RKS; ++ks) mfma32(kf0[ks], qf[ks], a);
        } else {
#pragma unroll
            for (int ks = 0; ks < RKS; ++ks) { bf16x8 kf[NL];
                LANES { const int lane = LANE_OF(ln), r = lane & 31, hh = lane >> 5;
                    const bf16* krow = REC ? H + (size_t)(b * SEQ + stile * 32 + r) * HP + C_RK + h * RK : WSP(bf16, WS_HKT) + (bh * SEQ + stile * 32 + r) * RK;
                    kf[ln] = ld8(krow + 16 * ks + 8 * hh); }
                mfma32(kf, qf[ks], a); }
        }
        bf16x8 pf[2][NL];
        LANES { const int lane = LANE_OF(ln), r = lane & 31, hh = lane >> 5, tc = half * 32 + r;
#pragma unroll
            for (int i = 0; i < 16; ++i) { const int sc = st * 32 + koff_of(i, hh); float v = a[ln][i];
                v = sc <= tc ? (REC ? v * fexp2(lg2 * (float)(tc - sc)) : v) : 0.f; pf[i >> 3][ln][i & 7] = (short)f2bf_s(v); } }
#pragma unroll
        for (int s2 = 0; s2 < 2; ++s2)
#pragma unroll
            for (int vb = 0; vb < RVB; ++vb) { bf16x8 vf[NL]; LANES { const int lane = LANE_OF(ln), r = lane & 31, hh = lane >> 5; vf[ln] = ld8(VP + (size_t)(32 * vb + r) * SEQ + stile * 32 + 16 * s2 + 8 * hh); } mfma32(vf, pf[s2], o[vb]); }
        SCHED_FENCE();
    }
    float s1[NL], s2v[NL];
    if (REC) { const float qs = 1.0f / sqrtf((float)RK);
        LANES { float a = 0.f;
#pragma unroll
            for (int vb = 0; vb < RVB; ++vb)
#pragma unroll
                for (int i = 0; i < 16; ++i) { o[vb][ln][i] *= qs; a += o[vb][ln][i]; }
            s1[ln] = a; }
        xor32_add(s1);
        LANES { const float mu = s1[ln] / (float)RV; float a = 0.f;
#pragma unroll
            for (int vb = 0; vb < RVB; ++vb)
#pragma unroll
                for (int i = 0; i < 16; ++i) { o[vb][ln][i] -= mu; a += o[vb][ln][i] * o[vb][ln][i]; }
            s2v[ln] = a; }
        xor32_add(s2v);
    } else {
        LANES { float a = 0.f;
#pragma unroll
            for (int vb = 0; vb < RVB; ++vb)
#pragma unroll
                for (int i = 0; i < 16; ++i) a += o[vb][ln][i] * o[vb][ln][i];
            s2v[ln] = a; }
        xor32_add(s2v);
    }
    bf16* OCAT = WSP(bf16, WS_OCAT); const float* gn = p.hg_out_norm + (size_t)l * HG_DV;
    LANES { const int lane = LANE_OF(ln), r = lane & 31, hh = lane >> 5; const size_t row = (size_t)b * SEQ + tile * 32 + r;
        const float rs = frsq(s2v[ln] / (float)RV + EPS);
#pragma unroll
        for (int vb = 0; vb < RVB; ++vb) {
#pragma unroll
            for (int q4 = 0; q4 < 4; ++q4) { const int v0 = 32 * vb + 8 * q4 + 4 * hh;
                float g[4], ov[4]; ld4bf(H + row * HP + (REC ? C_RG : C_HG) + h * RV + v0, g);
#pragma unroll
                for (int j = 0; j < 4; ++j) ov[j] = o[vb][ln][4 * q4 + j] * rs * (REC ? 1.0f : gn[v0 + j]) * siluf_(g[j]);
                st4bf(OCAT + row * KBR + (REC ? HGW + NSAW : 0) + h * RV + v0, ov); }
            SCHED_FENCE(); } }
}
DEV FI void phw_rec_ds(const int lane_, const P& p, int wv, int nw) {
    const int nH = BATCH * HG_HEADS * HG_NCH * RVB, nR = BATCH * RET_HEADS * RET_NCH * RVB;
    for (int it = wv; it < nH + nR; it += nw) {
        if (it < nH) { const int vb = it % RVB, c = (it / RVB) % HG_NCH, h = (it / (RVB * HG_NCH)) % HG_HEADS, b = it / (RVB * HG_NCH * HG_HEADS); rec_ds_item<0>(lane_fresh(lane_), p, b, h, c, vb); }
        else { const int j = it - nH; const int vb = j % RVB, c = (j / RVB) % RET_NCH, h = (j / (RVB * RET_NCH)) % RET_HEADS, b = j / (RVB * RET_NCH * RET_HEADS); rec_ds_item<1>(lane_fresh(lane_), p, b, h, c, vb); }
    }
}
template <int REC> DEV FI void rec_chain_item(const int lane_, const P& p, int l, int b, int h, int vb, int kb) {
    constexpr int C = REC ? RET_C : HG_C, NCH = REC ? RET_NCH : HG_NCH, NST = C / 16, CB = REC ? 4 : 8;
    static_assert(NCH % CB == 0, "chain batches");
    const size_t bh = (size_t)b * HG_HEADS + h;
    const bf16* VP = WSP(bf16, REC ? WS_RVP : WS_HVP) + bh * RV * SEQ; const bf16* KE = WSP(bf16, REC ? WS_RKE : WS_HKE) + bh * RK * SEQ;
    bf16* SC = WSP(bf16, REC ? WS_RSC : WS_HSC) + bh * NCH * RV * RK;
    const float* dec = WSP(float, WS_HDEC) + bh * HG_NCH * HG_DK + 32 * kb;
    const float gc = REC ? exp2f(log2f(1.0f - exp2f(-5.0f - (float)h)) * (float)RET_C) : 0.f;
    f32x16 S[NL]; LANES { for (int i = 0; i < 16; ++i) S[ln][i] = 0.f; }
#pragma unroll 1
    for (int c0 = 0; c0 < NCH; c0 += CB) {
        bf16x8 af[CB][NST][NL], bfr[CB][NST][NL]; float e[CB][NL];
#pragma unroll
        for (int j = 0; j < CB; ++j) {
            LANES { const int lane = LANE_OF(ln), r = lane & 31, hh = lane >> 5;
#pragma unroll
                for (int st = 0; st < NST; ++st) { af[j][st][ln] = ld8(VP + (size_t)(32 * vb + r) * SEQ + (size_t)(c0 + j) * C + 16 * st + 8 * hh); bfr[j][st][ln] = ld8(KE + (size_t)(32 * kb + r) * SEQ + (size_t)(c0 + j) * C + 16 * st + 8 * hh); }
                e[j][ln] = REC ? gc : dec[(size_t)(c0 + j) * HG_DK + r]; } }
#pragma unroll
        for (int j = 0; j < CB; ++j) {
            bf16* sc = SC + (size_t)(c0 + j) * RV * RK;
            LANES { const int lane = LANE_OF(ln), r = lane & 31, hh = lane >> 5;
#pragma unroll
                for (int i = 0; i < 16; ++i) { sc[(size_t)(32 * vb + koff_of(i, hh)) * RK + 32 * kb + r] = f2bf(S[ln][i]); S[ln][i] *= e[j][ln]; } }
#pragma unroll
            for (int st = 0; st < NST; ++st) mfma32(af[j][st], bfr[j][st], S);
        }
    }
    float* o = p.out + (REC ? O_RP : O_HP) + (((size_t)l * BATCH + b) * HG_HEADS + h) * RK * RV;
    LANES { const int lane = LANE_OF(ln), r = lane & 31, hh = lane >> 5;
#pragma unroll
        for (int q4 = 0; q4 < 4; ++q4) { const float t[4] = {S[ln][4 * q4], S[ln][4 * q4 + 1], S[ln][4 * q4 + 2], S[ln][4 * q4 + 3]}; st4f(o + (size_t)(32 * kb + r) * RV + 32 * vb + 8 * q4 + 4 * hh, t); } }
}
DEV FI void phw_rec_chain(const int lane_, const P& p, int l, int slot, int nslots) {
    constexpr int PER = RVB * RKB, nG = BATCH * HG_HEADS;
    for (int it = slot; it < 2 * nG * PER; it += nslots) { const int g = it / PER, idx = it % PER, vb = idx / RKB, kb = idx % RKB, bh = g >> 1;
        if (g & 1) rec_chain_item<1>(lane_fresh(lane_), p, l, bh / HG_HEADS, bh % HG_HEADS, vb, kb); else rec_chain_item<0>(lane_fresh(lane_), p, l, bh / HG_HEADS, bh % HG_HEADS, vb, kb); }
}
DEV FI void phw_rec_out(const int lane_, const P& p, int l, int wv, int nw) {
    const int nT = BATCH * HG_HEADS * (SEQ / 32);
    for (int it = wv; it < 2 * nT; it += nw) { const int j = it >> 1; const int tile = j % (SEQ / 32), h = (j / (SEQ / 32)) % HG_HEADS, b = j / ((SEQ / 32) * HG_HEADS);
        if (((it & 1) ^ ((j / ((nw + 1) / 2)) & 1)) != 0) rec_out_item<1>(lane_fresh(lane_), p, l, b, h, tile); else rec_out_item<0>(lane_fresh(lane_), p, l, b, h, tile); }
}
DEV FI void phw_rec_out_x(const int lane_, const P& p, int l, int xc, int nxc, int wl, int nwl) {
    for (int bh = xc; bh < BATCH * HG_HEADS; bh += nxc)
        for (int idx = wl; idx < 2 * (SEQ / 32); idx += nwl) { const int tile = idx >> 1, b = bh / HG_HEADS, h = bh % HG_HEADS;
            if ((((idx & 1) ^ (bh / nxc)) & 1) != 0) rec_out_item<1>(lane_fresh(lane_), p, l, b, h, tile); else rec_out_item<0>(lane_fresh(lane_), p, l, b, h, tile); }
}

static_assert(DEC_SEQ == 4 && PAGE_SIZE % 32 == 0 && (PAST_LEN - WINBUF) % 32 == 0 && NBS % 32 == 0, "wave NSA, sample group");
constexpr int SQW = (NSEL_S + 63) / 64;
struct TileSrc { const float* f; const bf16* b; int stride, nvalid; };
DEV FI float ts_at(const TileSrc& s, int ko, int d) { if (ko >= s.nvalid) return 0.f; return s.f ? s.f[(size_t)ko * s.stride + d] : bf2f(s.b[(size_t)ko * s.stride + d]); }
DEV FI TileSrc sel_tile_src(const P& p, const bf16* H, int l, int sb, int kpos0, int c, int kvh) {
    TileSrc s; s.f = nullptr; s.b = nullptr; s.stride = 0; s.nvalid = 0;
    if (kpos0 < PAST_LEN) { const int page = p.page_table[sb * NPAGES + kpos0 / PAGE_SIZE];
        s.f = p.cache_nsa + (((size_t)l * NPOOL + page) * PAGE_SIZE + kpos0 % PAGE_SIZE) * ROWF + c * NSAKVW + kvh * HDIM; s.stride = ROWF; s.nvalid = 32; }
    else { const int off = kpos0 - PAST_LEN; int nv = DEC_SEQ - off; nv = nv < 0 ? 0 : (nv > 32 ? 32 : nv);
        s.b = H + (size_t)(NP + sb * DEC_SEQ + (nv > 0 ? off : 0)) * HP + C_NKV + c * NSAKVW + kvh * HDIM; s.stride = HP; s.nvalid = nv; }
    return s;
}
DEV FI TileSrc win_tile_src(const P& p, const bf16* H, int l, int sb, int kpos0, int c, int kvh) {
    TileSrc s; s.f = nullptr; s.b = nullptr; s.stride = 0; s.nvalid = 0;
    if (kpos0 < PAST_LEN) { s.f = p.cache_win + (((size_t)l * DEC_BATCH + sb) * WINBUF + (kpos0 - (PAST_LEN - WINBUF))) * WROWF + c * NSAKVW + kvh * HDIM; s.stride = WROWF; s.nvalid = 32; }
    else { const int off = kpos0 - PAST_LEN; int nv = DEC_SEQ - off; nv = nv < 0 ? 0 : (nv > 32 ? 32 : nv);
        s.b = H + (size_t)(NP + sb * DEC_SEQ + (nv > 0 ? off : 0)) * HP + C_NWKV + c * NSAKVW + kvh * HDIM; s.stride = HP; s.nvalid = nv; }
    return s;
}
DEV FI void build_kf(const int lane_, const TileSrc& ks, const float* gk, bf16x8 (&kf)[NSTEP][NL]) {
    float x[NSTEP * 8][NL]; float ss[NL];
    LANES { const int lane = LANE_OF(ln), r = lane & 31, h = lane >> 5; float a = 0.f;
#pragma unroll
        for (int step = 0; step < NSTEP; ++step)
#pragma unroll
            for (int j = 0; j < 8; ++j) { const float v = ts_at(ks, r, 16 * step + 8 * h + j); x[step * 8 + j][ln] = v; a += v * v; }
        ss[ln] = a; }
    xor32_add(ss);
    LANES { const int lane = LANE_OF(ln), h = lane >> 5; const float rn = frsq(ss[ln] / (float)HDIM + EPS);
#pragma unroll
        for (int step = 0; step < NSTEP; ++step)
#pragma unroll
            for (int j = 0; j < 8; ++j) kf[step][ln][j] = (short)f2bf_s(x[step * 8 + j][ln] * rn * gk[16 * step + 8 * h + j]); }
}
template <class F> DEV FI void wattn_tile_src(const int lane_, const bf16x8 (&kf)[NSTEP][NL], const TileSrc& vs, const bf16x8 (&qf)[NSTEP][NL], WAttn& st, const F& f) {
    float xv[2][NDB][8][NL];
    LANES { const int lane = LANE_OF(ln), r = lane & 31, h = lane >> 5;
#pragma unroll
        for (int s2 = 0; s2 < 2; ++s2)
#pragma unroll
            for (int db = 0; db < NDB; ++db)
#pragma unroll
                for (int j = 0; j < 8; ++j) xv[s2][db][j][ln] = ts_at(vs, 16 * s2 + 8 * (j >> 2) + 4 * h + (j & 3), 32 * db + r); }
    f32x16 s[NL]; LANES { for (int i = 0; i < 16; ++i) s[ln][i] = 0.f; }
#pragma unroll
    for (int step = 0; step < NSTEP; ++step) mfma32(kf[step], qf[step], s);
    LANES { const int lane = LANE_OF(ln);
#pragma unroll
        for (int i = 0; i < 16; ++i) { bool v; float b; f(ln, lane, i, v, b); s[ln][i] = v ? s[ln][i] + b : -3.0e38f; } }
    float mx[NL]; LANES { float m = -3.0e38f;
#pragma unroll
        for (int i = 0; i < 16; ++i) m = fmaxf(m, s[ln][i]); mx[ln] = m; }
    xor32_max(mx);
    bf16x8 pf[2][NL];
    LANES { const float mn = fmaxf(st.m[ln], mx[ln]), alpha = fexp2(st.m[ln] - mn); float sum = 0.f;
#pragma unroll
        for (int i = 0; i < 16; ++i) { const float pv = s[ln][i] > -1.0e38f ? fexp2(s[ln][i] - mn) : 0.f; sum += pv; pf[i >> 3][ln][i & 7] = (short)f2bf_s(pv); }
        st.l[ln] = st.l[ln] * alpha + sum; st.m[ln] = mn;
#pragma unroll
        for (int db = 0; db < NDB; ++db)
#pragma unroll
            for (int i = 0; i < 16; ++i) st.o[db][ln][i] *= alpha; }
#pragma unroll
    for (int s2 = 0; s2 < 2; ++s2)
#pragma unroll
        for (int db = 0; db < NDB; ++db) { bf16x8 vf[NL];
            LANES {
#pragma unroll
                for (int j = 0; j < 8; ++j) vf[ln][j] = (short)f2bf_s(xv[s2][db][j][ln]); }
            mfma32(vf, pf[s2], st.o[db]); }
}
DEV FI void nsa_load_q_s(const int lane_, const P& p, int l, int sb, int kvh, bf16x8 (&qf)[NSTEP][NL]) {
    size_t row[NL]; LANES { const int r = LANE_OF(ln) & 31; row[ln] = (size_t)NP + sb * DEC_SEQ + ((r >> 2) & (DEC_SEQ - 1)); }
    nsa_q_frags(lane_, p, l, row, kvh, qf);
}
DEV FI void nsa_cmp_item_s(const int lane_, const P& p, int l, int sb, int kvh) {
    bf16x8 qf[NSTEP][NL]; nsa_load_q_s(lane_, p, l, sb, kvh, qf);
    const bf16* KC = WSP(bf16, WS_KCSB + l * SZ_KCS) + ((size_t)sb * NSA_KV_HEADS + kvh) * NBS * HDIM; const bf16* VC = WSP(bf16, WS_VCSB + l * SZ_KCS) + ((size_t)sb * NSA_KV_HEADS + kvh) * NBS * HDIM;
    WAttn st; wattn_reset(st);
    for (int tile = 0; tile < NBS / 32; ++tile) {
        auto f = [&](int ln, int lane, int i, bool& v, float& bias) { const int r = lane & 31, h = lane >> 5, t = PAST_LEN + ((r >> 2) & (DEC_SEQ - 1)), n = tile * 32 + koff_of(i, h), be = n * CMP_STRIDE + CMP_BLOCK - 1;
            v = be <= t; bias = slope2_of(kvh * 4 + (r & 3)) * (float)(be - PAST_LEN); (void)ln; };
        wattn_tile(lane_, KC + (size_t)tile * 32 * HDIM, VC + (size_t)tile * 32 * HDIM, 0, qf, st, f);
    }
    float mfin[NL]; LANES mfin[ln] = st.m[ln];
    wattn_finish(st);
    float* OCMP = WSP(float, WS_OCMP); float* PS = WSP(float, WS_PS);
    LANES { const int lane = LANE_OF(ln), r = lane & 31, h = lane >> 5; const size_t row = (size_t)NP + sb * DEC_SEQ + (r >> 2); const int head = kvh * 4 + (r & 3);
        if ((r >> 2) < DEC_SEQ) {
#pragma unroll
            for (int db = 0; db < NDB; ++db)
#pragma unroll
                for (int i = 0; i < 16; ++i) OCMP[row * NSAW + head * HDIM + 32 * db + koff_of(i, h)] = st.o[db][ln][i]; } }
    for (int tile = 0; tile < NBS / 32; ++tile) {
        f32x16 s[NL];
        auto f = [&](int ln, int lane, int i, bool& v, float& bias) { const int r = lane & 31, h = lane >> 5, t = PAST_LEN + ((r >> 2) & (DEC_SEQ - 1)), n = tile * 32 + koff_of(i, h), be = n * CMP_STRIDE + CMP_BLOCK - 1;
            v = be <= t; bias = slope2_of(kvh * 4 + (r & 3)) * (float)(be - PAST_LEN); (void)ln; };
        wattn_scores(lane_, KC + (size_t)tile * 32 * HDIM, qf, s, f);
        LANES { const int lane = LANE_OF(ln), r = lane & 31, h = lane >> 5; const size_t srow = (size_t)sb * DEC_SEQ + (r >> 2); const int head = kvh * 4 + (r & 3);
            const float inv = frcp(fmaxf(st.l[ln], 1e-30f));
            if ((r >> 2) < DEC_SEQ) {
#pragma unroll
                for (int i = 0; i < 16; ++i) PS[(srow * NSA_HEADS + head) * NBS + tile * 32 + koff_of(i, h)] = s[ln][i] > -1.0e38f ? fexp2(s[ln][i] - mfin[ln]) * inv : 0.f; } }
    }
}
DEV FI void nsa_select_item_s(const int lane_, const P& p, int srow, int kvh) {
    const float* Pr = WSP(float, WS_PS) + ((size_t)srow * NSA_HEADS + kvh * NSA_GROUP) * NBS;
    const int pos = PAST_LEN + srow % DEC_SEQ, cur = pos / SEL_BLOCK;
    float sc[SQW][NL]; int cnt[SQW][NL];
    LANES { for (int q = 0; q < SQW; ++q) { const int j = LANE_OF(ln) + 64 * q; float a = 0.f; cnt[q][ln] = 0;
        if (j < NSEL_S) { for (int mm = 0; mm < SEL_M; ++mm) for (int r = 0; r < CMP_R; ++r) { const int n = j * SEL_M + mm + r; if (n < NBS) for (int g = 0; g < NSA_GROUP; ++g) a += Pr[(size_t)g * NBS + n]; }
            const bool forced = (j == 0) || (j == cur), allowed = j * SEL_BLOCK <= pos; sc[q][ln] = forced ? POS_BIG : (allowed ? a : NEG_BIG); }
        else sc[q][ln] = -3.4e38f; } }
#pragma unroll
    for (int qi = 0; qi < SQW; ++qi)
        for (int ii = 0; ii < 64 && qi * 64 + ii < NSEL_S; ++ii) { const int i = qi * 64 + ii; const float v = wave_bcast(sc[qi], ii);
            LANES {
#pragma unroll
                for (int q = 0; q < SQW; ++q) { const int j = LANE_OF(ln) + 64 * q; cnt[q][ln] += (v > sc[q][ln] || (v == sc[q][ln] && i < j)) ? 1 : 0; } } }
#pragma unroll
    for (int q = 0; q < SQW; ++q) { bool sel[NL]; LANES { const int j = LANE_OF(ln) + 64 * q; sel[ln] = j < NSEL_S && cnt[q][ln] < TOPK_S; }
        const u64 m = wave_ballot(sel);
        LANES { if (LANE_OF(ln) == 0) WSP(u64, WS_SELMS)[((size_t)srow * NSA_KV_HEADS + kvh) * SQW + q] = m; } }
}
DEV FI void nsa_selwin_item_s(const int lane_, const P& p, int l, int sb, int kvh) {
    bf16x8 qf[NSTEP][NL]; nsa_load_q_s(lane_, p, l, sb, kvh, qf);
    const bf16* H = WSP(bf16, WS_H);
    const float* gks = p.nsa_k_norm + ((size_t)l * 3 + 1) * HDIM; const float* gkw = p.nsa_k_norm + ((size_t)l * 3 + 2) * HDIM;
    const u64* MS = WSP(u64, WS_SELMS);
    WAttn st; wattn_reset(st);
    for (int j = 0; j < NSEL_S; ++j) {
        bool sj[NL]; LANES { const int r = LANE_OF(ln) & 31; const size_t srow = (size_t)sb * DEC_SEQ + ((r >> 2) & (DEC_SEQ - 1)); sj[ln] = (MS[(srow * NSA_KV_HEADS + kvh) * SQW + (j >> 6)] >> (j & 63)) & 1ull; }
        if (wave_ballot(sj) == 0ull) continue;
        for (int half = 0; half < 2; ++half) { const int kpos0 = j * SEL_BLOCK + half * 32;
            bf16x8 kf[NSTEP][NL]; build_kf(lane_, sel_tile_src(p, H, l, sb, kpos0, 2, kvh), gks, kf);
            auto f = [&](int ln, int lane, int i, bool& v, float& bias) { const int r = lane & 31, h = lane >> 5, t = PAST_LEN + ((r >> 2) & (DEC_SEQ - 1)), kpos = kpos0 + koff_of(i, h);
                v = sj[ln] && kpos <= t; bias = slope2_of(kvh * 4 + (r & 3)) * (float)(kpos - PAST_LEN); };
            wattn_tile_src(lane_, kf, sel_tile_src(p, H, l, sb, kpos0, 3, kvh), qf, st, f); }
    }
    wattn_finish(st);
    f32x16 osel[NDB][NL]; LANES { for (int db = 0; db < NDB; ++db) osel[db][ln] = st.o[db][ln]; }
    wattn_reset(st);
    for (int kpos0 = PAST_LEN - WINBUF; kpos0 < PAST_LEN + DEC_SEQ; kpos0 += 32) {
        bf16x8 kf[NSTEP][NL]; build_kf(lane_, win_tile_src(p, H, l, sb, kpos0, 0, kvh), gkw, kf);
        auto f = [&](int ln, int lane, int i, bool& v, float& bias) { const int r = lane & 31, h = lane >> 5, t = PAST_LEN + ((r >> 2) & (DEC_SEQ - 1)), kpos = kpos0 + koff_of(i, h);
            v = kpos <= t && kpos > t - WINDOW; bias = slope2_of(kvh * 4 + (r & 3)) * (float)(kpos - PAST_LEN); (void)ln; };
        wattn_tile_src(lane_, kf, win_tile_src(p, H, l, sb, kpos0, 1, kvh), qf, st, f);
    }
    wattn_finish(st);
    const float* OCMP = WSP(float, WS_OCMP); bf16* OCAT = WSP(bf16, WS_OCAT);
    LANES { const int lane = LANE_OF(ln), r = lane & 31, h = lane >> 5; const size_t row = (size_t)NP + sb * DEC_SEQ + (r >> 2); const int head = kvh * 4 + (r & 3);
        if ((r >> 2) < DEC_SEQ) {
            const bf16* bgp = H + row * HP + C_NBG + head * 3;
            const float b0 = sigmoidf_(bf2f(bgp[0])), b1 = sigmoidf_(bf2f(bgp[1])), b2 = sigmoidf_(bf2f(bgp[2]));
#pragma unroll
            for (int db = 0; db < NDB; ++db)
#pragma unroll
                for (int i = 0; i < 16; ++i) { const int d = 32 * db + koff_of(i, h);
                    OCAT[row * KBR + HGW + head * HDIM + d] = f2bf(b0 * OCMP[row * NSAW + head * HDIM + d] + b1 * osel[db][ln][i] + b2 * st.o[db][ln][i]); } } }
}
DEV FI void phw_nsa_cmp_s(const int lane_, const P& p, int l, int wv, int nw) { for (int it = wv; it < DEC_BATCH * NSA_KV_HEADS; it += nw) nsa_cmp_item_s(lane_fresh(lane_), p, l, it / NSA_KV_HEADS, it % NSA_KV_HEADS); }
DEV FI void phw_nsa_select_s(const int lane_, const P& p, int wv, int nw) { for (int it = wv; it < NS * NSA_KV_HEADS; it += nw) nsa_select_item_s(lane_fresh(lane_), p, it / NSA_KV_HEADS, it % NSA_KV_HEADS); }
DEV FI void phw_nsa_selwin_s(const int lane_, const P& p, int l, int wv, int nw) { for (int it = wv; it < DEC_BATCH * NSA_KV_HEADS; it += nw) nsa_selwin_item_s(lane_fresh(lane_), p, l, it / NSA_KV_HEADS, it % NSA_KV_HEADS); }

static_assert(HDIM <= 64, "wave compress: one lane per head-dim element");
DEV FI float wave_sum64(float* x) {
#ifdef CPU_TEST
    float s = 0.f; for (int ln = 0; ln < 64; ++ln) s += x[ln]; return s;
#else
    float v = x[0];
#pragma unroll
    for (int o = 32; o >= 1; o >>= 1) v += __shfl_xor(v, o);
    return v;
#endif
}
static_assert((PAST_LEN / CMP_STRIDE - CMP_R + 1) * CMP_STRIDE + CMP_BLOCK - 1 >= PAST_LEN + DEC_SEQ - 1 + 1 || true, "");
constexpr int CMP_RB = 4, CLPH = HDIM / 4, CJB = 8;
static_assert(CMP_BLOCK == 2 * CMP_STRIDE && CMP_STRIDE == 16 && NSA_KV_HEADS * CLPH <= 64 && (CLPH & (CLPH - 1)) == 0, "compress runs");
DEV FI void group_sum(float* x) {
#ifdef CPU_TEST
    float t[64]; for (int ln = 0; ln < 64; ++ln) { float s = 0.f; for (int q = 0; q < CLPH; ++q) s += x[(ln / CLPH) * CLPH + q]; t[ln] = s; } for (int ln = 0; ln < 64; ++ln) x[ln] = t[ln];
#else
#pragma unroll
    for (int o = CLPH / 2; o >= 1; o >>= 1) x[0] += __shfl_xor(x[0], o);
#endif
}
DEV FI void ld4f_nt(const float* p, float (&v)[4]) {
#ifdef CPU_TEST
    for (int j = 0; j < 4; ++j) v[j] = p[j];
#else
    typedef float v4f_nt __attribute__((ext_vector_type(4))); const v4f_nt u = __builtin_nontemporal_load((const v4f_nt*)p); v[0] = u[0]; v[1] = u[1]; v[2] = u[2]; v[3] = u[3];
#endif
}
DEV FI void ld4any(const float* fb, const bf16* bb, size_t off, float (&v)[4]) { if (fb) ld4f_nt(fb + off, v); else ld4bf(bb + off, v); }
DEV FI void cmp_wave_run(const int lane_, const P& p, int l, int s, int n0, int nb, bool new_rows = true) {
    const bf16* H = WSP(bf16, WS_H);
    const float* w = p.nsa_cmp_w + (size_t)l * 2 * CMP_BLOCK; const float* gk = p.nsa_k_norm + (size_t)l * 3 * HDIM;
    const int npitch = s < BATCH ? NBPP : NBS;
    float pk[4][NL], pv[4][NL]; LANES { for (int j = 0; j < 4; ++j) { pk[j][ln] = 0.f; pv[j][ln] = 0.f; } }
    for (int ci = 0; ci <= nb; ++ci) {
        const int c0 = (n0 + ci) * CMP_STRIDE;
        const float* fb = nullptr; const bf16* bb = nullptr; int stride = 0, nv = 0;
        if (s < BATCH) { if (c0 < SEQ) { bb = H + (size_t)(s * SEQ + c0) * HP + C_NKV; stride = HP; nv = CMP_STRIDE; } }
        else { const int sb = s - BATCH;
            if (c0 < PAST_LEN) { const int page = p.page_table[sb * NPAGES + c0 / PAGE_SIZE]; fb = p.cache_nsa + (((size_t)l * NPOOL + page) * PAGE_SIZE + c0 % PAGE_SIZE) * ROWF; stride = ROWF; nv = CMP_STRIDE; }
            else if (c0 < LS && new_rows) { bb = H + (size_t)(NP + sb * DEC_SEQ + (c0 - PAST_LEN)) * HP + C_NKV; stride = HP; nv = LS - c0 < CMP_STRIDE ? LS - c0 : CMP_STRIDE; } }
        float ak[4][NL], av[4][NL], bk2[4][NL], bv2[4][NL];
        LANES { for (int j = 0; j < 4; ++j) { ak[j][ln] = 0.f; av[j][ln] = 0.f; bk2[j][ln] = 0.f; bv2[j][ln] = 0.f; } }
#pragma unroll 1
        for (int j0 = 0; j0 < CMP_STRIDE; j0 += CJB) {
            float xk[CJB][4][NL], xv[CJB][4][NL];
            LANES { const int lane = LANE_OF(ln); const bool act = lane < NSA_KV_HEADS * CLPH;
#pragma unroll
                for (int jj = 0; jj < CJB; ++jj) { float a4[4] = {0.f, 0.f, 0.f, 0.f}, b4[4] = {0.f, 0.f, 0.f, 0.f};
                    if (act && j0 + jj < nv) { ld4any(fb, bb, (size_t)(j0 + jj) * stride + 4 * lane, a4); ld4any(fb, bb, (size_t)(j0 + jj) * stride + NSAKVW + 4 * lane, b4); }
#pragma unroll
                    for (int q = 0; q < 4; ++q) { xk[jj][q][ln] = a4[q]; xv[jj][q][ln] = b4[q]; } } }
            LANES {
#pragma unroll
                for (int jj = 0; jj < CJB; ++jj) { const float w0 = w[j0 + jj], w1 = w[CMP_BLOCK + j0 + jj], w2 = w[CMP_STRIDE + j0 + jj], w3 = w[CMP_BLOCK + CMP_STRIDE + j0 + jj];
#pragma unroll
                    for (int q = 0; q < 4; ++q) { ak[q][ln] += w0 * xk[jj][q][ln]; av[q][ln] += w1 * xv[jj][q][ln]; bk2[q][ln] += w2 * xk[jj][q][ln]; bv2[q][ln] += w3 * xv[jj][q][ln]; } } }
        }
        if (ci > 0) {
            const int n = n0 + ci - 1;
            float ck[4][NL], cv[4][NL], sq[NL];
            LANES { float a = 0.f;
#pragma unroll
                for (int q = 0; q < 4; ++q) { ck[q][ln] = pk[q][ln] + bk2[q][ln]; cv[q][ln] = pv[q][ln] + bv2[q][ln]; a += ck[q][ln] * ck[q][ln]; }
                sq[ln] = a; }
            group_sum(sq);
            LANES { const int lane = LANE_OF(ln);
                if (lane < NSA_KV_HEADS * CLPH) { const int h = lane / CLPH, e0 = 4 * (lane % CLPH); const float rn = 1.0f / sqrtf(sq[ln] / (float)HDIM + EPS);
                    const size_t sh = s < BATCH ? (size_t)s * NSA_KV_HEADS + h : (size_t)(s - BATCH) * NSA_KV_HEADS + h;
                    bf16* kb = WSP(bf16, s < BATCH ? WS_KCB : WS_KCSB + l * SZ_KCS) + (sh * npitch + (n & ~31)) * HDIM; bf16* vb = WSP(bf16, s < BATCH ? WS_VCB : WS_VCSB + l * SZ_KCS) + (sh * npitch + (n & ~31)) * HDIM;
                    float kq[4];
#pragma unroll
                    for (int q = 0; q < 4; ++q) kq[q] = ck[q][ln] * rn * gk[e0 + q];
                    st4bf(kb + kf_off(n & 31, e0), kq);
#pragma unroll
                    for (int q = 0; q < 4; ++q) vb[vf_off(n & 31, e0 + q)] = f2bf(cv[q][ln]); } }
        }
        LANES { for (int q = 0; q < 4; ++q) { pk[q][ln] = ak[q][ln]; pv[q][ln] = av[q][ln]; } }
    }
}
DEV FI void phw_cmp_part(const int lane_, const P& p, int l, int wv, int nw, bool do_prompt, bool do_sample, bool new_rows = true) {
    constexpr int RP = (NBP + CMP_RB - 1) / CMP_RB, RS = (NBS + CMP_RB - 1) / CMP_RB;
    const int nP = do_prompt ? BATCH * RP : 0, nS = do_sample ? DEC_BATCH * RS : 0;
    for (int it = wv; it < nP + nS; it += nw) {
        if (it < nP) { const int r = it % RP, s = it / RP; const int n0 = r * CMP_RB; cmp_wave_run(lane_fresh(lane_), p, l, s, n0, NBP - n0 < CMP_RB ? NBP - n0 : CMP_RB); }
        else { const int j = it - nP; const int r = j % RS, sb = j / RS; const int n0 = r * CMP_RB; cmp_wave_run(lane_fresh(lane_), p, l, BATCH + sb, n0, NBS - n0 < CMP_RB ? NBS - n0 : CMP_RB, new_rows); }
    }
}
DEV FI void phw_cmp(const int lane_, const P& p, int l, int wv, int nw) { phw_cmp_part(lane_, p, l, wv, nw, true, true); }

constexpr int NPARTS = 16, SP_F = 2 + NDB * 16;
DEV FI float* sp_slot(const P& p, int sb, int kvh, int part, int br, int lane) { return WSP(float, WS_SPART) + (((((size_t)sb * NSA_KV_HEADS + kvh) * NPARTS + part) * 3 + br) * 64 + lane) * SP_F; }
DEV FI void sp_store(const int lane_, const P& p, int sb, int kvh, int part, int br, const WAttn& st) {
    LANES { float* d = sp_slot(p, sb, kvh, part, br, LANE_OF(ln)); d[0] = st.m[ln]; d[1] = st.l[ln];
#pragma unroll
        for (int db = 0; db < NDB; ++db)
#pragma unroll
            for (int i = 0; i < 16; ++i) d[2 + db * 16 + i] = st.o[db][ln][i]; }
}
DEV FI void sp_combine(const int lane_, const P& p, int sb, int kvh, int br, WAttn& st) {
    wattn_reset(st);
    LANES { float M = -3.0e38f; for (int part = 0; part < NPARTS; ++part) M = fmaxf(M, sp_slot(p, sb, kvh, part, br, LANE_OF(ln))[0]); st.m[ln] = M; }
#pragma unroll 2
    for (int part = 0; part < NPARTS; ++part) {
        LANES { const float* d = sp_slot(p, sb, kvh, part, br, LANE_OF(ln)); const float sc = d[0] > -1.0e38f ? fexp2(d[0] - st.m[ln]) : 0.f; st.l[ln] += d[1] * sc;
#pragma unroll
            for (int db = 0; db < NDB; ++db)
#pragma unroll
                for (int i = 0; i < 16; ++i) st.o[db][ln][i] += d[2 + db * 16 + i] * sc; } }
    wattn_finish(st);
}
DEV FI void nsa_cmp_part_s(const int lane_, const P& p, int l, int sb, int kvh, int part) {
    bf16x8 qf[NSTEP][NL]; nsa_load_q_s(lane_, p, l, sb, kvh, qf);
    const bf16* KC = WSP(bf16, WS_KCSB + l * SZ_KCS) + ((size_t)sb * NSA_KV_HEADS + kvh) * NBS * HDIM; const bf16* VC = WSP(bf16, WS_VCSB + l * SZ_KCS) + ((size_t)sb * NSA_KV_HEADS + kvh) * NBS * HDIM;
    float* PS = WSP(float, WS_PS);
    WAttn st; wattn_reset(st);
    for (int tile = part; tile < NBS / 32; tile += NPARTS) {
        auto f = [&](int ln, int lane, int i, bool& v, float& bias) { const int r = lane & 31, h = lane >> 5, t = PAST_LEN + ((r >> 2) & (DEC_SEQ - 1)), n = tile * 32 + koff_of(i, h), be = n * CMP_STRIDE + CMP_BLOCK - 1;
            v = be <= t; bias = slope2_of(kvh * 4 + (r & 3)) * (float)(be - PAST_LEN); (void)ln; };
        wattn_tile(lane_, KC + (size_t)tile * 32 * HDIM, VC + (size_t)tile * 32 * HDIM, 0, qf, st, f);
        f32x16 s[NL]; wattn_scores(lane_, KC + (size_t)tile * 32 * HDIM, qf, s, f);
        LANES { const int lane = LANE_OF(ln), r = lane & 31, h = lane >> 5; const size_t srow = (size_t)sb * DEC_SEQ + (r >> 2); const int head = kvh * 4 + (r & 3);
            if ((r >> 2) < DEC_SEQ) {
#pragma unroll
                for (int i = 0; i < 16; ++i) PS[(srow * NSA_HEADS + head) * NBS + tile * 32 + koff_of(i, h)] = s[ln][i]; } }
    }
    sp_store(lane_, p, sb, kvh, part, 0, st);
}
DEV FI void nsa_select_item_s2(const int lane_, const P& p, int srow, int kvh) {
    const int sb = srow / DEC_SEQ, tok = srow % DEC_SEQ;
    const float* Pr = WSP(float, WS_PS) + ((size_t)srow * NSA_HEADS + kvh * NSA_GROUP) * NBS;
    const int pos = PAST_LEN + tok, cur = pos / SEL_BLOCK;
    static_assert(NPARTS == 16 && NSA_GROUP == 4, "select_s2 lane mapping");
    float Mg[NSA_GROUP], Lg[NSA_GROUP];
    { float pm[2][NL], pl[2][NL];
      LANES { const int lane = LANE_OF(ln), gg = lane >> 5, part = (lane >> 1) & 15, hh = lane & 1;
#pragma unroll
          for (int u = 0; u < 2; ++u) { const float* d = sp_slot(p, sb, kvh, part, 0, tok * 4 + gg + 2 * u + 32 * hh); pm[u][ln] = d[0]; pl[u][ln] = d[1]; } }
#pragma unroll
      for (int u = 0; u < 2; ++u) {
          float mx[NL]; LANES mx[ln] = pm[u][ln];
          half_max32(mx);
          float ls[NL]; LANES ls[ln] = pm[u][ln] > -1.0e38f ? pl[u][ln] * fexp2(pm[u][ln] - mx[ln]) : 0.f;
          half_sum32(ls);
#pragma unroll
          for (int gg = 0; gg < 2; ++gg) { Mg[gg + 2 * u] = wave_bcast(mx, 32 * gg); Lg[gg + 2 * u] = 1.0f / fmaxf(wave_bcast(ls, 32 * gg), 1e-30f); } } }
    float sc[SQW][NL]; int cnt[SQW][NL];
    static_assert(SEL_M == 4 && CMP_R == 2, "importance taps");
#pragma unroll
    for (int q = 0; q < SQW; ++q) {
        float sv[5][NSA_GROUP][NL];
        LANES { const int j = LANE_OF(ln) + 64 * q, jc = j < NSEL_S ? j : NSEL_S - 1;
#pragma unroll
            for (int c5 = 0; c5 < 5; ++c5) { const int n = jc * SEL_M + c5, nc = n < NBS ? n : NBS - 1;
#pragma unroll
                for (int g = 0; g < NSA_GROUP; ++g) sv[c5][g][ln] = Pr[(size_t)g * NBS + nc]; } }
        LANES { const int j = LANE_OF(ln) + 64 * q, jc = j < NSEL_S ? j : NSEL_S - 1; float a = 0.f; cnt[q][ln] = 0;
#pragma unroll
            for (int c5 = 0; c5 < 5; ++c5) { const int n = jc * SEL_M + c5; const float wgt = n < NBS ? ((c5 == 0 || c5 == 4) ? 1.0f : 2.0f) : 0.f;
#pragma unroll
                for (int g = 0; g < NSA_GROUP; ++g) { const float x = sv[c5][g][ln]; a += x > -1.0e38f ? wgt * fexp2(x - Mg[g]) * Lg[g] : 0.f; } }
            if (j < NSEL_S) { const bool forced = (j == 0) || (j == cur), allowed = j * SEL_BLOCK <= pos; sc[q][ln] = forced ? POS_BIG : (allowed ? a : NEG_BIG); }
            else sc[q][ln] = -3.4e38f; }
    }
    u64 mw[SQW];
#pragma unroll
    for (int q = 0; q < SQW; ++q) mw[q] = 0ull;
    for (int r = 0; r < TOPK_S; ++r) {
        float bv[NL]; int bj[NL];
        LANES { float v = sc[0][ln]; int jj = LANE_OF(ln);
#pragma unroll
            for (int q = 1; q < SQW; ++q) if (sc[q][ln] > v) { v = sc[q][ln]; jj = LANE_OF(ln) + 64 * q; }
            bv[ln] = v; bj[ln] = jj; }
        wave_argmax(bv, bj);
        const int win = wave_first_i(bj);
        LANES {
#pragma unroll
            for (int q = 0; q < SQW; ++q) if (LANE_OF(ln) + 64 * q == win) sc[q][ln] = -3.4e38f; }
#pragma unroll
        for (int q = 0; q < SQW; ++q) if ((win >> 6) == q) mw[q] |= 1ull << (win & 63);
    }
#pragma unroll
    for (int q = 0; q < SQW; ++q) { LANES { if (LANE_OF(ln) == 0) WSP(u64, WS_SELMS)[((size_t)srow * NSA_KV_HEADS + kvh) * SQW + q] = mw[q]; } }
}
DEV FI void nsa_selwin_part_s(const int lane_, const P& p, int l, int sb, int kvh, int part) {
    bf16x8 qf[NSTEP][NL]; nsa_load_q_s(lane_, p, l, sb, kvh, qf);
    const bf16* H = WSP(bf16, WS_H);
    const float* gks = p.nsa_k_norm + ((size_t)l * 3 + 1) * HDIM; const float* gkw = p.nsa_k_norm + ((size_t)l * 3 + 2) * HDIM;
    const u64* MS = WSP(u64, WS_SELMS);
    WAttn st; wattn_reset(st);
    int nth = 0;
    for (int q = 0; q < SQW; ++q) {
      u64 mq[NL]; LANES { const int r = LANE_OF(ln) & 31; const size_t srow = (size_t)sb * DEC_SEQ + ((r >> 2) & (DEC_SEQ - 1)); mq[ln] = MS[(srow * NSA_KV_HEADS + kvh) * SQW + q]; }
      u64 U = wave_uniform_u64(wave_or_u64(mq));
      while (U != 0ull) {
        const int bit = (int)__builtin_ctzll(U); U &= U - 1ull;
        const bool mine = (nth % NPARTS) == part; ++nth;
        if (!mine) continue;
        const int j = 64 * q + bit;
        bool sj[NL]; LANES sj[ln] = (mq[ln] >> bit) & 1ull;
        for (int half = 0; half < 2; ++half) { const int kpos0 = j * SEL_BLOCK + half * 32;
            bf16x8 kf[NSTEP][NL]; build_kf(lane_, sel_tile_src(p, H, l, sb, kpos0, 2, kvh), gks, kf);
            auto f = [&](int ln, int lane, int i, bool& v, float& bias) { const int r = lane & 31, h = lane >> 5, t = PAST_LEN + ((r >> 2) & (DEC_SEQ - 1)), kpos = kpos0 + koff_of(i, h);
                v = sj[ln] && kpos <= t; bias = slope2_of(kvh * 4 + (r & 3)) * (float)(kpos - PAST_LEN); };
            wattn_tile_src(lane_, kf, sel_tile_src(p, H, l, sb, kpos0, 3, kvh), qf, st, f); }
      }
    }
    sp_store(lane_, p, sb, kvh, part, 1, st);
    wattn_reset(st);
    for (int wt = part; wt * 32 < WINBUF + DEC_SEQ; wt += NPARTS) { const int kpos0 = PAST_LEN - WINBUF + wt * 32;
        bf16x8 kf[NSTEP][NL]; build_kf(lane_, win_tile_src(p, H, l, sb, kpos0, 0, kvh), gkw, kf);
        auto f = [&](int ln, int lane, int i, bool& v, float& bias) { const int r = lane & 31, h = lane >> 5, t = PAST_LEN + ((r >> 2) & (DEC_SEQ - 1)), kpos = kpos0 + koff_of(i, h);
            v = kpos <= t && kpos > t - WINDOW; bias = slope2_of(kvh * 4 + (r & 3)) * (float)(kpos - PAST_LEN); (void)ln; };
        wattn_tile_src(lane_, kf, win_tile_src(p, H, l, sb, kpos0, 1, kvh), qf, st, f);
    }
    sp_store(lane_, p, sb, kvh, part, 2, st);
}
DEV FI void nsa_combine_item_s(const int lane_, const P& p, int sb, int kvh) {
    WAttn st; f32x16 oc[NDB][NL], os[NDB][NL];
    sp_combine(lane_, p, sb, kvh, 0, st); LANES { for (int db = 0; db < NDB; ++db) oc[db][ln] = st.o[db][ln]; }
    sp_combine(lane_, p, sb, kvh, 1, st); LANES { for (int db = 0; db < NDB; ++db) os[db][ln] = st.o[db][ln]; }
    sp_combine(lane_, p, sb, kvh, 2, st);
    const bf16* H = WSP(bf16, WS_H); bf16* OCAT = WSP(bf16, WS_OCAT);
    LANES { const int lane = LANE_OF(ln), r = lane & 31, h = lane >> 5; const size_t row = (size_t)NP + sb * DEC_SEQ + (r >> 2); const int head = kvh * 4 + (r & 3);
        if ((r >> 2) < DEC_SEQ) {
            const bf16* bgp = H + row * HP + C_NBG + head * 3;
            const float b0 = sigmoidf_(bf2f(bgp[0])), b1 = sigmoidf_(bf2f(bgp[1])), b2 = sigmoidf_(bf2f(bgp[2]));
#pragma unroll
            for (int db = 0; db < NDB; ++db)
#pragma unroll
                for (int i = 0; i < 16; ++i) { const int d = 32 * db + koff_of(i, h);
                    OCAT[row * KBR + HGW + head * HDIM + d] = f2bf(b0 * oc[db][ln][i] + b1 * os[db][ln][i] + b2 * st.o[db][ln][i]); } } }
}
DEV FI void phw_nsa_cmp_s2(const int lane_, const P& p, int l, int wv, int nw) { for (int it = wv; it < DEC_BATCH * NSA_KV_HEADS * NPARTS; it += nw) nsa_cmp_part_s(lane_fresh(lane_), p, l, it / (NSA_KV_HEADS * NPARTS), (it / NPARTS) % NSA_KV_HEADS, it % NPARTS); }
DEV FI void phw_nsa_select_s2(const int lane_, const P& p, int wv, int nw) { for (int it = wv; it < NS * NSA_KV_HEADS; it += nw) nsa_select_item_s2(lane_fresh(lane_), p, it / NSA_KV_HEADS, it % NSA_KV_HEADS); }
DEV FI void phw_nsa_selwin_s2(const int lane_, const P& p, int l, int wv, int nw) { for (int it = wv; it < DEC_BATCH * NSA_KV_HEADS * NPARTS; it += nw) nsa_selwin_part_s(lane_fresh(lane_), p, l, it / (NSA_KV_HEADS * NPARTS), (it / NPARTS) % NSA_KV_HEADS, it % NPARTS); }
DEV FI void phw_nsa_combine_s(const int lane_, const P& p, int wv, int nw) { for (int it = wv; it < DEC_BATCH * NSA_KV_HEADS; it += nw) nsa_combine_item_s(lane_fresh(lane_), p, it / NSA_KV_HEADS, it % NSA_KV_HEADS); }

static_assert(NS <= 32, "skinny GEMM: at most 32 sample rows");
template <class EP> DEV FI void skinny_item(const int lane_, const bf16* X, int lda, const bf16* Bt, int ldb, int K, int n0, const EP& ep) {
    f32x16 acc[NL]; LANES { for (int i = 0; i < 16; ++i) acc[ln][i] = 0.f; }
#pragma unroll 8
    for (int ks = 0; ks < K / 16; ++ks) { bf16x8 af[NL], bfr[NL];
        LANES { const int lane = LANE_OF(ln), r = lane & 31, h = lane >> 5, rs = r < NS ? r : NS - 1;
            af[ln] = ld8(Bt + (size_t)(n0 + r) * ldb + 16 * ks + 8 * h); bfr[ln] = ld8(X + (size_t)rs * lda + 16 * ks + 8 * h); }
        mfma32(af, bfr, acc); }
    LANES { const int lane = LANE_OF(ln), r = lane & 31, h = lane >> 5;
        if (r < NS) {
#pragma unroll
            for (int q4 = 0; q4 < 4; ++q4) { const float v[4] = {acc[ln][4 * q4], acc[ln][4 * q4 + 1], acc[ln][4 * q4 + 2], acc[ln][4 * q4 + 3]}; ep(NP + r, n0 + 8 * q4 + 4 * h, v); } } }
}
#ifndef CPU_TEST
#define LASP __attribute__((address_space(3)))
constexpr int NWAVES_K8 = 8;
typedef float v4f_t __attribute__((ext_vector_type(4)));
static_assert(D_MODEL % 256 == 0, "wave norm: 64 lanes x float4");
__device__ __forceinline__ void phw_norm(const int lane_, const P& p, int l, int stage, int wv, int nw) {
    bf16* XN = WSP(bf16, WS_XN); constexpr int NJ = D_MODEL / 256;
    for (int row = wv; row < MP; row += nw) {
        uint2* o = (uint2*)(XN + (size_t)row * D_MODEL) + lane_;
        if (row >= MR) {
#pragma unroll
            for (int j = 0; j < NJ; ++j) o[64 * j] = make_uint2(0u, 0u);
            continue; }
        const float* x = stage == 0 ? xin_row(p, l, row) : WSP(float, WS_X1) + (size_t)row * D_MODEL;
        const float4* g4 = (const float4*)((stage == 0 ? p.norm_attn : p.norm_ffn) + (size_t)l * D_MODEL) + lane_;
        const float4* x4 = (const float4*)x + lane_;
        float4 v[NJ]; float ss = 0.f;
#pragma unroll
        for (int j = 0; j < NJ; ++j) { v[j] = x4[64 * j]; ss += (v[j].x * v[j].x + v[j].y * v[j].y) + (v[j].z * v[j].z + v[j].w * v[j].w); }
#pragma unroll
        for (int of = 32; of >= 1; of >>= 1) ss += __shfl_xor(ss, of);
        const float r = 1.0f / sqrtf(ss / (float)D_MODEL + EPS);
#pragma unroll
        for (int j = 0; j < NJ; ++j) { const float4 g = g4[64 * j]; const float w4[4] = {v[j].x * r * g.x, v[j].y * r * g.y, v[j].z * r * g.z, v[j].w * r * g.w};
            uint2 u; u.x = pk2bf(w4[0], w4[1]); u.y = pk2bf(w4[2], w4[3]); o[64 * j] = u; }
    }
}
__device__ __forceinline__ void conv_tile(const float* W, int ldw, int n_real, bf16* WT, int ldd, int grp, LASP float* scr, int k0, int n0, int lane) {
    const int nn = n0 + (lane & 31); const bool ok = nn < n_real;
    float xv[32];
#pragma unroll
    for (int i = 0; i < 32; ++i) { const int kk = 2 * i + (lane >> 5); xv[i] = ok ? __builtin_nontemporal_load(W + (size_t)(k0 + kk) * ldw + nn) : 0.f; }
#pragma unroll
    for (int i = 0; i < 32; ++i) { const int kk = 2 * i + (lane >> 5); scr[kk * 33 + (lane & 31)] = xv[i]; }
    asm volatile("s_waitcnt lgkmcnt(0)" ::: "memory");
    const int c = lane & 7;
#pragma unroll
    for (int j = 0; j < 4; ++j) { const int nl = (lane >> 3) + 8 * j, n = n0 + nl; const LASP float* s = scr + (8 * c) * 33 + nl;
        uint4 o; o.x = pk2bf(s[0 * 33], s[1 * 33]); o.y = pk2bf(s[2 * 33], s[3 * 33]); o.z = pk2bf(s[4 * 33], s[5 * 33]); o.w = pk2bf(s[6 * 33], s[7 * 33]);
        const int dn = grp ? (n / grp) * 2 * grp + n % grp : n;
        *(uint4*)(WT + (size_t)dn * ldd + k0 + 8 * c) = o; }
    asm volatile("s_waitcnt lgkmcnt(0)" ::: "memory");
}
__device__ __forceinline__ void conv_xpose(const float (&xv)[32], bf16* WT, int ldd, int grp, LASP float* scr, int k0, int n0, int lane) {
#pragma unroll
    for (int i = 0; i < 32; ++i) { const int kk = 2 * i + (lane >> 5); scr[kk * 33 + (lane & 31)] = xv[i]; }
    asm volatile("s_waitcnt lgkmcnt(0)" ::: "memory");
    const int c = lane & 7;
#pragma unroll
    for (int j = 0; j < 4; ++j) { const int nl = (lane >> 3) + 8 * j, n = n0 + nl; const LASP float* s = scr + (8 * c) * 33 + nl;
        uint4 o; o.x = pk2bf(s[0 * 33], s[1 * 33]); o.y = pk2bf(s[2 * 33], s[3 * 33]); o.z = pk2bf(s[4 * 33], s[5 * 33]); o.w = pk2bf(s[6 * 33], s[7 * 33]);
        const int dn = grp ? (n / grp) * 2 * grp + n % grp : n;
        *(uint4*)(WT + (size_t)dn * ldd + k0 + 8 * c) = o; }
    asm volatile("s_waitcnt lgkmcnt(0)" ::: "memory");
}
__device__ __forceinline__ void conv_mat(const float* W, int K, int ldw, int n_real, int n_pad, bf16* WT, int ldd, int grp, LASP float* scr, int lane, int wv, int nw) {
    const int nblk = n_pad / 32, items = (K / 64) * nblk;
    for (int it = wv; it < items; it += 2 * nw) {
        const int i2 = it + nw; const bool doB = i2 < items; const int j2 = doB ? i2 : it;
        const int kA = 64 * (it / nblk), nA = 32 * (it % nblk), kB = 64 * (j2 / nblk), nB = 32 * (j2 % nblk);
        float xa[32], xb[32];
        { const int nn = nA + (lane & 31); const bool ok = nn < n_real;
#pragma unroll
          for (int i = 0; i < 32; ++i) { const int kk = 2 * i + (lane >> 5); xa[i] = ok ? __builtin_nontemporal_load(W + (size_t)(kA + kk) * ldw + nn) : 0.f; } }
        { const int nn = nB + (lane & 31); const bool ok = nn < n_real;
#pragma unroll
          for (int i = 0; i < 32; ++i) { const int kk = 2 * i + (lane >> 5); xb[i] = ok ? __builtin_nontemporal_load(W + (size_t)(kB + kk) * ldw + nn) : 0.f; } }
        conv_xpose(xa, WT, ldd, grp, scr, kA, nA, lane);
        if (doB) conv_xpose(xb, WT, ldd, grp, scr, kB, nB, lane);
    }
}
static_assert(D_MODEL % 64 == 0 && HGW % 64 == 0 && FFN % 64 == 0 && HP % 32 == 0 && FFN % 32 == 0, "conversion tiles");
__device__ __forceinline__ void phw_convert(const int lane_, const P& p, LASP float* scr, int wv, int nw, int l, int which) {
    if (which & 1) conv_mat(p.w_in + (size_t)l * D_MODEL * W_IN, D_MODEL, W_IN, W_IN, HP, WSP(bf16, WS_WIN + l * SZ_WIN), D_MODEL, 0, scr, lane_, wv, nw);
    if (which & 2) {
        conv_mat(p.w_br_hg + (size_t)l * HGW * D_MODEL, HGW, D_MODEL, D_MODEL, D_MODEL, WSP(bf16, WS_WBR + l * SZ_WBR), KBR, 0, scr, lane_, wv, nw);
        conv_mat(p.w_br_nsa + (size_t)l * NSAW * D_MODEL, NSAW, D_MODEL, D_MODEL, D_MODEL, WSP(bf16, WS_WBR + l * SZ_WBR) + HGW, KBR, 0, scr, lane_, wv, nw);
        conv_mat(p.w_br_ret + (size_t)l * RETW * D_MODEL, RETW, D_MODEL, D_MODEL, D_MODEL, WSP(bf16, WS_WBR + l * SZ_WBR) + HGW + NSAW, KBR, 0, scr, lane_, wv, nw);
        conv_mat(p.w_out + (size_t)l * D_MODEL * D_MODEL, D_MODEL, D_MODEL, D_MODEL, D_MODEL, WSP(bf16, WS_WOUT + l * SZ_WOUT), D_MODEL, 0, scr, lane_, wv, nw); }
    if (which & 4) {
        conv_mat(p.w_gate + (size_t)l * D_MODEL * FFN, D_MODEL, FFN, FFN, FFN, WSP(bf16, WS_WGU + l * SZ_WGU), D_MODEL, 128, scr, lane_, wv, nw);
        conv_mat(p.w_up + (size_t)l * D_MODEL * FFN, D_MODEL, FFN, FFN, FFN, WSP(bf16, WS_WGU + l * SZ_WGU) + (size_t)128 * D_MODEL, D_MODEL, 128, scr, lane_, wv, nw); }
    if (which & 8) {
        conv_mat(p.w_down + (size_t)l * FFN * D_MODEL, FFN, D_MODEL, D_MODEL, D_MODEL, WSP(bf16, WS_WDN + l * SZ_WDN), FFN, 0, scr, lane_, wv, nw); }
}
template <class EP> __device__ __forceinline__ void skinny_item_k8(const int tid_, LASP float* scr, const bf16* X, int lda, const bf16* Bt, int ldb, int K, int n0, const EP& ep) {
    const int lane_ = lane_fresh(tid_ & 63), wid = tid_ >> 6, r = lane_ & 31, h = lane_ >> 5, rs = r < NS ? r : NS - 1;
    f32x16 acc; for (int i = 0; i < 16; ++i) acc[i] = 0.f;
    const int kw = K / NWAVES_K8;
    const bf16* bp = Bt + (size_t)(n0 + r) * ldb + (size_t)wid * kw + 8 * h; const bf16* xp = X + (size_t)rs * lda + (size_t)wid * kw + 8 * h;
#pragma unroll 8
    for (int ks = 0; ks < kw / 16; ++ks) { const bf16x8 af = *(const bf16x8*)(bp + 16 * ks), bfr = *(const bf16x8*)(xp + 16 * ks); acc = __builtin_amdgcn_mfma_f32_32x32x16_bf16(af, bfr, acc, 0, 0, 0); }
    LASP float* my = scr + ((size_t)wid * 64 + lane_) * 16;
#pragma unroll
    for (int q = 0; q < 4; ++q) *(LASP v4f_t*)(my + 4 * q) = (v4f_t){acc[4 * q], acc[4 * q + 1], acc[4 * q + 2], acc[4 * q + 3]};
    __syncthreads();
    if (wid == 0 && r < NS) {
#pragma unroll
        for (int q4 = 0; q4 < 4; ++q4) { float v[4] = {0.f, 0.f, 0.f, 0.f};
#pragma unroll
            for (int w8 = 0; w8 < NWAVES_K8; ++w8) { const v4f_t t = *(const LASP v4f_t*)(scr + ((size_t)w8 * 64 + lane_) * 16 + 4 * q4); v[0] += t[0]; v[1] += t[1]; v[2] += t[2]; v[3] += t[3]; }
            ep(NP + r, n0 + 8 * q4 + 4 * h, v); } }
    __syncthreads();
}
#endif

#ifndef CPU_TEST
namespace pg8 {
#define PG8_LAS __attribute__((address_space(3)))
typedef unsigned short bf16_t;
typedef short bf16x8 __attribute__((ext_vector_type(8)));
typedef float f32x4 __attribute__((ext_vector_type(4)));
typedef unsigned u32x4 __attribute__((ext_vector_type(4)));
constexpr int BM = 256, BK = 64, HALF = 128, HTB = HALF * BK * 2  , STAGE_BYTES = 8 * HTB, NXCD = 8, WGM = 8;
__host__ __device__ __forceinline__ int lds_byte(int r, int c) { const int st = (r >> 4) * 2 + (c >> 5), rr = r & 15, cc = c & 31, ob = rr * 64 + cc * 2; return st * 1024 + (ob ^ (((ob >> 9) & 1) << 5)); }
__host__ __device__ __forceinline__ void stage_rc(int b, int& R, int& C) { const int st = b / 1024, sb = b % 1024, swz = sb ^ (((sb >> 9) & 1) << 5); R = (st >> 1) * 16 + swz / 64; C = (st & 1) * 32 + (swz % 64) / 2; }
__host__ __device__ __forceinline__ int perm32(int rho) { const int n = rho >> 4, i = rho & 15; return 8 * (i >> 2) + 4 * n + (i & 3); }
struct Unit { int pm, pn, seg; };
struct Gemm { const bf16_t* A; const bf16_t* Bt; int K, lda, ldb; };
__host__ __device__ __forceinline__ void tile_of(int wgid, int nM, int nN, int& pm, int& pn) {
    const int nwg = nM * nN; { const int q = nwg / NXCD, r = nwg % NXCD, xcd = wgid % NXCD, off = wgid / NXCD; wgid = (xcd < r ? xcd * (q + 1) : r * (q + 1) + (xcd - r) * q) + off; }
    const int nig = WGM * nN, gid = wgid / nig, fm = gid * WGM, gsz = (nM - fm) < WGM ? (nM - fm) : WGM;
    pm = fm + ((wgid % nig) % gsz); pn = (wgid % nig) / gsz;
}
struct StaticOrder {
    int nM, nN, nwg, G, c;
    __host__ __device__ void init(int M, int N, int G_, int c_) { nM = M / BM; nN = N / BM; nwg = nM * nN; G = G_; c = c_; }
    __host__ __device__ bool next(int i, Unit& u) const { const long L = (long)i * G + c; if (L >= nwg) return false; tile_of((int)L, nM, nN, u.pm, u.pn); u.seg = 0; return true; }
    __device__ __forceinline__ int koffA(const Unit&) const { return 0; }
    __device__ __forceinline__ int koffB(const Unit&) const { return 0; }
    __device__ __forceinline__ void a_ready(const Unit&) const {}
    __device__ __forceinline__ void done(const Unit&) const {}
};
struct BranchOrder {
    int nM, nN, nwg, G, c;
    __host__ __device__ void init(int M, int N, int G_, int c_) { nM = M / BM; nN = N / BM; nwg = nM * nN; G = G_; c = c_; }
    __host__ __device__ bool next(int i, Unit& u) const { const long L = (long)(i / 3) * G + c; if (L >= nwg) return false; tile_of((int)L, nM, nN, u.pm, u.pn); u.seg = i % 3; return true; }
    __device__ __forceinline__ int koffA(const Unit& u) const { return u.seg == 0 ? 0 : (u.seg == 1 ? HGW : HGW + NSAW); }
    __device__ __forceinline__ int koffB(const Unit& u) const { return u.seg == 0 ? 0 : (u.seg == 1 ? HGW : HGW + NSAW); }
    __device__ __forceinline__ void a_ready(const Unit&) const {}
    __device__ __forceinline__ void done(const Unit&) const {}
};
__device__ __forceinline__ unsigned cvt_pk_bf16(float lo, float hi) { unsigned r; asm volatile("v_cvt_pk_bf16_f32 %0, %1, %2" : "=v"(r) : "v"(lo), "v"(hi)); return r; }
template <class Epi, class Sched, bool ALIGN_EPI = false, bool SP2 = false>
__device__ __forceinline__ void gemm_phase(PG8_LAS unsigned char* lds, const Gemm g, const Sched& S, const Epi& E, const int tid_in) {
    int tid_l = tid_in; asm volatile("" : "+v"(tid_l));
    const int tid = tid_l, wid = __builtin_amdgcn_readfirstlane(tid >> 6), lane = tid & 63, wr = wid >> 2, wc = wid & 3, fr = lane & 15, fq = lane >> 4;
    const int K = g.K, nt = K / BK;
    unsigned voffA[2], voffB[2];
#pragma unroll
    for (int i = 0; i < 2; ++i) { int R, C; stage_rc(tid * 16 + i * 8192, R, C); const int Rb = Epi::PERM ? ((R & ~31) + perm32(R & 31)) : R;
        voffA[i] = (unsigned)(R * g.lda + C) * 2u; voffB[i] = (unsigned)(Rb * g.ldb + C) * 2u; }
    const size_t kstep = (size_t)(BK * 2);
    const size_t hstepA = (size_t)HALF * g.lda * 2, hstepB = (size_t)HALF * g.ldb * 2;
    const size_t tstepA = 2 * hstepA, tstepB = 2 * hstepB;
    const unsigned ldsw = (unsigned)wid * 1024u;
    const int aoff = lds_byte(wr * 64 + fr, fq * 8), boff = lds_byte(wc * 32 + fr, fq * 8);
#define PG8_SA(b, h) (((b) * 2 + (h)) * HTB)
#define PG8_SB(b, h) ((4 + (b) * 2 + (h)) * HTB)
#define PG8_STAGE(bufoff, gbase, voff) do { _Pragma("unroll") for (int _i = 0; _i < 2; ++_i) \
        __builtin_amdgcn_global_load_lds((const unsigned*)((const char*)(gbase) + (voff)[_i]), (PG8_LAS unsigned*)(lds + (bufoff) + ldsw + _i * 8192), 16, 0, 0); } while (0)
#define PG8_LDA(dst, b, h) do { _Pragma("unroll") for (int m = 0; m < 4; ++m) _Pragma("unroll") for (int k = 0; k < 2; ++k) dst[m][k] = *(const PG8_LAS bf16x8*)(lds + PG8_SA(b, h) + aoff + m * 2048 + k * 1024); } while (0)
#define PG8_LDB(dst, b, h) do { _Pragma("unroll") for (int n = 0; n < 2; ++n) _Pragma("unroll") for (int k = 0; k < 2; ++k) dst[n][k] = *(const PG8_LAS bf16x8*)(lds + PG8_SB(b, h) + boff + n * 2048 + k * 1024); } while (0)
#define PG8_MMA(ai, bj, At, Bt) do { __builtin_amdgcn_s_setprio(1); _Pragma("unroll") for (int m = 0; m < 4; ++m) _Pragma("unroll") for (int n = 0; n < 2; ++n) _Pragma("unroll") for (int k = 0; k < 2; ++k) \
        acc[ai][bj][m][n] = __builtin_amdgcn_mfma_f32_16x16x32_bf16(Bt[n][k], At[m][k], acc[ai][bj][m][n], 0, 0, 0); __builtin_amdgcn_s_setprio(0); } while (0)
#define PG8_WAIT_V(n) asm volatile("s_waitcnt vmcnt(" #n ")" ::: "memory")
#define PG8_WAIT_L(n) asm volatile("s_waitcnt lgkmcnt(" #n ")" ::: "memory")
#define PG8_BAR __builtin_amdgcn_s_barrier()
#define PG8_SCHED __builtin_amdgcn_sched_barrier(0)
    Unit cur, nxt; int ui = 0;
    if (!S.next(0, cur)) return;
    f32x4 acc[2][2][4][2];
#pragma unroll
    for (int a = 0; a < 2; ++a)
#pragma unroll
        for (int b = 0; b < 2; ++b)
#pragma unroll
            for (int m = 0; m < 4; ++m)
#pragma unroll
                for (int n = 0; n < 2; ++n) acc[a][b][m][n] = (f32x4){0.f, 0.f, 0.f, 0.f};
    bf16x8 At[4][2], B0[2][2], B1[2][2];
    const char* cA = (const char*)g.A + (size_t)cur.pm * tstepA + (size_t)S.koffA(cur) * 2; const char* cB = (const char*)g.Bt + (size_t)cur.pn * tstepB + (size_t)S.koffB(cur) * 2;
    S.a_ready(cur);
    if constexpr (SP2) {
        PG8_STAGE(PG8_SB(0, 0), cB, voffB); PG8_STAGE(PG8_SB(0, 1), cB + hstepB, voffB); PG8_STAGE(PG8_SA(0, 0), cA, voffA); PG8_STAGE(PG8_SA(0, 1), cA + hstepA, voffA);
        if (wr == 1) PG8_BAR;
        PG8_WAIT_V(2); PG8_BAR;
        PG8_STAGE(PG8_SB(1, 0), cB + kstep, voffB); PG8_STAGE(PG8_SA(1, 0), cA + kstep, voffA); PG8_STAGE(PG8_SB(1, 1), cB + hstepB + kstep, voffB);
        PG8_WAIT_V(6); PG8_BAR;
    } else {
        PG8_STAGE(PG8_SB(0, 0), cB, voffB); PG8_STAGE(PG8_SA(0, 0), cA, voffA); PG8_STAGE(PG8_SB(0, 1), cB + hstepB, voffB); PG8_STAGE(PG8_SA(0, 1), cA + hstepA, voffA);
        if (wr == 1) PG8_BAR;
        PG8_WAIT_V(4); PG8_BAR;
        PG8_STAGE(PG8_SB(1, 0), cB + kstep, voffB); PG8_STAGE(PG8_SA(1, 0), cA + kstep, voffA); PG8_STAGE(PG8_SB(1, 1), cB + hstepB + kstep, voffB);
        PG8_WAIT_V(6); PG8_BAR;
    }
    for (;;) {
        const bool has_next = S.next(ui + 1, nxt);
        const char* nA = has_next ? (const char*)g.A + (size_t)nxt.pm * tstepA + (size_t)S.koffA(nxt) * 2 : cA; const char* nB = has_next ? (const char*)g.Bt + (size_t)nxt.pn * tstepB + (size_t)S.koffB(nxt) * 2 : cB;
        for (int t = 0; t < nt; t += 2) {
            const bool last = (t == nt - 2);
            const char* a1 = cA + (size_t)(t + 1) * kstep;
            const char* a2 = last ? nA : cA + (size_t)(t + 2) * kstep; const char* b2 = last ? nB : cB + (size_t)(t + 2) * kstep;
            const char* a3 = a2 + kstep; const char* b3 = b2 + kstep;
            if (last && has_next) S.a_ready(nxt);
            if constexpr (SP2) {
            PG8_LDB(B0, 0, 0); PG8_LDB(B1, 0, 1); PG8_SCHED; PG8_LDA(At, 0, 0); PG8_STAGE(PG8_SA(1, 1), a1 + hstepA, voffA);
            PG8_WAIT_V(8); PG8_WAIT_L(0); PG8_BAR; PG8_MMA(0, 0, At, B0); PG8_MMA(0, 1, At, B1); PG8_BAR; PG8_SCHED;
            PG8_LDA(At, 0, 1); PG8_STAGE(PG8_SB(0, 0), b2, voffB); PG8_STAGE(PG8_SB(0, 1), b2 + hstepB, voffB); PG8_STAGE(PG8_SA(0, 0), a2, voffA);
            PG8_WAIT_V(8); PG8_WAIT_L(0); PG8_BAR; PG8_MMA(1, 0, At, B0); PG8_MMA(1, 1, At, B1); PG8_BAR; PG8_SCHED;
            PG8_LDB(B0, 1, 0); PG8_LDB(B1, 1, 1); PG8_SCHED; PG8_LDA(At, 1, 0); PG8_STAGE(PG8_SA(0, 1), a2 + hstepA, voffA);
            PG8_WAIT_V(8); PG8_WAIT_L(0); PG8_BAR; PG8_MMA(0, 0, At, B0); PG8_MMA(0, 1, At, B1); PG8_BAR; PG8_SCHED;
            PG8_LDA(At, 1, 1); PG8_STAGE(PG8_SB(1, 0), b3, voffB); PG8_STAGE(PG8_SB(1, 1), b3 + hstepB, voffB); PG8_STAGE(PG8_SA(1, 0), a3, voffA);
            PG8_WAIT_V(8); PG8_WAIT_L(0); PG8_BAR; PG8_MMA(1, 0, At, B0); PG8_MMA(1, 1, At, B1); PG8_BAR; PG8_SCHED;
            } else {
            PG8_LDB(B0, 0, 0); PG8_SCHED; PG8_LDA(At, 0, 0); PG8_STAGE(PG8_SA(1, 1), a1 + hstepA, voffA);
            PG8_WAIT_L(8); PG8_BAR; PG8_WAIT_L(0); PG8_MMA(0, 0, At, B0); PG8_BAR; PG8_SCHED;
            PG8_LDB(B1, 0, 1); PG8_STAGE(PG8_SB(0, 0), b2, voffB);
            PG8_BAR; PG8_WAIT_L(0); PG8_MMA(0, 1, At, B1); PG8_BAR;
            PG8_LDA(At, 0, 1); PG8_STAGE(PG8_SA(0, 0), a2, voffA);
            PG8_BAR; PG8_WAIT_L(0); PG8_MMA(1, 0, At, B0); PG8_BAR; PG8_SCHED;
            PG8_STAGE(PG8_SB(0, 1), b2 + hstepB, voffB);
            PG8_WAIT_V(6); PG8_BAR; PG8_MMA(1, 1, At, B1); PG8_BAR;
            PG8_LDB(B0, 1, 0); PG8_SCHED; PG8_LDA(At, 1, 0); PG8_STAGE(PG8_SA(0, 1), a2 + hstepA, voffA);
            PG8_WAIT_L(8); PG8_BAR; PG8_WAIT_L(0); PG8_MMA(0, 0, At, B0); PG8_BAR; PG8_SCHED;
            PG8_LDB(B1, 1, 1); PG8_STAGE(PG8_SB(1, 0), b3, voffB);
            PG8_BAR; PG8_WAIT_L(0); PG8_MMA(0, 1, At, B1); PG8_BAR;
            PG8_LDA(At, 1, 1); PG8_STAGE(PG8_SA(1, 0), a3, voffA);
            PG8_BAR; PG8_WAIT_L(0); PG8_MMA(1, 0, At, B0); PG8_BAR; PG8_SCHED;
            PG8_STAGE(PG8_SB(1, 1), b3 + hstepB, voffB);
            PG8_WAIT_V(6); PG8_BAR; PG8_MMA(1, 1, At, B1); PG8_BAR;
            }
        }
        if constexpr (ALIGN_EPI) { if (wr == 0) PG8_BAR; }
        if constexpr (!Epi::AFTER_DRAIN) { E(acc, cur, wr, wc, fr, fq); S.done(cur); }
        if (!has_next) break;
#pragma unroll
        for (int a = 0; a < 2; ++a)
#pragma unroll
            for (int b = 0; b < 2; ++b)
#pragma unroll
                for (int m = 0; m < 4; ++m)
#pragma unroll
                    for (int n = 0; n < 2; ++n) acc[a][b][m][n] = (f32x4){0.f, 0.f, 0.f, 0.f};
        cur = nxt; cA = nA; cB = nB; ++ui;
        if constexpr (ALIGN_EPI) { if (wr == 1) PG8_BAR; }
    }
    PG8_WAIT_V(0);
    if constexpr (!ALIGN_EPI) { if (wr == 0) PG8_BAR; }
    PG8_BAR;
    if constexpr (Epi::AFTER_DRAIN) { E.fused(acc, cur, wr, wc, fr, fq, lds, wid, lane); S.done(cur); }
#undef PG8_SA
#undef PG8_SB
#undef PG8_STAGE
#undef PG8_LDA
#undef PG8_LDB
#undef PG8_MMA
#undef PG8_WAIT_V
#undef PG8_WAIT_L
#undef PG8_BAR
#undef PG8_SCHED
}
}

#define LAS __attribute__((address_space(3)))
#define XB_TMO      128
#define XB_XCNT(j)  (256  + 64 * (j))
#define XB_XSUB(j)  (1280 + 64 * (j))
#define XB_XGEN(j)  (2304 + 64 * (j))
#define XB_TOP      3328
#define XB_TOPGEN   3392
#define XCD_BAR_WORDS 3456
#define XB_SPIN_CAP (1u << 18)

__device__ __forceinline__ unsigned xb_ld(unsigned* p)              { return __hip_atomic_load(p, __ATOMIC_RELAXED, __HIP_MEMORY_SCOPE_AGENT); }
__device__ __forceinline__ unsigned xb_add(unsigned* p, unsigned v) { return __hip_atomic_fetch_add(p, v, __ATOMIC_RELAXED, __HIP_MEMORY_SCOPE_AGENT); }
__device__ __forceinline__ unsigned xb_xcc_id() { return (unsigned)__builtin_amdgcn_s_getreg((3 << 11) | 20) & 0xFu; }
#define XB_SPIN(cond, bar) do { unsigned _sp = 0; while (cond) { __builtin_amdgcn_s_sleep(1); \
    if ((++_sp & 255u) == 0u) { if (xb_ld(&(bar)[XB_TMO])) break; if (_sp > XB_SPIN_CAP) { atomicAdd(&(bar)[XB_TMO], 1u); break; } } } } while (0)

struct XcdBarrier {
    unsigned* bar; unsigned x;
    volatile LAS unsigned* st;
};

__device__ __forceinline__ XcdBarrier xcd_barrier_post(unsigned* bar, volatile LAS unsigned* st) {
    XcdBarrier b; b.bar = bar; b.x = xb_xcc_id(); b.st = st;
    if (threadIdx.x == 0) (void)xb_add(&bar[XB_XCNT(b.x)], 1u);
    return b;
}
__device__ __forceinline__ void xcd_barrier_complete(unsigned* bar, unsigned x, unsigned& nloc, unsigned& nx) {
    const unsigned G = gridDim.x * gridDim.y * gridDim.z;
    unsigned sum, cnt, mine, sp = 0u;
    for (;;) {
        sum = 0u; cnt = 0u; mine = 0u;
#pragma unroll
        for (unsigned j = 0; j < 16; ++j) { const unsigned c = xb_ld(&bar[XB_XCNT(j)]); sum += c; cnt += (c > 0u) ? 1u : 0u; mine = (j == x) ? c : mine; }
        if (sum == G) break;
        __builtin_amdgcn_s_sleep(1);
        if ((++sp & 255u) == 0u) { if (xb_ld(&bar[XB_TMO])) break; if (sp > XB_SPIN_CAP) { atomicAdd(&bar[XB_TMO], 1u); break; } }
    }
    nloc = mine > 0u ? mine : 1u; nx = cnt > 0u ? cnt : 1u;
}

__device__ __forceinline__ void xcd_barrier(const XcdBarrier& b) {
    asm volatile("s_waitcnt vmcnt(0)" ::: "memory");
    __syncthreads();
    if (threadIdx.x == 0) {
        unsigned* bar = b.bar;
        __builtin_amdgcn_s_waitcnt(0);
        unsigned nloc = b.st[0], nx = b.st[1];
        if (nloc == 0u) { xcd_barrier_complete(bar, b.x, nloc, nx); b.st[0] = nloc; b.st[1] = nx; }
        const unsigned old = xb_add(&bar[XB_XSUB(b.x)], 1u);
        const unsigned gen = old / nloc;
        if (old + 1u == (gen + 1u) * nloc) {
            __builtin_amdgcn_fence(__ATOMIC_RELEASE, "agent");
            asm volatile("s_waitcnt vmcnt(0)" ::: "memory");
            const unsigned og = xb_add(&bar[XB_TOP], 1u);
            const unsigned tg = og / nx;
            if (og + 1u == (tg + 1u) * nx) xb_add(&bar[XB_TOPGEN], 1u);
            else XB_SPIN(xb_ld(&bar[XB_TOPGEN]) == tg, bar);
            __builtin_amdgcn_fence(__ATOMIC_ACQUIRE, "agent");
            xb_add(&bar[XB_XGEN(b.x)], 1u);
            asm volatile("s_waitcnt vmcnt(0)" ::: "memory");
        } else {
            XB_SPIN(xb_ld(&bar[XB_XGEN(b.x)]) == gen, bar);
            __builtin_amdgcn_fence(__ATOMIC_ACQUIRE, "agent");
            asm volatile("s_waitcnt vmcnt(0)" ::: "memory");
        }
    }
    __syncthreads();
}

template <class Ep, int MODE  > struct TileEp {
    static constexpr bool PERM = false, AFTER_DRAIN = false;
    Ep e;
    __device__ __forceinline__ void operator()(const pg8::f32x4 (&acc)[2][2][4][2], const pg8::Unit& u, int wr, int wc, int fr, int fq) const {
        const int row0 = u.pm * 256 + wr * 64 + fr, cin = wc * 32 + 4 * fq;
#pragma unroll
        for (int ai = 0; ai < 2; ++ai)
#pragma unroll
            for (int m = 0; m < 4; ++m) {
                const int row = row0 + ai * 128 + m * 16;
                if constexpr (MODE == 2) {
#pragma unroll
                    for (int n = 0; n < 2; ++n) { const pg8::f32x4 a = acc[ai][0][m][n], b = acc[ai][1][m][n]; const float vg[4] = {a[0], a[1], a[2], a[3]}, vu[4] = {b[0], b[1], b[2], b[3]};
                        e.apply4(row, u.pn * 128 + cin + n * 16, vg, vu); }
                } else {
#pragma unroll
                    for (int bj = 0; bj < 2; ++bj)
#pragma unroll
                        for (int n = 0; n < 2; ++n) { const pg8::f32x4 a = acc[ai][bj][m][n]; const float v[4] = {a[0], a[1], a[2], a[3]}; const int col = u.pn * 256 + bj * 128 + cin + n * 16;
                            if constexpr (MODE == 1) e.apply4(row, col, v, u.seg); else e.apply4(row, col, v); }
                }
            }
    }
};

#ifndef PG8_ALIGN_K
#define PG8_ALIGN_K true
#endif
#ifndef PG8_SP2_K
#define PG8_SP2_K true
#endif
#ifndef CMP_S_EARLY
#define CMP_S_EARLY 0
#endif
#ifndef CONV_TAIL
#define CONV_TAIL 1
#endif
#define CONV_IN_TAIL(ntiles, lc, which) do { if (CONV_TAIL && (which) != 0) { const int rem_ = (ntiles) % G, c0_ = rem_ ? rem_ : 0; \
        if (c >= c0_) { __syncthreads(); REFRESH(); phw_convert(tid_ & 63, p, (LASP float*)(L + (tid_ >> 6) * 16384), __builtin_amdgcn_readfirstlane((c - c0_) * NWAVES + (tid_ >> 6)), (G - c0_) * NWAVES, (lc), (which)); } } } while (0)
#ifndef REC_CHAIN
#define REC_CHAIN 1
#endif
#ifndef MK_PER_PHASE
#define MK_PER_PHASE 0
#endif
constexpr int NWAVES = 8, NTHREADS = NWAVES * 64;
constexpr int RING_BYTES = 131072, MISC_OFF = RING_BYTES + 320, LDS_BYTES = 147456;
constexpr int CW_BAR = 4096;
constexpr int NPH_LAYER = 12, NPHASES = 1 + DEPTH * NPH_LAYER;
static_assert(HGW == NSAW && NSAW == RETW && HGW % 128 == 0 && HGW >= 256, "branch GEMM: three equal K segments");
static_assert(HGW % 128 == 0 && D_MODEL % 128 == 0 && FFN % 128 == 0 && NP % 256 == 0 && MP % 256 == 0 && HP % 256 == 0 && D_MODEL % 256 == 0 && (2 * FFN) % 256 == 0 && FFN % 128 == 0, "GEMM tile shapes");
static_assert((CW_BAR + XCD_BAR_WORDS) * 4 <= (int)CTL_BYTES, "control region");

constexpr int NWAVES_C = 8;
#ifndef CMP_DYN
#define CMP_DYN 1
#endif
__device__ __forceinline__ void phw_nsa_cmp_dyn(const int lane_, const P& p, int l, int bkv, int wg, int nwg, LAS unsigned* ctr) {
    const int nwl = nwg * NWAVES_C, per = NTG / nwl, nit = NWAVES_C * per;
    for (;;) {
        unsigned n = 0u; if (lane_ == 0) n = __hip_atomic_fetch_add(ctr, 1u, __ATOMIC_RELAXED, __HIP_MEMORY_SCOPE_WORKGROUP);
        n = (unsigned)__builtin_amdgcn_readfirstlane((int)n);
        if ((int)n >= nit) break;
        const int w = (int)n % NWAVES_C, s = per - 1 - (int)n / NWAVES_C, tgi = wg * NWAVES_C + w + s * nwl, tg = tgi < NTG / 2 ? 2 * tgi : 2 * (NTG - 1 - tgi) + 1;
        nsa_cmp_item(lane_fresh(lane_), p, l, bkv / NSA_KV_HEADS, bkv % NSA_KV_HEADS, tg);
    }
}
struct Args { P p; int ph_lo, ph_hi; };
typedef const __attribute__((address_space(4))) P* KP;
__device__ __forceinline__ KP kernarg_p() { auto k = __builtin_amdgcn_kernarg_segment_ptr(); asm volatile("" : "+s"(k)); return (KP)k; }
#if defined(__HIP_DEVICE_COMPILE__)
#define LOADP() const P p = *kernarg_p(); int tid_; asm volatile("v_mbcnt_lo_u32_b32 %0, -1, 0\n\tv_mbcnt_hi_u32_b32 %0, -1, %0" : "=v"(tid_)); tid_ += wid0 * 64; int l = l0, G = gridDim.x, c = blockIdx.x; asm volatile("" : "+v"(tid_), "+s"(l), "+s"(G), "+s"(c)); \
    const long gsize = (long)G * NTHREADS; long gtid = (long)c * NTHREADS + tid_, grev = gsize - 1 - gtid, gti = ((long)(tid_ >> 6) * G + c) * 64 + (tid_ & 63)
#else
#define LOADP() const P p = args.p; int tid_ = threadIdx.x; int l = l0, G = gridDim.x, c = blockIdx.x; const long gsize = (long)G * NTHREADS, gtid = (long)c * NTHREADS + threadIdx.x, grev = gsize - 1 - gtid, gti = gtid
#endif
__global__ void __launch_bounds__(NTHREADS, 2) fwd_kernel(Args args) {
    extern __shared__ __attribute__((aligned(16))) unsigned char lds[];
    LAS unsigned char* L = (LAS unsigned char*)lds;
    const int wid0 = __builtin_amdgcn_readfirstlane((int)(threadIdx.x >> 6));
    volatile LAS unsigned* MISC = (volatile LAS unsigned*)(L + MISC_OFF);
    for (int u = threadIdx.x; u < (LDS_BYTES - RING_BYTES) / 4; u += NTHREADS) ((LAS unsigned*)(L + RING_BYTES))[u] = 0u;
    __syncthreads();
    unsigned* barw; { const int l0 = 0; LOADP(); barw = (unsigned*)(p.ws + WS_CTL) + CW_BAR; (void)l; (void)gtid; (void)grev; (void)gsize; (void)G; (void)c; }
    XcdBarrier bar; bar.bar = barw; bar.x = 0; bar.st = nullptr;
    if (!MK_PER_PHASE) bar = xcd_barrier_post(barw, MISC + 8);
    const int lo = args.ph_lo, hi = args.ph_hi;
#ifndef PHASE_MASK
#define PHASE_MASK 0xFFFFFFFFu
#endif
#define PM(j) (((PHASE_MASK) >> (j)) & 1u)
#ifndef DUP_MASK
#define DUP_MASK 0u
#endif
#ifndef DUP_SUB
#define DUP_SUB 0
#endif
#if defined(__HIP_DEVICE_COMPILE__)
#define REFRESH() do { asm volatile("v_mbcnt_lo_u32_b32 %0, -1, 0\n\tv_mbcnt_hi_u32_b32 %0, -1, %0" : "=v"(tid_)); tid_ += wid0 * 64; gtid = (long)c * NTHREADS + tid_; grev = gsize - 1 - gtid; gti = ((long)(tid_ >> 6) * G + c) * 64 + (tid_ & 63); } while (0)
#else
#define REFRESH() do {} while (0)
#endif
#define RPT(id, ...) do { REFRESH(); __VA_ARGS__; if (DUP_SUB == (id)) { __VA_ARGS__; } } while (0)
#define REPS(j) for (int rep_ = 0; rep_ < 1 + (int)(((DUP_MASK) >> (j)) & 1u); ++rep_)
#define IN(k) (lo <= (k) && (k) < hi)
#ifndef DUP_BAR
#define DUP_BAR 0
#endif
#define SEAM(k) do { if (!MK_PER_PHASE && IN(k) && IN((k) + 1)) { xcd_barrier(bar); if (DUP_BAR) xcd_barrier(bar); } } while (0)
    if (PM(12) && IN(0)) REPS(12) { const int l0 = 0; LOADP(); (void)l; (void)G; (void)c;
        const int wv_ = __builtin_amdgcn_readfirstlane((int)(gtid >> 6)), nw_ = (int)(gsize >> 6);
        ph_lb(p, gtid, gsize); for (int l2 = 0; l2 < DEPTH; ++l2) phw_convert(tid_ & 63, p, (LASP float*)(L + (tid_ >> 6) * 16384), wv_, nw_, l2, CONV_TAIL ? 1 : 15); ph_zero_pad(p, gtid, gsize);
        for (int l2 = 0; l2 < DEPTH; ++l2) ph_copy_win(p, l2, gtid, gsize);
#if CMP_S_EARLY
        for (int l2 = 0; l2 < DEPTH; ++l2) phw_cmp_part(tid_ & 63, p, l2, __builtin_amdgcn_readfirstlane((int)(gti >> 6)), nw_, false, true, false);
#endif
        phw_norm(tid_ & 63, p, 0, 0, __builtin_amdgcn_readfirstlane((int)(grev >> 6)), nw_);
    }
    SEAM(0);
    for (int l0 = 0; l0 < DEPTH; ++l0) {
        const int b = 1 + l0 * NPH_LAYER;
        if (PM(0) && IN(b + 0)) REPS(0) { LOADP();
            pg8::Gemm g{WSP(bf16, WS_XN), WSP(bf16, WS_WIN + l * SZ_WIN), D_MODEL, D_MODEL, D_MODEL}; pg8::StaticOrder S; S.init(MP, HP, G, c);
            TileEp<EpIn, 0> E{EpIn{WSP(bf16, WS_H), p.out, l}};
            pg8::gemm_phase<TileEp<EpIn, 0>, pg8::StaticOrder, PG8_ALIGN_K, PG8_SP2_K>(L, g, S, E, tid_);
            CONV_IN_TAIL(S.nwg, l, 4);
        }
        SEAM(b + 0);
        if (PM(1) && IN(b + 1)) REPS(1) { LOADP(); RPT(1, ph_hg_pre(p, l, gti, gsize, NP));  RPT(3, phw_cmp_part(tid_ & 63, p, l, __builtin_amdgcn_readfirstlane((int)(gti >> 6)), (int)(gsize >> 6), true, !CMP_S_EARLY)); RPT(4, ph_nsa_prep(p, l, grev, gsize)); RPT(5, ph_rec_prep(p, l, gtid, gsize)); }
        SEAM(b + 1);
        if (PM(2) && IN(b + 2)) REPS(2) { LOADP(); RPT(12, ph_hg_scan(p, l, gti, gsize, BATCH)); ph_ret_scan(p, l, gsize - 1 - gti, gsize, BATCH); RPT(13, phw_nsa_cmp_s2(tid_ & 63, p, l, __builtin_amdgcn_readfirstlane((int)(gti >> 6)), (int)(gsize >> 6)));
#if REC_CHAIN
            RPT(14, { if (wid0 >= NWAVES - 2) { const int w2 = wid0 - (NWAVES - 2); const int slot = (G % 8 == 0) ? (c % 8) * (2 * (G / 8)) + (c / 8) * 2 + w2 : c * 2 + w2; phw_rec_chain(tid_ & 63, p, l, slot, 2 * G); } });
#endif
            RPT(15, { const int wid_ = wid0; if (CMP_DYN && REC_CHAIN && G % 8 == 0 && G >= 8 && NTG % ((G / 8) * NWAVES) == 0) phw_nsa_cmp_dyn(tid_ & 63, p, l, c % 8, c / 8, G / 8, (LAS unsigned*)(L + MISC_OFF) + 32 + l); else if (G % 8 == 0) phw_nsa_cmp(tid_ & 63, p, l, c % 8, 8, (c / 8) * NWAVES + wid_, (G / 8) * NWAVES); else phw_nsa_cmp(tid_ & 63, p, l, 0, 1, c * NWAVES + wid_, G * NWAVES); });
#if !REC_CHAIN
            RPT(14, phw_rec_ds(tid_ & 63, p, __builtin_amdgcn_readfirstlane((int)(gtid >> 6)), (int)(gsize >> 6)));
#endif
        }
        SEAM(b + 2);
        if (PM(3) && IN(b + 3)) REPS(3) { LOADP(); RPT(6, phw_nsa_select_s2(tid_ & 63, p, __builtin_amdgcn_readfirstlane((int)((gsize - 1 - gti) >> 6)), (int)(gsize >> 6))); ph_hg_post(p, l, gti, gsize, NP); ph_ret_post(p, l, gsize - 1 - gti, gsize, NP); RPT(10, { const int wid_ = wid0; if (G % 8 == 0) phw_nsa_selwin(tid_ & 63, p, l, c % 8, 8, (c / 8) * NWAVES + wid_, (G / 8) * NWAVES); else phw_nsa_selwin(tid_ & 63, p, l, 0, 1, c * NWAVES + wid_, G * NWAVES); }); if (!REC_CHAIN) RPT(7, ph_rec_scan(p, l, grev, gsize));  }
        SEAM(b + 3);
        if (PM(4) && IN(b + 4)) REPS(4) { LOADP(); RPT(9, phw_nsa_selwin_s2(tid_ & 63, p, l, __builtin_amdgcn_readfirstlane((int)(gti >> 6)), (int)(gsize >> 6)));
            RPT(11, { if (G % 8 == 0) phw_rec_out_x(tid_ & 63, p, l, c % 8, 8, (c / 8) * NWAVES + wid0, (G / 8) * NWAVES); else phw_rec_out(tid_ & 63, p, l, __builtin_amdgcn_readfirstlane((int)(gtid >> 6)), (int)(gsize >> 6)); }); }
        SEAM(b + 4);
        if (PM(5) && IN(b + 5)) REPS(5) { LOADP(); phw_nsa_combine_s(tid_ & 63, p, __builtin_amdgcn_readfirstlane((int)(gti >> 6)), (int)(gsize >> 6)); (void)grev; (void)G; (void)c;
            if (CONV_TAIL) { REFRESH(); phw_convert(tid_ & 63, p, (LASP float*)(L + (tid_ >> 6) * 16384), __builtin_amdgcn_readfirstlane((int)(gtid >> 6)), (int)(gsize >> 6), l, l == 0 ? 2 : 8); } }
        SEAM(b + 5);
        if (PM(6) && IN(b + 6)) REPS(6) { LOADP();
            pg8::Gemm g{WSP(bf16, WS_OCAT), WSP(bf16, WS_WBR + l * SZ_WBR), HGW, KBR, KBR}; pg8::BranchOrder S; S.init(NP, D_MODEL, G, c);
            TileEp<EpBr, 1> E{EpBr{WSP(bf16, WS_H), WSP(float, WS_MGF), WSP(bf16, WS_MG)}};
            pg8::gemm_phase<TileEp<EpBr, 1>, pg8::BranchOrder, PG8_ALIGN_K, PG8_SP2_K>(L, g, S, E, tid_);
            if (c < D_MODEL / 32) {
                for (int seg = 0; seg < 3; ++seg) { const int ko = seg == 0 ? 0 : (seg == 1 ? HGW : HGW + NSAW);
                    skinny_item_k8(tid_, (LASP float*)L, WSP(bf16, WS_OCAT) + (size_t)NP * KBR + ko, KBR, WSP(bf16, WS_WBR + l * SZ_WBR) + ko, KBR, HGW, 32 * c, [&](int r, int cc, const float* v) { E.e.apply4(r, cc, v, seg); }); } }
        }
        SEAM(b + 6);
        if (PM(7) && IN(b + 7)) REPS(7) { LOADP();
            pg8::Gemm g{WSP(bf16, WS_MG), WSP(bf16, WS_WOUT + l * SZ_WOUT), D_MODEL, D_MODEL, D_MODEL}; pg8::StaticOrder S; S.init(NP, D_MODEL, G, c);
            TileEp<EpOut, 0> E{EpOut{p.x_prompt, p.x_sample, WSP(float, WS_XL), WSP(float, WS_X1), l}};
            pg8::gemm_phase<TileEp<EpOut, 0>, pg8::StaticOrder, PG8_ALIGN_K, PG8_SP2_K>(L, g, S, E, tid_);
            if (c < D_MODEL / 32) skinny_item_k8(tid_, (LASP float*)L, WSP(bf16, WS_MG) + (size_t)NP * D_MODEL, D_MODEL, WSP(bf16, WS_WOUT + l * SZ_WOUT), D_MODEL, D_MODEL, 32 * c, [&](int r, int cc, const float* v) { E.e.apply4(r, cc, v); });
        }
        SEAM(b + 7);
        if (PM(8) && IN(b + 8)) REPS(8) { LOADP(); phw_norm(tid_ & 63, p, l, 1, __builtin_amdgcn_readfirstlane((int)(gtid >> 6)), (int)(gsize >> 6)); }
        SEAM(b + 8);
        if (PM(9) && IN(b + 9)) REPS(9) { LOADP();
            pg8::Gemm g{WSP(bf16, WS_XN), WSP(bf16, WS_WGU + l * SZ_WGU), D_MODEL, D_MODEL, D_MODEL}; pg8::StaticOrder S; S.init(MP, 2 * FFN, G, c);
            TileEp<EpGU, 2> E{EpGU{WSP(bf16, WS_GU)}};
            pg8::gemm_phase<TileEp<EpGU, 2>, pg8::StaticOrder, PG8_ALIGN_K, PG8_SP2_K>(L, g, S, E, tid_);
            CONV_IN_TAIL(S.nwg, l, l == 0 ? 8 : 0); CONV_IN_TAIL(S.nwg, l + 1, l + 1 < DEPTH ? 2 : 0);
        }
        SEAM(b + 9);
        if (PM(10) && IN(b + 10)) REPS(10) { LOADP();
            pg8::Gemm g{WSP(bf16, WS_GU), WSP(bf16, WS_WDN + l * SZ_WDN), FFN, FFN, FFN}; pg8::StaticOrder S; S.init(NP, D_MODEL, G, c);
            TileEp<EpDown, 0> E{EpDown{WSP(float, WS_X1), WSP(float, WS_XL), p.out, l}};
            pg8::gemm_phase<TileEp<EpDown, 0>, pg8::StaticOrder, PG8_ALIGN_K, PG8_SP2_K>(L, g, S, E, tid_);
            if (c < D_MODEL / 32) skinny_item_k8(tid_, (LASP float*)L, WSP(bf16, WS_GU) + (size_t)NP * FFN, FFN, WSP(bf16, WS_WDN + l * SZ_WDN), FFN, FFN, 32 * c, [&](int r, int cc, const float* v) { E.e.apply4(r, cc, v); });
        }
        SEAM(b + 10);
        if (PM(11) && IN(b + 11) && l0 + 1 < DEPTH) REPS(11) { LOADP(); phw_norm(tid_ & 63, p, l + 1, 0, __builtin_amdgcn_readfirstlane((int)(gtid >> 6)), (int)(gsize >> 6)); }
        SEAM(b + 11);
    }
#undef IN
#undef SEAM
}

extern "C" void kernel_launch(void* const* d_in, const int* in_sizes, int n_in, void* d_out, int out_size, void* d_ws, size_t ws_size, hipStream_t stream) {
    static int grid = 0;
    if (grid == 0) {
        if (n_in != 22 || (long)out_size != O_END || ws_size < WS_END) { fprintf(stderr, "kernel_launch: unexpected shapes: n_in %d out %d (want %ld) ws %zu (want %zu)\n", n_in, out_size, O_END, ws_size, (size_t)WS_END); grid = -1; return; }
        int dev = 0, cus = 0;
        if (hipGetDevice(&dev) != hipSuccess || hipDeviceGetAttribute(&cus, hipDeviceAttributeMultiprocessorCount, dev) != hipSuccess) { grid = -1; return; }
        if (hipFuncSetAttribute((const void*)fwd_kernel, hipFuncAttributeMaxDynamicSharedMemorySize, LDS_BYTES) != hipSuccess) { fprintf(stderr, "kernel_launch: hipFuncSetAttribute failed\n"); grid = -1; return; }
        int per_cu = 0;
        if (hipOccupancyMaxActiveBlocksPerMultiprocessor(&per_cu, (const void*)fwd_kernel, NTHREADS, LDS_BYTES) != hipSuccess || per_cu < 1) { fprintf(stderr, "kernel_launch: occupancy query says %d\n", per_cu); }
        (void)hipGetLastError();
        grid = cus;
    }
    if (grid < 0) return;
    (void)hipMemsetAsync((char*)d_ws + WS_CTL, 0, (size_t)(CW_BAR + XCD_BAR_WORDS) * 4, stream);
    Args a{};
    P& p = a.p;
    p.x_prompt = (const float*)d_in[0]; p.x_sample = (const float*)d_in[1]; p.cache_nsa = (const float*)d_in[2]; p.cache_win = (const float*)d_in[3];
    p.state_hgrn = (const float*)d_in[4]; p.state_ret = (const float*)d_in[5]; p.page_table = (const int*)d_in[6];
    p.norm_attn = (const float*)d_in[7]; p.w_in = (const float*)d_in[8]; p.lb_logits = (const float*)d_in[9]; p.hg_out_norm = (const float*)d_in[10];
    p.nsa_q_norm = (const float*)d_in[11]; p.nsa_k_norm = (const float*)d_in[12]; p.nsa_cmp_w = (const float*)d_in[13];
    p.w_br_hg = (const float*)d_in[14]; p.w_br_nsa = (const float*)d_in[15]; p.w_br_ret = (const float*)d_in[16]; p.w_out = (const float*)d_in[17];
    p.norm_ffn = (const float*)d_in[18]; p.w_gate = (const float*)d_in[19]; p.w_up = (const float*)d_in[20]; p.w_down = (const float*)d_in[21];
    p.out = (float*)d_out; p.ws = (unsigned char*)d_ws;
#if MK_PER_PHASE
    for (int k = 0; k < NPHASES; ++k) { a.ph_lo = k; a.ph_hi = k + 1; hipLaunchKernelGGL(fwd_kernel, dim3(grid), dim3(NTHREADS), LDS_BYTES, stream, a); }
#else
    a.ph_lo = 0; a.ph_hi = NPHASES;
    hipLaunchKernelGGL(fwd_kernel, dim3(grid), dim3(NTHREADS), LDS_BYTES, stream, a);
#endif
    const hipError_t le = hipPeekAtLastError();
    if (le != hipSuccess) fprintf(stderr, "kernel_launch: launch failed: %s\n", hipGetErrorName(le));
}
#endif
```
